# Optimizing an MI355X kernel written in HIP

```python
import numpy as np
import jax
import jax.numpy as jnp
from jax import lax

D_MODEL = 1024
BATCH = 2
SEQ = 16384
DEPTH = 4

GRID_W = 64
CTX_LEN = 256
N_MIXERS = 2
N_LAYERS_NA = (DEPTH + N_MIXERS - 1) // N_MIXERS
N_LAYERS_LRU = DEPTH // N_MIXERS
N_SUBLAYERS = 3
N_MOD = 3 * N_SUBLAYERS
FFN_HIDDEN = 256 * ((8 * D_MODEL // 3 + 255) // 256)
NA_HEADS = 16
NA_HEAD_DIM = D_MODEL // NA_HEADS
NA_WIN_ROWS = 8
NA_WIN_COLS = 16
ROPE_BASE = 10000.0
ROPE_PAIRS_PER_AXIS = NA_HEAD_DIM // 4
LRU_WIDTH = 5 * D_MODEL // 4
LRU_BLOCKS = 10
LRU_BLOCK_W = LRU_WIDTH // LRU_BLOCKS
LRU_C = 8.0
CONV_W = 4
CONV_PAD_LEFT = 2
CONV_PAD_RIGHT = CONV_W - 1 - CONV_PAD_LEFT
RMS_EPS = 1e-6
FFN_RES_WEIGHT = 0.5

kernel_name = 'hybrid_natten_rglru_macaron_dit'


def rms_norm(x, gain):
    x32 = x.astype(jnp.float32)
    y = x32 * lax.rsqrt(jnp.mean(x32 * x32, axis=-1, keepdims=True) + RMS_EPS)
    return (y * gain.astype(jnp.float32)).astype(x.dtype)


def modulate(u, gain, mod, s):
    return rms_norm(u, gain) * (1.0 + mod[:, 3 * s + 1]) + mod[:, 3 * s]


def gated_residual(u, y, gain, mod, s, weight):
    return u + weight * mod[:, 3 * s + 2] * rms_norm(y, gain)


def swiglu(h, w_gate, w_up, w_down):
    return (jax.nn.silu(h @ w_gate) * (h @ w_up)) @ w_down


def axial_rope_tables(n_tok):
    t = jnp.arange(n_tok, dtype=jnp.int32)
    row = (t // GRID_W).astype(jnp.float32)
    col = (t % GRID_W).astype(jnp.float32)
    inv_freq = jnp.power(ROPE_BASE, -jnp.arange(ROPE_PAIRS_PER_AXIS, dtype=jnp.float32) / ROPE_PAIRS_PER_AXIS)
    ang = jnp.concatenate([row[:, None] * inv_freq, col[:, None] * inv_freq], axis=-1)
    return jnp.cos(ang), jnp.sin(ang)


def apply_rope(x, cos, sin):
    x1, x2 = jnp.split(x.astype(jnp.float32), 2, axis=-1)
    cs, sn = cos[None, :, None, :], sin[None, :, None, :]
    return jnp.concatenate([x1 * cs - x2 * sn, x1 * sn + x2 * cs], axis=-1).astype(x.dtype)


def neighbourhood_attention(h, hc, w_qkv, w_o, rpb, cos, sin, need_ctx):
    bsz, n_tok, _ = h.shape
    rows = n_tok // GRID_W
    wr = min(NA_WIN_ROWS, rows)
    wc = min(NA_WIN_COLS, GRID_W)
    scale = NA_HEAD_DIM ** -0.5

    def heads(u):
        return u.reshape(u.shape[0], u.shape[1], NA_HEADS, NA_HEAD_DIM)

    q, k, v = (heads(t) for t in jnp.split(h @ w_qkv, 3, axis=-1))
    q = apply_rope(q, cos, sin)
    k = apply_rope(k, cos, sin)
    kc, vc = (heads(t) for t in jnp.split(hc @ w_qkv[:, D_MODEL:], 2, axis=-1))

    def grid(t):
        return t.reshape(bsz, rows, GRID_W, NA_HEADS, NA_HEAD_DIM)

    q_g, k_g, v_g = grid(q), grid(k), grid(v)

    col = np.arange(GRID_W)
    col_start = np.clip(col - wc // 2, 0, GRID_W - wc)
    col_idx = col_start[:, None] + np.arange(wc)[None, :]
    dc_idx = col_idx - col[:, None] + NA_WIN_COLS - 1
    rpb_cols = rpb[:, :, dc_idx]

    def row_block(r):
        r0 = jnp.clip(r - wr // 2, 0, rows - wr)
        k_win = lax.dynamic_slice_in_dim(k_g, r0, wr, axis=1)[:, :, col_idx]
        v_win = lax.dynamic_slice_in_dim(v_g, r0, wr, axis=1)[:, :, col_idx]
        dr_idx = r0 + jnp.arange(wr, dtype=jnp.int32) - r + NA_WIN_ROWS - 1
        bias = jnp.take(rpb_cols, dr_idx, axis=1).transpose(0, 2, 1, 3)
        q_r = lax.dynamic_index_in_dim(q_g, r, axis=1, keepdims=False)
        s_lat = jnp.einsum('bqhd,bkqjhd->bhqkj', q_r, k_win) * scale + bias[None]
        s_ctx = jnp.einsum('bqhd,bchd->bhqc', q_r, kc) * scale
        s_all = jnp.concatenate([s_lat.reshape(bsz, NA_HEADS, GRID_W, wr * wc), s_ctx], axis=-1)
        p = jax.nn.softmax(s_all.astype(jnp.float32), axis=-1).astype(v.dtype)
        p_lat = p[..., :wr * wc].reshape(bsz, NA_HEADS, GRID_W, wr, wc)
        p_ctx = p[..., wr * wc:]
        return (jnp.einsum('bhqkj,bkqjhd->bqhd', p_lat, v_win)
                + jnp.einsum('bhqc,bchd->bqhd', p_ctx, vc))

    o = lax.map(row_block, jnp.arange(rows, dtype=jnp.int32))
    y = o.transpose(1, 0, 2, 3, 4).reshape(bsz, n_tok, D_MODEL) @ w_o
    if not need_ctx:
        return y, None
    qc = heads(hc @ w_qkv[:, :D_MODEL])
    s_c = jnp.einsum('bqhd,bkhd->bhqk', qc, kc) * scale
    p_c = jax.nn.softmax(s_c.astype(jnp.float32), axis=-1).astype(vc.dtype)
    yc = jnp.einsum('bhqk,bkhd->bqhd', p_c, vc).reshape(bsz, hc.shape[1], D_MODEL) @ w_o
    return y, yc


def depthwise_conv(u, w, b):
    n = u.shape[1]
    up = jnp.pad(u, ((0, 0), (CONV_PAD_LEFT, CONV_PAD_RIGHT), (0, 0)))
    out = up[:, 0:n] * w[0] + b
    for tap in range(1, CONV_W):
        out = out + up[:, tap:tap + n] * w[tap]
    return out


def lru_gates(u, w_a, b_a, w_x, b_x, lam):
    bsz, n, _ = u.shape
    ub = u.reshape(bsz, n, LRU_BLOCKS, LRU_BLOCK_W)
    r = jax.nn.sigmoid(jnp.einsum('blnk,nkj->blnj', ub, w_a).reshape(bsz, n, LRU_WIDTH) + b_a)
    i = jax.nn.sigmoid(jnp.einsum('blnk,nkj->blnj', ub, w_x).reshape(bsz, n, LRU_WIDTH) + b_x)
    log_a = -LRU_C * r.astype(jnp.float32) * jax.nn.softplus(-lam.astype(jnp.float32))
    a = jnp.exp(log_a)
    b = jnp.sqrt(-jnp.expm1(2.0 * log_a)) * (i * u).astype(jnp.float32)
    return a, b


def linear_scan(a, b, reverse):
    def combine(e1, e2):
        a1, b1 = e1
        a2, b2 = e2
        return a1 * a2, a2 * b1 + b2
    return lax.associative_scan(combine, (a, b), axis=1, reverse=reverse)[1]


def rglru_mixer(h, hc, w_in, conv_w, conv_b, w_a, b_a, w_x, b_x, lam, w_o, need_ctx):
    w_gate, w_rec = w_in[:, :LRU_WIDTH], w_in[:, LRU_WIDTH:]
    u = depthwise_conv(h @ w_rec, conv_w, conv_b)
    uc = depthwise_conv(hc @ w_rec, conv_w, conv_b)
    lat_states, ctx_states = [], []
    for d, reverse in enumerate((False, True)):
        ctx_edge = 0 if reverse else -1
        lat_edge = -1 if reverse else 0
        a_c, b_c = lru_gates(uc, w_a[d], b_a[d], w_x[d], b_x[d], lam[d])
        hs_c = linear_scan(a_c, b_c, reverse)
        a, b = lru_gates(u, w_a[d], b_a[d], w_x[d], b_x[d], lam[d])
        b = b.at[:, lat_edge].add(a[:, lat_edge] * hs_c[:, ctx_edge])
        lat_states.append(linear_scan(a, b, reverse))
        ctx_states.append(hs_c)
    rec = (lat_states[0] + lat_states[1]).astype(h.dtype)
    y = (rec * jax.nn.gelu(h @ w_gate)) @ w_o
    if not need_ctx:
        return y, None
    rec_c = (ctx_states[0] + ctx_states[1]).astype(hc.dtype)
    yc = (rec_c * jax.nn.gelu(hc @ w_gate)) @ w_o
    return y, yc


def setup_inputs(seed: int = 0) -> dict:
    key = jax.random.key(seed)
    ks = jax.random.split(key, 24)
    f32 = jnp.float32

    def nrm(k, shape, scale):
        return jax.random.normal(k, shape, f32) * scale

    a_pow = jax.random.uniform(ks[21], (N_LAYERS_LRU, 2, LRU_WIDTH), f32, 0.9, 0.999)
    s = a_pow ** (1.0 / LRU_C)
    return {
        'x': nrm(ks[0], (BATCH, SEQ, D_MODEL), 1.0),
        'c': nrm(ks[1], (BATCH, D_MODEL), 1.0),
        'ctx': nrm(ks[2], (BATCH, CTX_LEN, D_MODEL), 1.0),
        'c_ctx': nrm(ks[3], (D_MODEL,), 1.0),
        'ada_w': nrm(ks[4], (DEPTH, D_MODEL, N_MOD * D_MODEL), D_MODEL ** -0.5),
        'ada_b': nrm(ks[5], (DEPTH, N_MOD * D_MODEL), 0.01),
        'norm_pre': 1.0 + nrm(ks[6], (DEPTH, N_SUBLAYERS, D_MODEL), 0.05),
        'norm_post': 1.0 + nrm(ks[7], (DEPTH, N_SUBLAYERS, D_MODEL), 0.05),
        'ffn_w_gate': nrm(ks[8], (DEPTH, 2, D_MODEL, FFN_HIDDEN), D_MODEL ** -0.5),
        'ffn_w_up': nrm(ks[9], (DEPTH, 2, D_MODEL, FFN_HIDDEN), D_MODEL ** -0.5),
        'ffn_w_down': nrm(ks[10], (DEPTH, 2, FFN_HIDDEN, D_MODEL), FFN_HIDDEN ** -0.5),
        'na_w_qkv': nrm(ks[11], (N_LAYERS_NA, D_MODEL, 3 * D_MODEL), D_MODEL ** -0.5),
        'na_w_o': nrm(ks[12], (N_LAYERS_NA, D_MODEL, D_MODEL), D_MODEL ** -0.5),
        'na_rpb': nrm(ks[13], (N_LAYERS_NA, NA_HEADS, 2 * NA_WIN_ROWS - 1, 2 * NA_WIN_COLS - 1), 0.1),
        'lru_w_in': nrm(ks[14], (N_LAYERS_LRU, D_MODEL, 2 * LRU_WIDTH), D_MODEL ** -0.5),
        'lru_conv_w': nrm(ks[15], (N_LAYERS_LRU, CONV_W, LRU_WIDTH), CONV_W ** -0.5),
        'lru_conv_b': nrm(ks[16], (N_LAYERS_LRU, LRU_WIDTH), 0.01),
        'lru_w_a': nrm(ks[17], (N_LAYERS_LRU, 2, LRU_BLOCKS, LRU_BLOCK_W, LRU_BLOCK_W), LRU_BLOCK_W ** -0.5),
        'lru_b_a': nrm(ks[18], (N_LAYERS_LRU, 2, LRU_WIDTH), 0.01),
        'lru_w_x': nrm(ks[19], (N_LAYERS_LRU, 2, LRU_BLOCKS, LRU_BLOCK_W, LRU_BLOCK_W), LRU_BLOCK_W ** -0.5),
        'lru_b_x': nrm(ks[20], (N_LAYERS_LRU, 2, LRU_WIDTH), 0.01),
        'lru_lambda': jnp.log(s) - jnp.log1p(-s),
        'lru_w_o': nrm(ks[22], (N_LAYERS_LRU, LRU_WIDTH, D_MODEL), LRU_WIDTH ** -0.5),
    }


def reference(x, c, ctx, c_ctx, ada_w, ada_b, norm_pre, norm_post, ffn_w_gate, ffn_w_up, ffn_w_down,
              na_w_qkv, na_w_o, na_rpb, lru_w_in, lru_conv_w, lru_conv_b, lru_w_a, lru_b_a,
              lru_w_x, lru_b_x, lru_lambda, lru_w_o):
    cos, sin = axial_rope_tables(x.shape[1])
    xc = ctx
    for i in range(DEPTH):
        last = i == DEPTH - 1
        j = i // N_MIXERS
        mod = (jax.nn.silu(c) @ ada_w[i] + ada_b[i]).reshape(x.shape[0], N_MOD, 1, D_MODEL)
        mod_c = (jax.nn.silu(c_ctx) @ ada_w[i] + ada_b[i]).reshape(1, N_MOD, 1, D_MODEL)

        def half_ffn(u, m, s):
            f = s // 2
            y = swiglu(modulate(u, norm_pre[i, s], m, s), ffn_w_gate[i, f], ffn_w_up[i, f], ffn_w_down[i, f])
            return gated_residual(u, y, norm_post[i, s], m, s, FFN_RES_WEIGHT)

        x = half_ffn(x, mod, 0)
        xc = half_ffn(xc, mod_c, 0)
        h = modulate(x, norm_pre[i, 1], mod, 1)
        hc = modulate(xc, norm_pre[i, 1], mod_c, 1)
        if i % N_MIXERS == 0:
            y, yc = neighbourhood_attention(h, hc, na_w_qkv[j], na_w_o[j], na_rpb[j], cos, sin, not last)
        else:
            y, yc = rglru_mixer(h, hc, lru_w_in[j], lru_conv_w[j], lru_conv_b[j], lru_w_a[j], lru_b_a[j],
                                lru_w_x[j], lru_b_x[j], lru_lambda[j], lru_w_o[j], not last)
        x = gated_residual(x, y, norm_post[i, 1], mod, 1, 1.0)
        x = half_ffn(x, mod, 2)
        if not last:
            xc = gated_residual(xc, yc, norm_post[i, 1], mod_c, 1, 1.0)
            xc = half_ffn(xc, mod_c, 2)
    return x
```

```cpp
#include <hip/hip_runtime.h>
namespace pg8 {
#define PG8_LAS __attribute__((address_space(3)))
typedef unsigned short bf16_t;
typedef short bf16x8 __attribute__((ext_vector_type(8)));
typedef float f32x4 __attribute__((ext_vector_type(4)));
typedef unsigned u32x4 __attribute__((ext_vector_type(4)));
constexpr int BM = 256, BK = 64, HALF = 128, HTB = HALF * BK * 2  , STAGE_BYTES = 8 * HTB, NXCD = 8, WGM = 8;

__host__ __device__ __forceinline__ int lds_byte(int r, int c) { const int st = (r >> 4) * 2 + (c >> 5), rr = r & 15, cc = c & 31, ob = rr * 64 + cc * 2; return st * 1024 + (ob ^ (((ob >> 9) & 1) << 5)); }
__host__ __device__ __forceinline__ void stage_rc(int b, int& R, int& C) { const int st = b / 1024, sb = b % 1024, swz = sb ^ (((sb >> 9) & 1) << 5); R = (st >> 1) * 16 + swz / 64; C = (st & 1) * 32 + (swz % 64) / 2; }
__host__ __device__ __forceinline__ int perm32(int rho) { const int n = rho >> 4, i = rho & 15; return 8 * (i >> 2) + 4 * n + (i & 3); }

struct Unit { int pm, pn; };
struct Gemm { const bf16_t* A; const bf16_t* Bt; int M, N, K; };

struct StaticOrder {
    int nM, nN, nwg, G, c;
    __host__ __device__ void init(int M, int N, int G_, int c_) { nM = M / BM; nN = N / BM; nwg = nM * nN; G = G_; c = c_; }
    __host__ __device__ bool next(int i, Unit& u) const {
        const long L = (long)i * G + c; if (L >= nwg) return false;
        int wgid = (int)L; { const int q = nwg / NXCD, r = nwg % NXCD, xcd = wgid % NXCD, off = wgid / NXCD; wgid = (xcd < r ? xcd * (q + 1) : r * (q + 1) + (xcd - r) * q) + off; }
        const int nig = WGM * nN, gid = wgid / nig, fm = gid * WGM, gsz = (nM - fm) < WGM ? (nM - fm) : WGM;
        u.pm = fm + ((wgid % nig) % gsz); u.pn = (wgid % nig) / gsz; return true;
    }
    __device__ __forceinline__ void a_ready(const Unit&) const {}
    __device__ __forceinline__ void done(const Unit&) const {}
};
struct CountedOrder : StaticOrder {
    const unsigned* ready; unsigned need; unsigned* tmo;
    __device__ __forceinline__ void a_ready(const Unit& u) const {
        if (threadIdx.x < 64) {
            const unsigned long long t0 = __builtin_amdgcn_s_memrealtime(); unsigned polls = 0;
            while ((unsigned)__builtin_amdgcn_readfirstlane(__hip_atomic_load(ready + 64 * u.pm, __ATOMIC_RELAXED, __HIP_MEMORY_SCOPE_AGENT)) < need) {
                if ((++polls & 255u) == 0u && __builtin_amdgcn_readfirstlane(__hip_atomic_load(tmo, __ATOMIC_RELAXED, __HIP_MEMORY_SCOPE_AGENT)) != 0u) break;
                if (__builtin_amdgcn_s_memrealtime() - t0 > 2000000ull) {
                    if (threadIdx.x == 0) { unsigned expect = 0u; __hip_atomic_compare_exchange_strong(tmo + 1, &expect, 0x600u | (unsigned)(u.pm & 0xff), __ATOMIC_RELAXED, __ATOMIC_RELAXED, __HIP_MEMORY_SCOPE_AGENT); __hip_atomic_store(tmo, 1u, __ATOMIC_RELAXED, __HIP_MEMORY_SCOPE_AGENT); }
                    break; }
                __builtin_amdgcn_s_sleep(2); }
            __builtin_amdgcn_fence(__ATOMIC_ACQUIRE, "agent");
            asm volatile("s_waitcnt vmcnt(0)" ::: "memory");
        }
#if !defined(BROKEN_HOOK_NO_BARRIER)
        asm volatile("" ::: "memory"); __builtin_amdgcn_s_barrier(); asm volatile("" ::: "memory");
#endif
    }
};

__device__ __forceinline__ unsigned cvt_pk_bf16(float lo, float hi) { unsigned r; asm volatile("v_cvt_pk_bf16_f32 %0, %1, %2" : "=v"(r) : "v"(lo), "v"(hi)); return r; }
typedef float f32x2 __attribute__((ext_vector_type(2)));
__device__ __forceinline__ f32x2 gelu_pk(f32x2 v) {
    const f32x2 av = __builtin_elementwise_abs(v), d = av * 0.2316418882f + 1.0f;
    f32x2 t; t.x = __builtin_amdgcn_rcpf(d.x); t.y = __builtin_amdgcn_rcpf(d.y);
    f32x2 q = t * 0.5307027145f + (-0.7265760135f); q = q * t + 0.7107068705f; q = q * t + (-0.142248368f); q = q * t + 0.127414796f; q = q * t;
    const f32x2 s = (v * v) * (-0.72134752044f);
    f32x2 e; e.x = __builtin_amdgcn_exp2f(s.x); e.y = __builtin_amdgcn_exp2f(s.y);
    const f32x2 m = v * (q * e), r = v - m;
    f32x2 o; o.x = v.x < 0.f ? m.x : r.x; o.y = v.y < 0.f ? m.y : r.y; return o;
}

struct EpiF32 {
    static constexpr bool PERM = false, AFTER_DRAIN = false;
    float* C; int ldc; const float* bias;
    __device__ __forceinline__ void operator()(const f32x4 (&acc)[2][2][4][2], const Unit& u, int wr, int wc, int fr, int fq) const {
        const int row0 = u.pm * BM + wr * 64 + fr, col0 = u.pn * BM + wc * 32 + 4 * fq;
        f32x4 bv[2][2];
#pragma unroll
        for (int bj = 0; bj < 2; ++bj)
#pragma unroll
            for (int n = 0; n < 2; ++n) bv[bj][n] = bias ? *(const f32x4*)(bias + col0 + bj * HALF + n * 16) : (f32x4){0.f, 0.f, 0.f, 0.f};
#pragma unroll
        for (int ai = 0; ai < 2; ++ai)
#pragma unroll
            for (int m = 0; m < 4; ++m) { float* rowp = C + (size_t)(row0 + ai * HALF + m * 16) * ldc + col0;
#pragma unroll
                for (int bj = 0; bj < 2; ++bj)
#pragma unroll
                    for (int n = 0; n < 2; ++n) *(f32x4*)(rowp + bj * HALF + n * 16) = acc[ai][bj][m][n] + bv[bj][n]; }
    }
};
template <int ACT  > struct EpiBf16 {
    static constexpr bool PERM = true, AFTER_DRAIN = false;
    bf16_t* O; int ldc; const float* bias; int split_cols; size_t split_stride;
    __device__ __forceinline__ void operator()(const f32x4 (&acc)[2][2][4][2], const Unit& u, int wr, int wc, int fr, int fq) const {
        const int row0 = u.pm * BM + wr * 64 + fr; int colt = u.pn * BM; bf16_t* base = O;
        if (split_cols) { const int t = colt / split_cols; base += (size_t)t * split_stride; colt -= t * split_cols; }
        const int col0 = colt + wc * 32 + 8 * fq, bcol0 = u.pn * BM + wc * 32 + 8 * fq;
        f32x4 bv[2][2];
#pragma unroll
        for (int bj = 0; bj < 2; ++bj)
#pragma unroll
            for (int n = 0; n < 2; ++n) bv[bj][n] = bias ? *(const f32x4*)(bias + bcol0 + bj * HALF + 4 * n) : (f32x4){0.f, 0.f, 0.f, 0.f};
#pragma unroll
        for (int ai = 0; ai < 2; ++ai)
#pragma unroll
            for (int m = 0; m < 4; ++m) { bf16_t* rowp = base + (size_t)(row0 + ai * HALF + m * 16) * ldc + col0;
#pragma unroll
                for (int bj = 0; bj < 2; ++bj) { f32x4 v0 = acc[ai][bj][m][0] + bv[bj][0], v1 = acc[ai][bj][m][1] + bv[bj][1];
                    if (ACT == 1) { f32x2 a = gelu_pk((f32x2){v0[0], v0[1]}), b = gelu_pk((f32x2){v0[2], v0[3]}), c = gelu_pk((f32x2){v1[0], v1[1]}), d = gelu_pk((f32x2){v1[2], v1[3]});
                        v0 = (f32x4){a.x, a.y, b.x, b.y}; v1 = (f32x4){c.x, c.y, d.x, d.y}; }
                    if (ACT == 2) {
#pragma unroll
                        for (int j = 0; j < 4; ++j) { v0[j] = 0.5f * v0[j] * (1.0f + erff(v0[j] * 0.70710678f)); v1[j] = 0.5f * v1[j] * (1.0f + erff(v1[j] * 0.70710678f)); } }
                    u32x4 w; w.x = cvt_pk_bf16(v0[0], v0[1]); w.y = cvt_pk_bf16(v0[2], v0[3]); w.z = cvt_pk_bf16(v1[0], v1[1]); w.w = cvt_pk_bf16(v1[2], v1[3]);
                    *(u32x4*)(rowp + bj * HALF) = w; } }
    }
};

struct PanelStats {
    unsigned* xbuf;
    unsigned* cnt;
    unsigned* tmo;
    int ntn; float eps;
    unsigned code;
    __device__ __forceinline__ bool run(const f32x4 (&v)[2][2][4][2], const Unit& u, int wr, int wc, int fr, int fq, PG8_LAS unsigned char* lds, int wid, int lane) const {
        typedef float f32x2v __attribute__((ext_vector_type(2)));
        PG8_LAS f32x2v* P = (PG8_LAS f32x2v*)lds;
        PG8_LAS f32x2v* S = (PG8_LAS f32x2v*)(lds + 8192);
        PG8_LAS unsigned* flag = (PG8_LAS unsigned*)(lds + 8192 + 2048);
#pragma unroll
        for (int ai = 0; ai < 2; ++ai)
#pragma unroll
            for (int m = 0; m < 4; ++m) {
                float s = 0.f;
#pragma unroll
                for (int bj = 0; bj < 2; ++bj)
#pragma unroll
                    for (int n = 0; n < 2; ++n) { const f32x4 x = v[ai][bj][m][n]; s += (x[0] + x[1]) + (x[2] + x[3]); }
                s += __shfl_xor(s, 16); s += __shfl_xor(s, 32);
                const float mw = s * (1.0f / 64.0f); float q = 0.f;
#pragma unroll
                for (int bj = 0; bj < 2; ++bj)
#pragma unroll
                    for (int n = 0; n < 2; ++n) { const f32x4 d = v[ai][bj][m][n] - mw; q += (d[0] * d[0] + d[1] * d[1]) + (d[2] * d[2] + d[3] * d[3]); }
                q += __shfl_xor(q, 16); q += __shfl_xor(q, 32);
                if (fq == 0) P[(ai * HALF + wr * 64 + m * 16 + fr) * 4 + wc] = (f32x2v){mw, q};
            }
        asm volatile("s_waitcnt lgkmcnt(0)" ::: "memory"); __builtin_amdgcn_s_barrier(); asm volatile("" ::: "memory");
#if defined(BROKEN_NO_WAIT)
        if (blockIdx.x >= 64) { const long long t0 = clock64(); while (clock64() - t0 < 60000) __builtin_amdgcn_s_sleep(8); }
#endif
        const int row = wid * 32 + (lane & 31);
        if (lane < 32) {
            const f32x2v a = P[row * 4 + 0], b = P[row * 4 + 1], c = P[row * 4 + 2], d = P[row * 4 + 3];
            const float mt = (a.x + b.x + c.x + d.x) * 0.25f;
            const float da = a.x - mt, db = b.x - mt, dc = c.x - mt, dd = d.x - mt;
            const float m2 = (a.y + b.y) + (c.y + d.y) + 64.0f * ((da * da + db * db) + (dc * dc + dd * dd));
            unsigned long long* slot = (unsigned long long*)xbuf + ((size_t)(u.pm * BM + row) * 4 + u.pn);
            __hip_atomic_store(slot, ((unsigned long long)__float_as_uint(m2) << 32) | __float_as_uint(mt), __ATOMIC_RELAXED, __HIP_MEMORY_SCOPE_AGENT);
        }
        asm volatile("s_waitcnt vmcnt(0)" ::: "memory");
        if (lane == 0) __hip_atomic_fetch_add(cnt + 64 * u.pm, 1u, __ATOMIC_RELAXED, __HIP_MEMORY_SCOPE_AGENT);
        if (wid == 0) {
            bool dead = false; const unsigned long long t0 = __builtin_amdgcn_s_memrealtime(); const unsigned want = 8u * (unsigned)ntn;
            for (;;) {
#if defined(BROKEN_NO_WAIT)
                break;
#endif
                if ((unsigned)__builtin_amdgcn_readfirstlane(__hip_atomic_load(cnt + 64 * u.pm, __ATOMIC_RELAXED, __HIP_MEMORY_SCOPE_AGENT)) >= want) break;
                if (__builtin_amdgcn_s_memrealtime() - t0 > 2000000ull) {
                    if (lane == 0) { unsigned expect = 0u; __hip_atomic_compare_exchange_strong(tmo + 1, &expect, code | (unsigned)(u.pm & 0xff), __ATOMIC_RELAXED, __ATOMIC_RELAXED, __HIP_MEMORY_SCOPE_AGENT);
                                     __hip_atomic_store(tmo, 1u, __ATOMIC_RELAXED, __HIP_MEMORY_SCOPE_AGENT); }
                    dead = true; break; }
                __builtin_amdgcn_s_sleep(2);
            }
            __builtin_amdgcn_fence(__ATOMIC_ACQUIRE, "agent");
            if (lane == 0) flag[0] = dead ? 1u : 0u;
        }
        asm volatile("s_waitcnt vmcnt(0) lgkmcnt(0)" ::: "memory"); __builtin_amdgcn_s_barrier(); asm volatile("" ::: "memory");
        const bool bad = flag[0] != 0u;
        if (lane < 32) {
            const unsigned long long* slot = (const unsigned long long*)xbuf + (size_t)(u.pm * BM + row) * 4; float mt[4], m2[4]; float ms = 0.f;
#pragma unroll
            for (int t = 0; t < 4; ++t) { if (t < ntn) { const unsigned long long w = __hip_atomic_load(slot + t, __ATOMIC_RELAXED, __HIP_MEMORY_SCOPE_AGENT); mt[t] = __uint_as_float((unsigned)w); m2[t] = __uint_as_float((unsigned)(w >> 32)); } else { mt[t] = 0.f; m2[t] = 0.f; } ms += mt[t]; }
            const float mean = ms / (float)ntn; float q = 0.f;
#pragma unroll
            for (int t = 0; t < 4; ++t) if (t < ntn) { const float dm = mt[t] - mean; q += m2[t] + 256.0f * dm * dm; }
            S[row] = (f32x2v){mean, 1.0f / sqrtf(q / (256.0f * (float)ntn) + eps)};
        }
        asm volatile("s_waitcnt lgkmcnt(0)" ::: "memory"); __builtin_amdgcn_s_barrier(); asm volatile("" ::: "memory");
        return bad;
    }
};
struct EpiLnRes {
    static constexpr bool PERM = false, AFTER_DRAIN = true;
    const float* base; float* out; int ldc; const float* bias; PanelStats st; unsigned poison;
    __device__ __forceinline__ void refuse(size_t i0, size_t stride, int M, int N) const { const float q = __builtin_nanf(""); for (size_t i = i0; i < (size_t)M * N; i += stride) out[(i / N) * ldc + i % N] = q;
        if (i0 == 0) { unsigned expect = 0u; __hip_atomic_compare_exchange_strong(st.tmo + 1, &expect, 0x7f0u, __ATOMIC_RELAXED, __ATOMIC_RELAXED, __HIP_MEMORY_SCOPE_AGENT); __hip_atomic_store(st.tmo, 1u, __ATOMIC_RELAXED, __HIP_MEMORY_SCOPE_AGENT); } }
    __device__ __forceinline__ void fused(f32x4 (&acc)[2][2][4][2], const Unit& u, int wr, int wc, int fr, int fq, PG8_LAS unsigned char* lds, int wid, int lane) const {
        typedef float f32x2v __attribute__((ext_vector_type(2)));
        const PG8_LAS f32x2v* S = (const PG8_LAS f32x2v*)(lds + 8192);
        const int col0 = u.pn * BM + wc * 32 + 4 * fq;
#pragma unroll
        for (int bj = 0; bj < 2; ++bj)
#pragma unroll
            for (int n = 0; n < 2; ++n) { const f32x4 bv = bias ? *(const f32x4*)(bias + col0 + bj * HALF + n * 16) : (f32x4){0.f, 0.f, 0.f, 0.f};
#pragma unroll
                for (int ai = 0; ai < 2; ++ai)
#pragma unroll
                    for (int m = 0; m < 4; ++m) acc[ai][bj][m][n] += bv; }
        const bool bad = st.run(acc, u, wr, wc, fr, fq, lds, wid, lane) || poison != 0u;
        const float qnan = __builtin_nanf("");
#pragma unroll
        for (int ai = 0; ai < 2; ++ai)
#pragma unroll
            for (int m = 0; m < 4; ++m) { const int r = ai * HALF + wr * 64 + m * 16 + fr; const f32x2v sr = S[r]; const size_t off = (size_t)(u.pm * BM + r) * ldc + col0;
#pragma unroll
                for (int bj = 0; bj < 2; ++bj)
#pragma unroll
                    for (int n = 0; n < 2; ++n) { const f32x4 bs = *(const f32x4*)(base + off + bj * HALF + n * 16); f32x4 o = bs + (acc[ai][bj][m][n] - sr.x) * sr.y;
                        if (bad) o = (f32x4){qnan, qnan, qnan, qnan}; *(f32x4*)(out + off + bj * HALF + n * 16) = o; }
                asm volatile("" ::: "memory"); }
    }
};
struct EpiLnResLn {
    static constexpr bool PERM = false, AFTER_DRAIN = true;
    const float* base; float* out; bf16_t* xn; int ldc; const float* bias; PanelStats st1, st2; unsigned poison;
    __device__ __forceinline__ void refuse(size_t i0, size_t stride, int M, int N) const { const float q = __builtin_nanf(""); for (size_t i = i0; i < (size_t)M * N; i += stride) { const size_t o = (i / N) * ldc + i % N; out[o] = q; xn[o] = (bf16_t)0x7fc0u; }
        if (i0 == 0) { unsigned expect = 0u; __hip_atomic_compare_exchange_strong(st1.tmo + 1, &expect, 0x7f0u, __ATOMIC_RELAXED, __ATOMIC_RELAXED, __HIP_MEMORY_SCOPE_AGENT); __hip_atomic_store(st1.tmo, 1u, __ATOMIC_RELAXED, __HIP_MEMORY_SCOPE_AGENT); } }
    __device__ __forceinline__ void fused(f32x4 (&acc)[2][2][4][2], const Unit& u, int wr, int wc, int fr, int fq, PG8_LAS unsigned char* lds, int wid, int lane) const {
        typedef float f32x2v __attribute__((ext_vector_type(2))); typedef unsigned u32x2v __attribute__((ext_vector_type(2)));
        const PG8_LAS f32x2v* S = (const PG8_LAS f32x2v*)(lds + 8192);
        const int col0 = u.pn * BM + wc * 32 + 4 * fq;
#pragma unroll
        for (int bj = 0; bj < 2; ++bj)
#pragma unroll
            for (int n = 0; n < 2; ++n) { const f32x4 bv = bias ? *(const f32x4*)(bias + col0 + bj * HALF + n * 16) : (f32x4){0.f, 0.f, 0.f, 0.f};
#pragma unroll
                for (int ai = 0; ai < 2; ++ai)
#pragma unroll
                    for (int m = 0; m < 4; ++m) acc[ai][bj][m][n] += bv; }
        bool bad = st1.run(acc, u, wr, wc, fr, fq, lds, wid, lane) || poison != 0u;
        const float qnan = __builtin_nanf("");
#pragma unroll
        for (int ai = 0; ai < 2; ++ai)
#pragma unroll
            for (int m = 0; m < 4; ++m) { const int r = ai * HALF + wr * 64 + m * 16 + fr; const f32x2v sr = S[r]; const size_t off = (size_t)(u.pm * BM + r) * ldc + col0;
#pragma unroll
                for (int bj = 0; bj < 2; ++bj)
#pragma unroll
                    for (int n = 0; n < 2; ++n) { const f32x4 bs = *(const f32x4*)(base + off + bj * HALF + n * 16); acc[ai][bj][m][n] = bs + (acc[ai][bj][m][n] - sr.x) * sr.y; }
                asm volatile("" : "+v"(acc[ai][0][m][0]), "+v"(acc[ai][0][m][1]), "+v"(acc[ai][1][m][0]), "+v"(acc[ai][1][m][1]));
                if (m & 1) asm volatile("" ::: "memory"); }
        const bool bad1 = bad;
        bad = st2.run(acc, u, wr, wc, fr, fq, lds, wid, lane) || bad;
#pragma unroll
        for (int ai = 0; ai < 2; ++ai)
#pragma unroll
            for (int m = 0; m < 4; ++m) { const int r = ai * HALF + wr * 64 + m * 16 + fr; const f32x2v sr = S[r]; const size_t off = (size_t)(u.pm * BM + r) * ldc + col0;
#pragma unroll
                for (int bj = 0; bj < 2; ++bj)
#pragma unroll
                    for (int n = 0; n < 2; ++n) { const f32x4 x1 = acc[ai][bj][m][n]; *(f32x4*)(out + off + bj * HALF + n * 16) = bad1 ? (f32x4){qnan, qnan, qnan, qnan} : x1;
                        const f32x4 o = (x1 - sr.x) * sr.y; u32x2v w; w.x = cvt_pk_bf16(o[0], o[1]); w.y = cvt_pk_bf16(o[2], o[3]);
                        if (bad) { w.x = 0x7fc07fc0u; w.y = 0x7fc07fc0u; } *(u32x2v*)(xn + off + bj * HALF + n * 16) = w; }
                asm volatile("" ::: "memory"); }
    }
};

template <class Epi, class Sched, bool STAMP = false>
__device__ __forceinline__ void gemm_phase(PG8_LAS unsigned char* lds, const Gemm g, const Sched& S, const Epi& E, unsigned long long* stamps) {
    int tid_l = threadIdx.x; asm volatile("" : "+v"(tid_l));
    const int tid = tid_l, wid = __builtin_amdgcn_readfirstlane(tid >> 6), lane = tid & 63, wr = wid >> 2, wc = wid & 3, fr = lane & 15, fq = lane >> 4;
    const int K = g.K, nt = K / BK;
    int ts_lo = 0, ts_hi = 0, nts = 0; const unsigned long long rt_entry = STAMP ? (unsigned long long)wall_clock64() : 0ull;
#define PG8_STAMP() do { if (STAMP && wid == 0 && nts < 64) { const unsigned long long _c = (unsigned long long)clock64(); \
        ts_lo = (lane == nts) ? (int)(unsigned)_c : ts_lo; ts_hi = (lane == nts) ? (int)(unsigned)(_c >> 32) : ts_hi; ++nts; } } while (0)
    PG8_STAMP();
    unsigned voffA[2], voffB[2];
#pragma unroll
    for (int i = 0; i < 2; ++i) { int R, C; stage_rc(tid * 16 + i * 8192, R, C); const int Rb = Epi::PERM ? ((R & ~31) + perm32(R & 31)) : R;
        voffA[i] = (unsigned)(R * K + C) * 2u; voffB[i] = (unsigned)(Rb * K + C) * 2u; }
    const size_t kstep = (size_t)(BK * 2);
    const size_t hstep = (size_t)HALF * K * 2;
    const size_t tstep = 2 * hstep;
    const unsigned ldsw = (unsigned)wid * 1024u;
    const int aoff = lds_byte(wr * 64 + fr, fq * 8), boff = lds_byte(wc * 32 + fr, fq * 8);
#define PG8_SA(b, h) (((b) * 2 + (h)) * HTB)
#define PG8_SB(b, h) ((4 + (b) * 2 + (h)) * HTB)
#define PG8_STAGE(bufoff, gbase, voff) do { _Pragma("unroll") for (int _i = 0; _i < 2; ++_i) \
        __builtin_amdgcn_global_load_lds((const unsigned*)((const char*)(gbase) + (voff)[_i]), (PG8_LAS unsigned*)(lds + (bufoff) + ldsw + _i * 8192), 16, 0, 0); } while (0)
#define PG8_LDA(dst, b, h) do { _Pragma("unroll") for (int m = 0; m < 4; ++m) _Pragma("unroll") for (int k = 0; k < 2; ++k) dst[m][k] = *(const PG8_LAS bf16x8*)(lds + PG8_SA(b, h) + aoff + m * 2048 + k * 1024); } while (0)
#define PG8_LDB(dst, b, h) do { _Pragma("unroll") for (int n = 0; n < 2; ++n) _Pragma("unroll") for (int k = 0; k < 2; ++k) dst[n][k] = *(const PG8_LAS bf16x8*)(lds + PG8_SB(b, h) + boff + n * 2048 + k * 1024); } while (0)
#define PG8_MMA(ai, bj, At, Bt) do { __builtin_amdgcn_s_setprio(1); _Pragma("unroll") for (int m = 0; m < 4; ++m) _Pragma("unroll") for (int n = 0; n < 2; ++n) _Pragma("unroll") for (int k = 0; k < 2; ++k) \
        acc[ai][bj][m][n] = __builtin_amdgcn_mfma_f32_16x16x32_bf16(Bt[n][k], At[m][k], acc[ai][bj][m][n], 0, 0, 0); __builtin_amdgcn_s_setprio(0); } while (0)
#define PG8_WAIT_V(n) asm volatile("s_waitcnt vmcnt(" #n ")" ::: "memory")
#define PG8_WAIT_L(n) asm volatile("s_waitcnt lgkmcnt(" #n ")" ::: "memory")
#define PG8_BAR __builtin_amdgcn_s_barrier()
#define PG8_SCHED __builtin_amdgcn_sched_barrier(0)
    Unit cur, nxt; int ui = 0;
    if (!S.next(0, cur)) return;
    f32x4 acc[2][2][4][2];
#pragma unroll
    for (int a = 0; a < 2; ++a)
#pragma unroll
        for (int b = 0; b < 2; ++b)
#pragma unroll
            for (int m = 0; m < 4; ++m)
#pragma unroll
                for (int n = 0; n < 2; ++n) acc[a][b][m][n] = (f32x4){0.f, 0.f, 0.f, 0.f};
    bf16x8 At[4][2], B0[2][2], B1[2][2];
    const char* cA = (const char*)g.A + (size_t)cur.pm * tstep; const char* cB = (const char*)g.Bt + (size_t)cur.pn * tstep;
    S.a_ready(cur);
    PG8_STAGE(PG8_SB(0, 0), cB, voffB); PG8_STAGE(PG8_SA(0, 0), cA, voffA); PG8_STAGE(PG8_SB(0, 1), cB + hstep, voffB); PG8_STAGE(PG8_SA(0, 1), cA + hstep, voffA);
    if (wr == 1) PG8_BAR;
    PG8_WAIT_V(4); PG8_BAR;
    PG8_STAGE(PG8_SB(1, 0), cB + kstep, voffB); PG8_STAGE(PG8_SA(1, 0), cA + kstep, voffA); PG8_STAGE(PG8_SB(1, 1), cB + hstep + kstep, voffB);
    PG8_WAIT_V(6); PG8_BAR;
    PG8_STAMP();
    for (;;) {
        const bool has_next = S.next(ui + 1, nxt);
        const char* nA = has_next ? (const char*)g.A + (size_t)nxt.pm * tstep : cA; const char* nB = has_next ? (const char*)g.Bt + (size_t)nxt.pn * tstep : cB;
        for (int t = 0; t < nt; t += 2) {
            const bool last = (t == nt - 2);
            const char* a1 = cA + (size_t)(t + 1) * kstep;
            const char* a2 = last ? nA : cA + (size_t)(t + 2) * kstep; const char* b2 = last ? nB : cB + (size_t)(t + 2) * kstep;
            const char* a3 = a2 + kstep; const char* b3 = b2 + kstep;
            if (last && has_next) S.a_ready(nxt);
            PG8_LDB(B0, 0, 0); PG8_SCHED; PG8_LDA(At, 0, 0); PG8_STAGE(PG8_SA(1, 1), a1 + hstep, voffA);
            PG8_WAIT_L(8); PG8_BAR; PG8_WAIT_L(0); PG8_MMA(0, 0, At, B0); PG8_BAR; PG8_SCHED;
            PG8_LDB(B1, 0, 1); PG8_STAGE(PG8_SB(0, 0), b2, voffB);
            PG8_BAR; PG8_WAIT_L(0); PG8_MMA(0, 1, At, B1); PG8_BAR;
            PG8_LDA(At, 0, 1); PG8_STAGE(PG8_SA(0, 0), a2, voffA);
            PG8_BAR; PG8_WAIT_L(0); PG8_MMA(1, 0, At, B0); PG8_BAR; PG8_SCHED;
            PG8_STAGE(PG8_SB(0, 1), b2 + hstep, voffB);
            PG8_WAIT_V(6); PG8_BAR; PG8_MMA(1, 1, At, B1); PG8_BAR;
            PG8_LDB(B0, 1, 0); PG8_SCHED; PG8_LDA(At, 1, 0); PG8_STAGE(PG8_SA(0, 1), a2 + hstep, voffA);
            PG8_WAIT_L(8); PG8_BAR; PG8_WAIT_L(0); PG8_MMA(0, 0, At, B0); PG8_BAR; PG8_SCHED;
            PG8_LDB(B1, 1, 1); PG8_STAGE(PG8_SB(1, 0), b3, voffB);
            PG8_BAR; PG8_WAIT_L(0); PG8_MMA(0, 1, At, B1); PG8_BAR;
            PG8_LDA(At, 1, 1); PG8_STAGE(PG8_SA(1, 0), a3, voffA);
            PG8_BAR; PG8_WAIT_L(0); PG8_MMA(1, 0, At, B0); PG8_BAR; PG8_SCHED;
            PG8_STAGE(PG8_SB(1, 1), b3 + hstep, voffB);
            PG8_WAIT_V(6); PG8_BAR; PG8_MMA(1, 1, At, B1); PG8_BAR;
        }
        PG8_STAMP();
        if constexpr (!Epi::AFTER_DRAIN) { E(acc, cur, wr, wc, fr, fq); S.done(cur); }
        PG8_STAMP();
        if (!has_next) break;
#pragma unroll
        for (int a = 0; a < 2; ++a)
#pragma unroll
            for (int b = 0; b < 2; ++b)
#pragma unroll
                for (int m = 0; m < 4; ++m)
#pragma unroll
                    for (int n = 0; n < 2; ++n) acc[a][b][m][n] = (f32x4){0.f, 0.f, 0.f, 0.f};
        cur = nxt; cA = nA; cB = nB; ++ui;
    }
    PG8_WAIT_V(0);
    if (wr == 0) PG8_BAR;
    PG8_BAR;
    if constexpr (Epi::AFTER_DRAIN) { E.fused(acc, cur, wr, wc, fr, fq, lds, wid, lane); S.done(cur); }
    PG8_STAMP();
    if (STAMP && wid == 0) { stamps[lane] = lane < nts ? (((unsigned long long)(unsigned)ts_hi << 32) | (unsigned)ts_lo) : 0ull;
        if (lane == 62) stamps[62] = rt_entry; if (lane == 63) stamps[63] = (unsigned long long)wall_clock64(); }
#undef PG8_STAMP
#undef PG8_SA
#undef PG8_SB
#undef PG8_STAGE
#undef PG8_LDA
#undef PG8_LDB
#undef PG8_MMA
#undef PG8_WAIT_V
#undef PG8_WAIT_L
#undef PG8_BAR
#undef PG8_SCHED
}
}

#include <hip/hip_cooperative_groups.h>
#include <cstdio>
namespace cg = cooperative_groups;

#define LAS __attribute__((address_space(3)))
typedef unsigned short bf16;
typedef float f32x4 __attribute__((ext_vector_type(4)));
typedef float f32x2 __attribute__((ext_vector_type(2)));
typedef short bf16x8 __attribute__((ext_vector_type(8)));
typedef unsigned u32x4 __attribute__((ext_vector_type(4)));
typedef unsigned u32x2 __attribute__((ext_vector_type(2)));

constexpr int D = 1024, ML = 32768, MC = 512, MT = 33280, SEQ = 16384, CTXL = 256, FF = 2816, LW = 1280;
constexpr int NMOD = 9216;
constexpr size_t MiB = 1u << 20;
constexpr size_t WS_MOD = 1 * MiB, WS_ROPE = 2 * MiB, WS_XC = 6 * MiB, WS_SUM = 8 * MiB, WS_CIN = 29 * MiB, WS_W = 40 * MiB;
constexpr size_t WS_HB = 206 * MiB, WS_YB = 271 * MiB, WS_BIG = 336 * MiB, WS_END = 531 * MiB;
constexpr size_t W1T_BYTES = 11 * MiB, W2T_BYTES = 5 * MiB + MiB / 2;
__host__ __device__ constexpr size_t off_w1t(int i, int f) { return WS_W + (size_t)(i * 2 + f) * W1T_BYTES; }
__host__ __device__ constexpr size_t off_w2t(int i, int f) { return WS_W + 88 * MiB + (size_t)(i * 2 + f) * W2T_BYTES; }
__host__ __device__ constexpr size_t off_na(int j) { return WS_W + 132 * MiB + (size_t)j * 8 * MiB; }
__host__ __device__ constexpr size_t off_lru(int j) { return WS_W + 148 * MiB + (size_t)j * 9 * MiB; }
constexpr size_t LRU_WOL = 5 * MiB, LRU_WG = 7 * MiB + MiB / 2;
constexpr size_t ACT_ELEMS = (size_t)MT * D;
constexpr int LDS_BYTES = 147456;

struct TJob { long long src_off; long long dst_off; int in_idx, map, ldn, ldk, nnt, tile0, ncol0, pad; };
constexpr int MAXJOBS = 44;
struct Args {
    const float* in[23];
    float* out;
    unsigned char* ws;
    int ph_lo, ph_hi, njobs, ntiles;
    unsigned pdesc[48];
    TJob jobs[MAXJOBS];
};

__device__ __forceinline__ float bf2f(unsigned short v) { return __uint_as_float((unsigned)v << 16); }
__device__ __forceinline__ unsigned pk2(float lo, float hi) { return pg8::cvt_pk_bf16(lo, hi); }
__device__ __forceinline__ float wave_sum(float v) {
#pragma unroll
    for (int o = 1; o < 64; o <<= 1) v += __shfl_xor(v, o);
    return v;
}
__device__ __forceinline__ float sigmoidf_(float v) { return 1.0f / (1.0f + __expf(-v)); }

struct EpiSwiGLU {
    static constexpr bool PERM = true, AFTER_DRAIN = false;
    bf16* O;
    __device__ __forceinline__ void operator()(const f32x4 (&acc)[2][2][4][2], const pg8::Unit& u, int wr, int wc, int fr, int fq) const {
        const int row0 = u.pm * 256 + wr * 64 + fr, colh = u.pn * 128 + wc * 16 + 4 * fq;
#pragma unroll
        for (int ai = 0; ai < 2; ++ai)
#pragma unroll
            for (int m = 0; m < 4; ++m) { bf16* rowp = O + (size_t)(row0 + ai * 128 + m * 16) * FF + colh;
#pragma unroll
                for (int bj = 0; bj < 2; ++bj) { const f32x4 g = acc[ai][bj][m][0], up = acc[ai][bj][m][1]; float o[4];
#pragma unroll
                    for (int e = 0; e < 4; ++e) o[e] = g[e] * sigmoidf_(g[e]) * up[e];
                    u32x2 w; w.x = pk2(o[0], o[1]); w.y = pk2(o[2], o[3]);
                    *(u32x2*)(rowp + bj * 64) = w; } }
    }
};
struct EpiRope {
    static constexpr bool PERM = true, AFTER_DRAIN = false;
    bf16* Q; bf16* K; const float* ctab; const float* stab;
    __device__ __forceinline__ void operator()(const f32x4 (&acc)[2][2][4][2], const pg8::Unit& u, int wr, int wc, int fr, int fq) const {
        const int row0 = u.pm * 256 + wr * 64 + fr;
        const int i = 4 * (wc & 1) + fq;
#pragma unroll
        for (int ai = 0; ai < 2; ++ai)
#pragma unroll
            for (int m = 0; m < 4; ++m) {
                const int row = row0 + ai * 128 + m * 16;
                f32x4 cs = (f32x4){1.f, 1.f, 1.f, 1.f}, sn = (f32x4){0.f, 0.f, 0.f, 0.f};
                if (row < ML) { const int t = row & (SEQ - 1); cs = *(const f32x4*)(ctab + t * 32 + 4 * i); sn = *(const f32x4*)(stab + t * 32 + 4 * i); }
#pragma unroll
                for (int bj = 0; bj < 2; ++bj) {
                    const int c = u.pn * 256 + bj * 128 + wc * 32;
                    const bool isk = c >= 1024; const int head = (c & 1023) >> 6;
                    const float sc = isk ? 1.0f : 0.125f;
                    bf16* dst = (isk ? K : Q) + (size_t)row * D + head * 64 + 4 * i;
                    const f32x4 x1 = acc[ai][bj][m][0], x2 = acc[ai][bj][m][1];
                    const f32x4 o1 = (x1 * cs - x2 * sn) * sc, o2 = (x1 * sn + x2 * cs) * sc;
                    u32x2 w1, w2; w1.x = pk2(o1[0], o1[1]); w1.y = pk2(o1[2], o1[3]); w2.x = pk2(o2[0], o2[1]); w2.y = pk2(o2[2], o2[3]);
                    *(u32x2*)dst = w1; *(u32x2*)(dst + 32) = w2; } }
    }
};
struct EpiGeluSplit {
    static constexpr bool PERM = true, AFTER_DRAIN = false;
    bf16* G; bf16* V;
    __device__ __forceinline__ void operator()(const f32x4 (&acc)[2][2][4][2], const pg8::Unit& u, int wr, int wc, int fr, int fq) const {
        const int row0 = u.pm * 256 + wr * 64 + fr; const bool isg = u.pn < 5;
        const int col0 = (isg ? u.pn * 256 : u.pn * 256 - LW) + wc * 32 + 8 * fq;
        bf16* base = isg ? G : V;
#pragma unroll
        for (int ai = 0; ai < 2; ++ai)
#pragma unroll
            for (int m = 0; m < 4; ++m) { bf16* rowp = base + (size_t)(row0 + ai * 128 + m * 16) * LW + col0;
#pragma unroll
                for (int bj = 0; bj < 2; ++bj) { f32x4 v0 = acc[ai][bj][m][0], v1 = acc[ai][bj][m][1];
                    if (isg) {
#pragma unroll
                        for (int e = 0; e < 4; ++e) { const float a = v0[e], b = v1[e];
                            v0[e] = a * sigmoidf_(1.5957691216f * (a + 0.044715f * a * a * a));
                            v1[e] = b * sigmoidf_(1.5957691216f * (b + 0.044715f * b * b * b)); } }
                    u32x4 w; w.x = pk2(v0[0], v0[1]); w.y = pk2(v0[2], v0[3]); w.z = pk2(v1[0], v1[1]); w.w = pk2(v1[2], v1[3]);
                    *(u32x4*)(rowp + bj * 128) = w; } }
    }
};

template <class Epi>
__device__ __forceinline__ void run_gemm(LAS unsigned char* lds, const bf16* A, const bf16* Bt, int Mg, int Ng, int K, const Epi& E) {
    int bid = blockIdx.x, gsz = gridDim.x; asm volatile("" : "+s"(bid), "+s"(gsz));
    pg8::Gemm g{A, Bt, Mg, Ng, K}; pg8::StaticOrder S; S.init(Mg, Ng, gsz, bid);
    pg8::gemm_phase<Epi, pg8::StaticOrder, false>(lds, g, S, E, nullptr);
}

__device__ __forceinline__ const float* pick_in(const Args& a, const int z, int idx) {
    const float* p = a.in[8 + z];
    p = idx == 9 ? a.in[9 + z] : p; p = idx == 10 ? a.in[10 + z] : p; p = idx == 11 ? a.in[11 + z] : p; p = idx == 12 ? a.in[12 + z] : p;
    p = idx == 14 ? a.in[14 + z] : p; p = idx == 17 ? a.in[17 + z] : p; p = idx == 19 ? a.in[19 + z] : p; p = idx == 22 ? a.in[22 + z] : p;
    return p;
}
__device__ __forceinline__ int map_row(int map, int n) {
    if (map == 1) return 8 * (n >> 2) + (n & 3);
    if (map == 2) return 8 * (n >> 2) + 4 + (n & 3);
    if (map == 3) { const int hc = n >> 6, d = n & 63; return 64 * hc + 8 * ((d & 31) >> 2) + 4 * (d >> 5) + (d & 3); }
    return n;
}
__device__ __forceinline__ void prep_phase(const Args& a, const int z, LAS unsigned char* lds) {
    int tid_ = threadIdx.x; asm volatile("" : "+v"(tid_));
    const int tid = tid_, wave = __builtin_amdgcn_readfirstlane(tid >> 6), lane = tid & 63;
    float* MOD = (float*)((a.ws + z) + WS_MOD);
    LAS float* sc = (LAS float*)lds;
    LAS float* red = (LAS float*)(lds + 16384);
    bool have_sc = false;
    for (int it = blockIdx.x; it < 144; it += gridDim.x) {
        if (!have_sc) {
            for (int e = tid; e < 3 * D; e += 512) { const int r = e >> 10, k = e & 1023; const float v = r < 2 ? a.in[1 + z][r * D + k] : a.in[3 + z][k]; sc[e] = v * sigmoidf_(v); }
            have_sc = true; __syncthreads();
        }
        const int layer = it / 36, cg0 = (it % 36) * 256;
        const float* W = a.in[4 + z] + (size_t)layer * D * NMOD + cg0 + 4 * lane;
        f32x4 acc0 = (f32x4){0.f, 0.f, 0.f, 0.f}, acc1 = acc0, acc2 = acc0;
        const int kb = wave * 128;
        for (int k0 = 0; k0 < 128; k0 += 8) {
            f32x4 w[8];
#pragma unroll
            for (int e = 0; e < 8; ++e) w[e] = *(const f32x4*)(W + (size_t)(kb + k0 + e) * NMOD);
#pragma unroll
            for (int e = 0; e < 8; ++e) { const float s0 = sc[kb + k0 + e], s1 = sc[D + kb + k0 + e], s2 = sc[2 * D + kb + k0 + e];
                acc0 += w[e] * s0; acc1 += w[e] * s1; acc2 += w[e] * s2; }
        }
        *(LAS f32x4*)(red + (wave * 3 + 0) * 256 + 4 * lane) = acc0;
        *(LAS f32x4*)(red + (wave * 3 + 1) * 256 + 4 * lane) = acc1;
        *(LAS f32x4*)(red + (wave * 3 + 2) * 256 + 4 * lane) = acc2;
        __syncthreads();
        for (int e = tid; e < 768; e += 512) { const int r = e >> 8, c = e & 255; float s = 0.f;
#pragma unroll
            for (int w8 = 0; w8 < 8; ++w8) s += red[(w8 * 3 + r) * 256 + c];
            MOD[(size_t)(layer * 3 + r) * NMOD + cg0 + c] = s + a.in[5 + z][layer * NMOD + cg0 + c]; }
        __syncthreads();
    }
    {
        float* ctab = (float*)((a.ws + z) + WS_ROPE); float* stab = ctab + SEQ * 32;
        for (int e = blockIdx.x * 512 + tid; e < SEQ * 32; e += gridDim.x * 512) {
            const int t = e >> 5, p = e & 31; const float pos = (float)(p < 16 ? (t >> 6) : (t & 63));
            const float invf = powf(10000.0f, -(float)(p & 15) / 16.0f); const float ang = pos * invf;
            ctab[e] = cosf(ang); stab[e] = sinf(ang); }
    }
    __syncthreads();
    LAS float* T = (LAS float*)(lds + 65536);
    for (int tile = blockIdx.x; tile < a.ntiles; tile += gridDim.x) {
        int jx = 0;
        for (int q = 1; q < a.njobs; ++q) jx = (tile >= a.jobs[q].tile0) ? q : jx;
        const TJob jb = a.jobs[jx];
        const int local = tile - jb.tile0, kt = local / jb.nnt, nt = local % jb.nnt, k0 = kt * 64, n0 = nt * 64;
        const float* src = pick_in(a, z, jb.in_idx) + jb.src_off;
        bf16* dst = (bf16*)((a.ws + z) + jb.dst_off);
        { const int kk = tid >> 3, ns = (tid & 7) * 8; const float* p = src + (size_t)(k0 + kk) * jb.ldn + jb.ncol0 + n0 + ns;
          const f32x4 v0 = *(const f32x4*)p, v1 = *(const f32x4*)(p + 4);
          LAS float* t = T + kk * 65 + ns; t[0] = v0[0]; t[1] = v0[1]; t[2] = v0[2]; t[3] = v0[3]; t[4] = v1[0]; t[5] = v1[1]; t[6] = v1[2]; t[7] = v1[3]; }
        __syncthreads();
        { const int nl = tid >> 3, ks = (tid & 7) * 8; const LAS float* t = T + ks * 65 + nl;
          u32x4 o; o.x = pk2(t[0], t[65]); o.y = pk2(t[2 * 65], t[3 * 65]); o.z = pk2(t[4 * 65], t[5 * 65]); o.w = pk2(t[6 * 65], t[7 * 65]);
          size_t drow, dcol;
          if (jb.map == 4) { drow = (size_t)((k0 >> 7) * 128 + n0 + nl); dcol = (size_t)((k0 & 127) + ks); }
          else { drow = (size_t)map_row(jb.map, n0 + nl); dcol = (size_t)(k0 + ks); }
          *(u32x4*)(dst + drow * jb.ldk + dcol) = o; }
        __syncthreads();
    }
}

__device__ __forceinline__ void norm_phase(const Args& a, const int z, int res_l, int res_s, float res_w, int pre_l, int pre_s) {
    int tid_ = threadIdx.x; asm volatile("" : "+v"(tid_));
    const int tid = tid_, wave = __builtin_amdgcn_readfirstlane(tid >> 6), lane = tid & 63;
    const int gw = blockIdx.x * 8 + wave, NGW = gridDim.x * 8;
    const float* MOD = (const float*)((a.ws + z) + WS_MOD);
    float* XC = (float*)((a.ws + z) + WS_XC);
    const bf16* YB = (const bf16*)((a.ws + z) + WS_YB);
    bf16* HB = (bf16*)((a.ws + z) + WS_HB);
    const bool first = res_l < 0, has_pre = pre_l >= 0;
    for (int row = gw; row < MT; row += NGW) {
        const int r = row < SEQ ? 0 : (row < ML ? 1 : 2);
        const float* xs = first ? (row < ML ? a.in[0 + z] + (size_t)row * D : a.in[2 + z] + (size_t)(row - ML) * D)
                                : (row < ML ? (a.out + z) + (size_t)row * D : XC + (size_t)(row - ML) * D);
        float* xd = row < ML ? (a.out + z) + (size_t)row * D : XC + (size_t)(row - ML) * D;
        f32x4 xv[4];
#pragma unroll
        for (int j = 0; j < 4; ++j) xv[j] = *(const f32x4*)(xs + j * 256 + 4 * lane);
        if (!first) {
            f32x4 yv[4]; float ss = 0.f;
#pragma unroll
            for (int j = 0; j < 4; ++j) { const u32x2 w = *(const u32x2*)(YB + (size_t)row * D + j * 256 + 4 * lane);
                yv[j] = (f32x4){__uint_as_float(w.x << 16), __uint_as_float(w.x & 0xffff0000u), __uint_as_float(w.y << 16), __uint_as_float(w.y & 0xffff0000u)};
                ss += (yv[j][0] * yv[j][0] + yv[j][1] * yv[j][1]) + (yv[j][2] * yv[j][2] + yv[j][3] * yv[j][3]); }
            const float rstd = rsqrtf(wave_sum(ss) * (1.0f / D) + 1e-6f) * res_w;
            const float* gate = MOD + (size_t)(res_l * 3 + r) * NMOD + (3 * res_s + 2) * D;
            const float* gpost = a.in[7 + z] + (size_t)(res_l * 3 + res_s) * D;
#pragma unroll
            for (int j = 0; j < 4; ++j) { const f32x4 gt = *(const f32x4*)(gate + j * 256 + 4 * lane), gp = *(const f32x4*)(gpost + j * 256 + 4 * lane);
                xv[j] += gt * gp * yv[j] * rstd; }
        }
#pragma unroll
        for (int j = 0; j < 4; ++j) *(f32x4*)(xd + j * 256 + 4 * lane) = xv[j];
        if (has_pre) {
            float ss = 0.f;
#pragma unroll
            for (int j = 0; j < 4; ++j) ss += (xv[j][0] * xv[j][0] + xv[j][1] * xv[j][1]) + (xv[j][2] * xv[j][2] + xv[j][3] * xv[j][3]);
            const float rstd = rsqrtf(wave_sum(ss) * (1.0f / D) + 1e-6f);
            const float* mb = MOD + (size_t)(pre_l * 3 + r) * NMOD + (3 * pre_s) * D;
            const float* gpre = a.in[6 + z] + (size_t)(pre_l * 3 + pre_s) * D;
#pragma unroll
            for (int j = 0; j < 4; ++j) { const f32x4 sh = *(const f32x4*)(mb + j * 256 + 4 * lane), scl = *(const f32x4*)(mb + D + j * 256 + 4 * lane), gp = *(const f32x4*)(gpre + j * 256 + 4 * lane);
                const f32x4 h = xv[j] * rstd * gp * (scl + 1.0f) + sh;
                u32x2 w; w.x = pk2(h[0], h[1]); w.y = pk2(h[2], h[3]);
                *(u32x2*)(HB + (size_t)row * D + j * 256 + 4 * lane) = w; }
        }
    }
}

struct KVFrag { bf16x8 k[2][2]; bf16x8 v[4]; };
__device__ __forceinline__ void attn_load(KVFrag& f, const bf16* Kb, const bf16* Vt, int T0, int krow, int h, int fr, int g) {
    const bf16* kp = Kb + (size_t)(T0 + krow) * D + h * 64 + g * 8;
#pragma unroll
    for (int t = 0; t < 2; ++t)
#pragma unroll
        for (int ks = 0; ks < 2; ++ks) f.k[t][ks] = *(const bf16x8*)(kp + (size_t)(4 * t) * D + ks * 32);
    const bf16* vp = Vt + (size_t)(h * 64 + fr) * MT + T0 + g * 8;
#pragma unroll
    for (int dt = 0; dt < 4; ++dt) f.v[dt] = *(const bf16x8*)(vp + (size_t)(dt * 16) * MT);
}
__device__ __forceinline__ void attn_phase(const Args& a, const int z, int j) {
    int tid_ = threadIdx.x; asm volatile("" : "+v"(tid_));
    const int tid = tid_, wave = __builtin_amdgcn_readfirstlane(tid >> 6), lane = tid & 63, fr = lane & 15, g = lane >> 4;
    const int gw = blockIdx.x * 8 + wave, NGW = gridDim.x * 8;
    bf16* Q = (bf16*)((a.ws + z) + WS_BIG); const bf16* Kb = Q + ACT_ELEMS; const bf16* Vt = Q + 2 * ACT_ELEMS;
    const float* rpb = a.in[13 + z] + (size_t)j * 16 * 15 * 31;
    const int krow = (fr >> 2) * 8 + (fr & 3);
    for (int it = gw; it < MT; it += NGW) {
        int h, b, r = 0, cq = 0, qrow0, nl;
        if (it < ML) { h = it & 15; cq = (it >> 4) & 3; r = (it >> 6) & 255; b = it >> 14; qrow0 = b * SEQ + r * 64 + cq * 16; nl = 8; }
        else { const int k = it - ML; h = k & 15; const int qg = (k >> 4) & 15; b = k >> 8; qrow0 = ML + b * CTXL + qg * 16; nl = 0; }
        const int r0 = min(max(r - 4, 0), 248);
        const int cw = cq == 0 ? 0 : (cq == 1 ? 8 : (cq == 2 ? 24 : 32));
        const int nch = nl + 8;
        const int cqq = cq * 16 + fr, c0 = min(max(cqq - 8, 0), 48);
        bf16* qp = Q + (size_t)(qrow0 + fr) * D + h * 64;
        const bf16x8 qb0 = *(const bf16x8*)(qp + g * 8), qb1 = *(const bf16x8*)(qp + 32 + g * 8);
        f32x4 o[4];
#pragma unroll
        for (int dt = 0; dt < 4; ++dt) o[dt] = (f32x4){0.f, 0.f, 0.f, 0.f};
        float mrun = -1e30f, lrun = 0.f;
        KVFrag cur, nxt;
        { const int T0 = nl ? (b * SEQ + r0 * 64 + cw) : (ML + b * CTXL); attn_load(cur, Kb, Vt, T0, krow, h, fr, g); }
        for (int ci = 0; ci < nch; ++ci) {
            if (ci + 1 < nch) { const int cn = ci + 1; const int T0 = cn < nl ? (b * SEQ + (r0 + cn) * 64 + cw) : (ML + b * CTXL + (cn - nl) * 32); attn_load(nxt, Kb, Vt, T0, krow, h, fr, g); }
            f32x4 s0 = (f32x4){0.f, 0.f, 0.f, 0.f}, s1 = s0;
            s0 = __builtin_amdgcn_mfma_f32_16x16x32_bf16(cur.k[0][0], qb0, s0, 0, 0, 0);
            s0 = __builtin_amdgcn_mfma_f32_16x16x32_bf16(cur.k[0][1], qb1, s0, 0, 0, 0);
            s1 = __builtin_amdgcn_mfma_f32_16x16x32_bf16(cur.k[1][0], qb0, s1, 0, 0, 0);
            s1 = __builtin_amdgcn_mfma_f32_16x16x32_bf16(cur.k[1][1], qb1, s1, 0, 0, 0);
            float s[8] = {s0[0], s0[1], s0[2], s0[3], s1[0], s1[1], s1[2], s1[3]};
            if (ci < nl) {
                const int dr = r0 + ci - r + 7;
                const float* bp = rpb + (h * 15 + dr) * 31;
#pragma unroll
                for (int e = 0; e < 8; ++e) { const int kc = cw + g * 8 + e; const int rel = kc - c0; const int dc = min(max(kc - cqq + 15, 0), 30);
                    const float bv = bp[dc]; s[e] = (rel >= 0 && rel < 16) ? s[e] + bv : -1e30f; }
            }
            float cm = fmaxf(fmaxf(fmaxf(s[0], s[1]), fmaxf(s[2], s[3])), fmaxf(fmaxf(s[4], s[5]), fmaxf(s[6], s[7])));
            cm = fmaxf(cm, __shfl_xor(cm, 16)); cm = fmaxf(cm, __shfl_xor(cm, 32));
            const float mnew = fmaxf(mrun, cm); const float alpha = __expf(mrun - mnew);
            float ps = 0.f;
#pragma unroll
            for (int e = 0; e < 8; ++e) { s[e] = __expf(s[e] - mnew); ps += s[e]; }
            ps += __shfl_xor(ps, 16); ps += __shfl_xor(ps, 32);
            lrun = lrun * alpha + ps; mrun = mnew;
            union { u32x4 u; bf16x8 v; } pb;
            pb.u.x = pk2(s[0], s[1]); pb.u.y = pk2(s[2], s[3]); pb.u.z = pk2(s[4], s[5]); pb.u.w = pk2(s[6], s[7]);
#pragma unroll
            for (int dt = 0; dt < 4; ++dt) { o[dt] = o[dt] * alpha; o[dt] = __builtin_amdgcn_mfma_f32_16x16x32_bf16(cur.v[dt], pb.v, o[dt], 0, 0, 0); }
            cur = nxt;
        }
        const float inv = 1.0f / lrun;
#pragma unroll
        for (int dt = 0; dt < 4; ++dt) { u32x2 w; w.x = pk2(o[dt][0] * inv, o[dt][1] * inv); w.y = pk2(o[dt][2] * inv, o[dt][3] * inv);
            *(u32x2*)(qp + dt * 16 + g * 4) = w; }
    }
}

constexpr int UP = 132;
constexpr int L_U32 = 0, L_UB = 16896, L_LA = 25600, L_LB = 59392;
template <bool FINAL>
__device__ __forceinline__ void lru_chunk_phase(const Args& a, const int z, int j, LAS unsigned char* lds) {
    int tid_ = threadIdx.x; asm volatile("" : "+v"(tid_));
    const int tid = tid_, wave = __builtin_amdgcn_readfirstlane(tid >> 6), lane = tid & 63, fr = lane & 15, g = lane >> 4;
    bf16* G = (bf16*)((a.ws + z) + WS_BIG); const bf16* V = G + (size_t)MT * LW;
    const bf16* Wg = (const bf16*)((a.ws + z) + off_lru(j) + LRU_WG);
    const float* convw = a.in[15 + z] + (size_t)j * 4 * LW; const float* convb = a.in[16 + z] + (size_t)j * LW;
    const float* b_a = a.in[18 + z] + (size_t)j * 2 * LW; const float* b_x = a.in[20 + z] + (size_t)j * 2 * LW; const float* lam = a.in[21 + z] + (size_t)j * 2 * LW;
    f32x2* SUM = (f32x2*)((a.ws + z) + WS_SUM); float* CIN = (float*)((a.ws + z) + WS_CIN);
    LAS float* U32 = (LAS float*)(lds + L_U32); LAS bf16* UB = (LAS bf16*)(lds + L_UB);
    LAS float* LA = (LAS float*)(lds + L_LA); LAS float* LB = (LAS float*)(lds + L_LB);
    for (int task = blockIdx.x; task < 10400; task += gridDim.x) {
        const int c = task / 10, n = task % 10, m0 = c * 32;
        int seq_lo, seq_hi;
        if (m0 < ML) { seq_lo = (m0 / SEQ) * SEQ; seq_hi = seq_lo + SEQ; } else { seq_lo = ML + ((m0 - ML) / CTXL) * CTXL; seq_hi = seq_lo + CTXL; }
        { const int tok = tid >> 4, ch8 = (tid & 15) * 8, mrow = m0 + tok, gch = n * 128 + ch8;
          float u[8];
          { const f32x4 b0 = *(const f32x4*)(convb + gch), b1 = *(const f32x4*)(convb + gch + 4);
            u[0] = b0[0]; u[1] = b0[1]; u[2] = b0[2]; u[3] = b0[3]; u[4] = b1[0]; u[5] = b1[1]; u[6] = b1[2]; u[7] = b1[3]; }
#pragma unroll
          for (int tap = 0; tap < 4; ++tap) { const int mr = mrow + tap - 2;
              if (mr >= seq_lo && mr < seq_hi) {
                  const u32x4 vv = *(const u32x4*)(V + (size_t)mr * LW + gch);
                  const f32x4 w0 = *(const f32x4*)(convw + tap * LW + gch), w1 = *(const f32x4*)(convw + tap * LW + gch + 4);
                  u[0] += w0[0] * __uint_as_float(vv.x << 16); u[1] += w0[1] * __uint_as_float(vv.x & 0xffff0000u);
                  u[2] += w0[2] * __uint_as_float(vv.y << 16); u[3] += w0[3] * __uint_as_float(vv.y & 0xffff0000u);
                  u[4] += w1[0] * __uint_as_float(vv.z << 16); u[5] += w1[1] * __uint_as_float(vv.z & 0xffff0000u);
                  u[6] += w1[2] * __uint_as_float(vv.w << 16); u[7] += w1[3] * __uint_as_float(vv.w & 0xffff0000u); } }
          *(LAS f32x4*)(U32 + tok * UP + ch8) = (f32x4){u[0], u[1], u[2], u[3]};
          *(LAS f32x4*)(U32 + tok * UP + ch8 + 4) = (f32x4){u[4], u[5], u[6], u[7]};
          u32x4 w; w.x = pk2(u[0], u[1]); w.y = pk2(u[2], u[3]); w.z = pk2(u[4], u[5]); w.w = pk2(u[6], u[7]);
          *(LAS u32x4*)(UB + tok * 136 + ch8) = w; }
        __syncthreads();
        const int ct = wave, ch = ct * 16 + fr, gch1 = n * 128 + ch;
        f32x4 acc[2][4];
#pragma unroll
        for (int rt = 0; rt < 2; ++rt)
#pragma unroll
            for (int cb = 0; cb < 4; ++cb) acc[rt][cb] = (f32x4){0.f, 0.f, 0.f, 0.f};
#pragma unroll
        for (int ks = 0; ks < 4; ++ks) {
            bf16x8 af[2];
#pragma unroll
            for (int rt = 0; rt < 2; ++rt) af[rt] = *(const LAS bf16x8*)(UB + (rt * 16 + fr) * 136 + ks * 32 + g * 8);
#pragma unroll
            for (int cb = 0; cb < 4; ++cb) {
                const bf16x8 bfg = *(const bf16x8*)(Wg + ((size_t)(cb * 10 + n) * 128 + ch) * 128 + ks * 32 + g * 8);
#pragma unroll
                for (int rt = 0; rt < 2; ++rt) acc[rt][cb] = __builtin_amdgcn_mfma_f32_16x16x32_bf16(af[rt], bfg, acc[rt][cb], 0, 0, 0);
            }
        }
#pragma unroll
        for (int dir = 0; dir < 2; ++dir) {
            const float ba = b_a[dir * LW + gch1], bx = b_x[dir * LW + gch1], lm = lam[dir * LW + gch1];
            const float sp = log1pf(__expf(-lm));
#pragma unroll
            for (int rt = 0; rt < 2; ++rt)
#pragma unroll
                for (int jj = 0; jj < 4; ++jj) { const int tok = rt * 16 + g * 4 + jj;
                    const float rg = sigmoidf_(acc[rt][dir * 2][jj] + ba), ig = sigmoidf_(acc[rt][dir * 2 + 1][jj] + bx);
                    const float la = -8.0f * rg * sp; const float av = __expf(la);
                    const float bv = sqrtf(fmaxf(-expm1f(2.0f * la), 0.f)) * ig * U32[tok * UP + ch];
                    LA[(dir * 32 + tok) * UP + ch] = av; LB[(dir * 32 + tok) * UP + ch] = bv; }
        }
        __syncthreads();
        if (tid < 256) { const int dir = tid >> 7, chs = tid & 127; const size_t sidx = (size_t)(c * 2 + dir) * LW + n * 128 + chs;
            float Hh = FINAL ? CIN[sidx] : 0.f, Ap = 1.f;
#pragma unroll 8
            for (int s = 0; s < 32; ++s) { const int t = dir ? 31 - s : s; const float av = LA[(dir * 32 + t) * UP + chs], bv = LB[(dir * 32 + t) * UP + chs];
                Hh = av * Hh + bv; if (FINAL) LB[(dir * 32 + t) * UP + chs] = Hh; else Ap *= av; }
            if (!FINAL) SUM[sidx] = (f32x2){Ap, Hh};
        }
        if (FINAL) {
            __syncthreads();
            const int tok = tid >> 4, ch8 = (tid & 15) * 8; bf16* gp = G + (size_t)(m0 + tok) * LW + n * 128 + ch8;
            const u32x4 gv = *(const u32x4*)gp;
            const f32x4 h0 = *(const LAS f32x4*)(LB + tok * UP + ch8) + *(const LAS f32x4*)(LB + (32 + tok) * UP + ch8);
            const f32x4 h1 = *(const LAS f32x4*)(LB + tok * UP + ch8 + 4) + *(const LAS f32x4*)(LB + (32 + tok) * UP + ch8 + 4);
            u32x4 w;
            w.x = pk2(h0[0] * __uint_as_float(gv.x << 16), h0[1] * __uint_as_float(gv.x & 0xffff0000u));
            w.y = pk2(h0[2] * __uint_as_float(gv.y << 16), h0[3] * __uint_as_float(gv.y & 0xffff0000u));
            w.z = pk2(h1[0] * __uint_as_float(gv.z << 16), h1[1] * __uint_as_float(gv.z & 0xffff0000u));
            w.w = pk2(h1[2] * __uint_as_float(gv.w << 16), h1[3] * __uint_as_float(gv.w & 0xffff0000u));
            *(u32x4*)gp = w;
        }
        __syncthreads();
    }
}
__device__ __forceinline__ void lru_carry_phase(const Args& a, const int z) {
    int tid_ = threadIdx.x; asm volatile("" : "+v"(tid_));
    const int tid = tid_;
    if (tid >= 64 || blockIdx.x >= 80) return;
    const int chain = blockIdx.x * 64 + tid, b = chain / 2560, dir = (chain / LW) & 1, ch = chain % LW;
    const f32x2* SUM = (const f32x2*)((a.ws + z) + WS_SUM); float* CIN = (float*)((a.ws + z) + WS_CIN);
    float Hh = 0.f;
    for (int s0 = 0; s0 < 520; s0 += 8) {
        f32x2 v[8]; size_t idx[8];
#pragma unroll
        for (int e = 0; e < 8; ++e) { const int s = s0 + e; int c;
            if (s < 8) c = 1024 + b * 8 + (dir ? 7 - s : s); else { const int li = s - 8; c = b * 512 + (dir ? 511 - li : li); }
            idx[e] = (size_t)(c * 2 + dir) * LW + ch; v[e] = SUM[idx[e]]; }
#pragma unroll
        for (int e = 0; e < 8; ++e) { CIN[idx[e]] = Hh; Hh = v[e][0] * Hh + v[e][1]; }
    }
}


#ifndef EN_MASK
#define EN_MASK 0xffff
#endif
#define EN(t) ((EN_MASK >> (t)) & 1)
enum { PT_PREP = 0, PT_NORM = 1, PT_G1 = 2, PT_PLAIN = 3, PT_QK = 4, PT_ATT = 5, PT_IN = 6, PT_L2 = 7, PT_L3 = 8, PT_L4 = 9 };
__global__ void __launch_bounds__(512, 2) mega_fwd(Args a) {
    extern __shared__ __attribute__((aligned(16))) unsigned char lds_raw[];
    LAS unsigned char* lds = (LAS unsigned char*)lds_raw;
    cg::grid_group grid = cg::this_grid();
    for (int ph = a.ph_lo; ph < a.ph_hi; ++ph) {
        int z; asm volatile("s_mov_b32 %0, 0" : "=s"(z));
        bf16* HB = (bf16*)((a.ws + z) + WS_HB); bf16* YB = (bf16*)((a.ws + z) + WS_YB); bf16* BIG = (bf16*)((a.ws + z) + WS_BIG);
        const unsigned pd = a.pdesc[ph + z];
        const int type = pd & 0xff, i = (pd >> 8) & 0xff, s = (pd >> 16) & 0xff, sub = (pd >> 24) & 0xff, j = i >> 1;
        if (type == PT_PREP && EN(PT_PREP)) prep_phase(a, z, lds);
        else if (type == PT_NORM && EN(PT_NORM)) {
            int res_l = (s > 0) ? i : i - 1, res_s = (s > 0) ? s - 1 : 2;
            const float res_w = (res_s == 1) ? 1.0f : 0.5f;
            norm_phase(a, z, res_l, res_s, res_w, i < 4 ? i : -1, s);
        } else if (type == PT_G1 && EN(PT_G1)) {
            const bf16* W1t = (const bf16*)((a.ws + z) + WS_W) + (size_t)(i * 2 + (s >> 1)) * (W1T_BYTES / 2);
            EpiSwiGLU E{BIG}; run_gemm(lds, HB, W1t, MT, 2 * FF, D, E);
        } else if (type == PT_PLAIN && EN(PT_PLAIN)) {
            const bf16* A = BIG; const bf16* Bt; int Mg = MT, Ng = D, K; bf16* O = YB; int ldc = D;
            if (sub == 0) { Bt = (const bf16*)((a.ws + z) + WS_W + 88 * MiB) + (size_t)(i * 2 + (s >> 1)) * (W2T_BYTES / 2); K = FF; }
            else if (sub == 1) { Bt = (const bf16*)((a.ws + z) + WS_W + 132 * MiB) + (size_t)j * (4 * MiB) + 3 * MiB; K = D; }
            else if (sub == 2) { Bt = (const bf16*)((a.ws + z) + WS_W + 148 * MiB) + (size_t)j * (9 * MiB / 2) + LRU_WOL / 2; K = LW; }
            else { A = (const bf16*)((a.ws + z) + WS_W + 132 * MiB) + (size_t)j * (4 * MiB) + 2 * MiB; Bt = HB; Mg = D; Ng = MT; K = D; O = BIG + 2 * ACT_ELEMS; ldc = MT; }
            pg8::EpiBf16<0> E{O, ldc, nullptr, 0, 0}; run_gemm(lds, A, Bt, Mg, Ng, K, E);
        } else if (type == PT_QK && EN(PT_QK)) {
            const bf16* Wn = (const bf16*)((a.ws + z) + WS_W + 132 * MiB) + (size_t)j * (4 * MiB);
            EpiRope E{BIG, BIG + ACT_ELEMS, (const float*)((a.ws + z) + WS_ROPE), (const float*)((a.ws + z) + WS_ROPE) + SEQ * 32};
            run_gemm(lds, HB, Wn, MT, 2048, D, E);
        } else if (type == PT_ATT && EN(PT_ATT)) attn_phase(a, z, j);
        else if (type == PT_IN && EN(PT_IN)) {
            const bf16* Wl = (const bf16*)((a.ws + z) + WS_W + 148 * MiB) + (size_t)j * (9 * MiB / 2);
            EpiGeluSplit E{BIG, BIG + (size_t)MT * LW}; run_gemm(lds, HB, Wl, MT, 2 * LW, D, E);
        } else if (type == PT_L2 && EN(PT_L2)) lru_chunk_phase<false>(a, z, j, lds);
        else if (type == PT_L3 && EN(PT_L3)) lru_carry_phase(a, z);
        else if (type == PT_L4 && EN(PT_L4)) lru_chunk_phase<true>(a, z, j, lds);
        if (ph + 1 < a.ph_hi) grid.sync();
    }
}
constexpr int N_PHASES = 48;

#ifndef MK_MULTI
#define MK_MULTI 0
#endif
extern "C" void kernel_launch(void* const* d_in, const int* in_sizes, int n_in, void* d_out, int out_size, void* d_ws, size_t ws_size, hipStream_t stream) {
    static int grid = 0;
    if (grid == 0) {
        int dev = 0, cus = 0, per_cu = 0;
        hipGetDevice(&dev);
        hipDeviceGetAttribute(&cus, hipDeviceAttributeMultiprocessorCount, dev);
        if (hipFuncSetAttribute((const void*)mega_fwd, hipFuncAttributeMaxDynamicSharedMemorySize, LDS_BYTES) != hipSuccess) { fprintf(stderr, "hipFuncSetAttribute failed\n"); grid = -1; return; }
        if (hipOccupancyMaxActiveBlocksPerMultiprocessor(&per_cu, (const void*)mega_fwd, 512, LDS_BYTES) != hipSuccess || per_cu < 1) { fprintf(stderr, "occupancy query: %d\n", per_cu); per_cu = 1; }
        (void)hipGetLastError();
        grid = cus * per_cu;
        if (ws_size < WS_END || n_in != 23) { fprintf(stderr, "kernel_launch: ws %zu n_in %d\n", ws_size, n_in); grid = -1; return; }
    }
    if (grid < 0) return;
    Args a{};
    for (int i = 0; i < 23; ++i) a.in[i] = (const float*)d_in[i];
    a.out = (float*)d_out; a.ws = (unsigned char*)d_ws;
    int nj = 0, tiles = 0;
    auto add = [&](int in_idx, long long src_off, size_t dst_off, int K, int N, int ldn, int ldk, int map, int ncol0) {
        TJob& t = a.jobs[nj++]; t.src_off = src_off; t.dst_off = (long long)dst_off; t.in_idx = in_idx; t.map = map; t.ldn = ldn; t.ldk = ldk; t.nnt = N / 64; t.tile0 = tiles; t.ncol0 = ncol0; t.pad = 0;
        tiles += (K / 64) * (N / 64);
    };
    for (int i = 0; i < 4; ++i) for (int f = 0; f < 2; ++f) {
        add(8, (long long)(i * 2 + f) * D * FF, off_w1t(i, f), D, FF, FF, D, 1, 0);
        add(9, (long long)(i * 2 + f) * D * FF, off_w1t(i, f), D, FF, FF, D, 2, 0);
        add(10, (long long)(i * 2 + f) * FF * D, off_w2t(i, f), FF, D, D, FF, 0, 0);
    }
    for (int j = 0; j < 2; ++j) {
        add(11, (long long)j * D * 3 * D, off_na(j), D, 2 * D, 3 * D, D, 3, 0);
        add(11, (long long)j * D * 3 * D, off_na(j) + 4 * MiB, D, D, 3 * D, D, 0, 2 * D);
        add(12, (long long)j * D * D, off_na(j) + 6 * MiB, D, D, D, D, 0, 0);
        add(14, (long long)j * D * 2 * LW, off_lru(j), D, 2 * LW, 2 * LW, D, 0, 0);
        add(22, (long long)j * LW * D, off_lru(j) + LRU_WOL, LW, D, D, LW, 0, 0);
        for (int d = 0; d < 2; ++d) {
            add(17, (long long)(j * 2 + d) * 10 * 128 * 128, off_lru(j) + LRU_WG + (size_t)(d * 2 + 0) * 10 * 128 * 128 * 2, LW, 128, 128, 128, 4, 0);
            add(19, (long long)(j * 2 + d) * 10 * 128 * 128, off_lru(j) + LRU_WG + (size_t)(d * 2 + 1) * 10 * 128 * 128 * 2, LW, 128, 128, 128, 4, 0);
        }
    }
    a.njobs = nj; a.ntiles = tiles;
    {
        int np = 0;
        auto P = [&](int type, int i, int s, int sub) { a.pdesc[np++] = (unsigned)type | ((unsigned)i << 8) | ((unsigned)s << 16) | ((unsigned)sub << 24); };
        P(PT_PREP, 0, 0, 0);
        for (int i = 0; i < 4; ++i) for (int s = 0; s < 3; ++s) {
            P(PT_NORM, i, s, 0);
            if (s != 1) { P(PT_G1, i, s, 0); P(PT_PLAIN, i, s, 0); }
            else if ((i & 1) == 0) { P(PT_QK, i, s, 0); P(PT_PLAIN, i, s, 3); P(PT_ATT, i, s, 0); P(PT_PLAIN, i, s, 1); }
            else { P(PT_IN, i, s, 0); P(PT_L2, i, s, 0); P(PT_L3, i, s, 0); P(PT_L4, i, s, 0); P(PT_PLAIN, i, s, 2); }
        }
        P(PT_NORM, 4, 0, 0);
        if (np != N_PHASES) { fprintf(stderr, "phase count %d\n", np); return; }
    }
#if MK_MULTI
    for (int p = 0; p < N_PHASES; ++p) { a.ph_lo = p; a.ph_hi = p + 1; hipLaunchKernelGGL(mega_fwd, dim3(grid), dim3(512), LDS_BYTES, stream, a); }
#else
    a.ph_lo = 0; a.ph_hi = N_PHASES;
    void* kargs[] = {&a};
    hipError_t e = hipLaunchCooperativeKernel((const void*)mega_fwd, dim3(grid), dim3(512), kargs, LDS_BYTES, stream);
    if (e != hipSuccess) fprintf(stderr, "cooperative launch failed: %s (grid %d)\n", hipGetErrorString(e), grid);
#endif
}
```

```cpp
#include <hip/hip_runtime.h>
namespace pg8 {
#define PG8_LAS __attribute__((address_space(3)))
typedef unsigned short bf16_t;
typedef short bf16x8 __attribute__((ext_vector_type(8)));
typedef float f32x4 __attribute__((ext_vector_type(4)));
typedef unsigned u32x4 __attribute__((ext_vector_type(4)));
constexpr int BM = 256, BK = 64, HALF = 128, HTB = HALF * BK * 2  , STAGE_BYTES = 8 * HTB, NXCD = 8, WGM = 8;

__host__ __device__ __forceinline__ int lds_byte(int r, int c) { const int st = (r >> 4) * 2 + (c >> 5), rr = r & 15, cc = c & 31, ob = rr * 64 + cc * 2; return st * 1024 + (ob ^ (((ob >> 9) & 1) << 5)); }
__host__ __device__ __forceinline__ void stage_rc(int b, int& R, int& C) { const int st = b / 1024, sb = b % 1024, swz = sb ^ (((sb >> 9) & 1) << 5); R = (st >> 1) * 16 + swz / 64; C = (st & 1) * 32 + (swz % 64) / 2; }
__host__ __device__ __forceinline__ int perm32(int rho) { const int n = rho >> 4, i = rho & 15; return 8 * (i >> 2) + 4 * n + (i & 3); }

struct Unit { int pm, pn; };
struct Gemm { const bf16_t* A; const bf16_t* Bt; int M, N, K; };

struct StaticOrder {
    int nM, nN, nwg, G, c;
    __host__ __device__ void init(int M, int N, int G_, int c_) { nM = M / BM; nN = N / BM; nwg = nM * nN; G = G_; c = c_; }
    __host__ __device__ bool next(int i, Unit& u) const {
        const long L = (long)i * G + c; if (L >= nwg) return false;
        int wgid = (int)L; { const int q = nwg / NXCD, r = nwg % NXCD, xcd = wgid % NXCD, off = wgid / NXCD; wgid = (xcd < r ? xcd * (q + 1) : r * (q + 1) + (xcd - r) * q) + off; }
        const int nig = WGM * nN, gid = wgid / nig, fm = gid * WGM, gsz = (nM - fm) < WGM ? (nM - fm) : WGM;
        u.pm = fm + ((wgid % nig) % gsz); u.pn = (wgid % nig) / gsz; return true;
    }
    __device__ __forceinline__ void a_ready(const Unit&) const {}
    __device__ __forceinline__ void done(const Unit&) const {}
};
struct CountedOrder : StaticOrder {
    const unsigned* ready; unsigned need; unsigned* tmo;
    __device__ __forceinline__ void a_ready(const Unit& u) const {
        if (threadIdx.x < 64) {
            const unsigned long long t0 = __builtin_amdgcn_s_memrealtime(); unsigned polls = 0;
            while ((unsigned)__builtin_amdgcn_readfirstlane(__hip_atomic_load(ready + 64 * u.pm, __ATOMIC_RELAXED, __HIP_MEMORY_SCOPE_AGENT)) < need) {
                if ((++polls & 255u) == 0u && __builtin_amdgcn_readfirstlane(__hip_atomic_load(tmo, __ATOMIC_RELAXED, __HIP_MEMORY_SCOPE_AGENT)) != 0u) break;
                if (__builtin_amdgcn_s_memrealtime() - t0 > 2000000ull) {
                    if (threadIdx.x == 0) { unsigned expect = 0u; __hip_atomic_compare_exchange_strong(tmo + 1, &expect, 0x600u | (unsigned)(u.pm & 0xff), __ATOMIC_RELAXED, __ATOMIC_RELAXED, __HIP_MEMORY_SCOPE_AGENT); __hip_atomic_store(tmo, 1u, __ATOMIC_RELAXED, __HIP_MEMORY_SCOPE_AGENT); }
                    break; }
                __builtin_amdgcn_s_sleep(2); }
            __builtin_amdgcn_fence(__ATOMIC_ACQUIRE, "agent");
            asm volatile("s_waitcnt vmcnt(0)" ::: "memory");
        }
#if !defined(BROKEN_HOOK_NO_BARRIER)
        asm volatile("" ::: "memory"); __builtin_amdgcn_s_barrier(); asm volatile("" ::: "memory");
#endif
    }
};

__device__ __forceinline__ unsigned cvt_pk_bf16(float lo, float hi) { unsigned r; asm volatile("v_cvt_pk_bf16_f32 %0, %1, %2" : "=v"(r) : "v"(lo), "v"(hi)); return r; }
typedef float f32x2 __attribute__((ext_vector_type(2)));
__device__ __forceinline__ f32x2 gelu_pk(f32x2 v) {
    const f32x2 av = __builtin_elementwise_abs(v), d = av * 0.2316418882f + 1.0f;
    f32x2 t; t.x = __builtin_amdgcn_rcpf(d.x); t.y = __builtin_amdgcn_rcpf(d.y);
    f32x2 q = t * 0.5307027145f + (-0.7265760135f); q = q * t + 0.7107068705f; q = q * t + (-0.142248368f); q = q * t + 0.127414796f; q = q * t;
    const f32x2 s = (v * v) * (-0.72134752044f);
    f32x2 e; e.x = __builtin_amdgcn_exp2f(s.x); e.y = __builtin_amdgcn_exp2f(s.y);
    const f32x2 m = v * (q * e), r = v - m;
    f32x2 o; o.x = v.x < 0.f ? m.x : r.x; o.y = v.y < 0.f ? m.y : r.y; return o;
}

struct EpiF32 {
    static constexpr bool PERM = false, AFTER_DRAIN = false;
    float* C; int ldc; const float* bias;
    __device__ __forceinline__ void operator()(const f32x4 (&acc)[2][2][4][2], const Unit& u, int wr, int wc, int fr, int fq) const {
        const int row0 = u.pm * BM + wr * 64 + fr, col0 = u.pn * BM + wc * 32 + 4 * fq;
        f32x4 bv[2][2];
#pragma unroll
        for (int bj = 0; bj < 2; ++bj)
#pragma unroll
            for (int n = 0; n < 2; ++n) bv[bj][n] = bias ? *(const f32x4*)(bias + col0 + bj * HALF + n * 16) : (f32x4){0.f, 0.f, 0.f, 0.f};
#pragma unroll
        for (int ai = 0; ai < 2; ++ai)
#pragma unroll
            for (int m = 0; m < 4; ++m) { float* rowp = C + (size_t)(row0 + ai * HALF + m * 16) * ldc + col0;
#pragma unroll
                for (int bj = 0; bj < 2; ++bj)
#pragma unroll
                    for (int n = 0; n < 2; ++n) *(f32x4*)(rowp + bj * HALF + n * 16) = acc[ai][bj][m][n] + bv[bj][n]; }
    }
};
template <int ACT  > struct EpiBf16 {
    static constexpr bool PERM = true, AFTER_DRAIN = false;
    bf16_t* O; int ldc; const float* bias; int split_cols; size_t split_stride;
    __device__ __forceinline__ void operator()(const f32x4 (&acc)[2][2][4][2], const Unit& u, int wr, int wc, int fr, int fq) const {
        const int row0 = u.pm * BM + wr * 64 + fr; int colt = u.pn * BM; bf16_t* base = O;
        if (split_cols) { const int t = colt / split_cols; base += (size_t)t * split_stride; colt -= t * split_cols; }
        const int col0 = colt + wc * 32 + 8 * fq, bcol0 = u.pn * BM + wc * 32 + 8 * fq;
        f32x4 bv[2][2];
#pragma unroll
        for (int bj = 0; bj < 2; ++bj)
#pragma unroll
            for (int n = 0; n < 2; ++n) bv[bj][n] = bias ? *(const f32x4*)(bias + bcol0 + bj * HALF + 4 * n) : (f32x4){0.f, 0.f, 0.f, 0.f};
#pragma unroll
        for (int ai = 0; ai < 2; ++ai)
#pragma unroll
            for (int m = 0; m < 4; ++m) { bf16_t* rowp = base + (size_t)(row0 + ai * HALF + m * 16) * ldc + col0;
#pragma unroll
                for (int bj = 0; bj < 2; ++bj) { f32x4 v0 = acc[ai][bj][m][0] + bv[bj][0], v1 = acc[ai][bj][m][1] + bv[bj][1];
                    if (ACT == 1) { f32x2 a = gelu_pk((f32x2){v0[0], v0[1]}), b = gelu_pk((f32x2){v0[2], v0[3]}), c = gelu_pk((f32x2){v1[0], v1[1]}), d = gelu_pk((f32x2){v1[2], v1[3]});
                        v0 = (f32x4){a.x, a.y, b.x, b.y}; v1 = (f32x4){c.x, c.y, d.x, d.y}; }
                    if (ACT == 2) {
#pragma unroll
                        for (int j = 0; j < 4; ++j) { v0[j] = 0.5f * v0[j] * (1.0f + erff(v0[j] * 0.70710678f)); v1[j] = 0.5f * v1[j] * (1.0f + erff(v1[j] * 0.70710678f)); } }
                    u32x4 w; w.x = cvt_pk_bf16(v0[0], v0[1]); w.y = cvt_pk_bf16(v0[2], v0[3]); w.z = cvt_pk_bf16(v1[0], v1[1]); w.w = cvt_pk_bf16(v1[2], v1[3]);
                    *(u32x4*)(rowp + bj * HALF) = w; } }
    }
};

struct PanelStats {
    unsigned* xbuf;
    unsigned* cnt;
    unsigned* tmo;
    int ntn; float eps;
    unsigned code;
    __device__ __forceinline__ bool run(const f32x4 (&v)[2][2][4][2], const Unit& u, int wr, int wc, int fr, int fq, PG8_LAS unsigned char* lds, int wid, int lane) const {
        typedef float f32x2v __attribute__((ext_vector_type(2)));
        PG8_LAS f32x2v* P = (PG8_LAS f32x2v*)lds;
        PG8_LAS f32x2v* S = (PG8_LAS f32x2v*)(lds + 8192);
        PG8_LAS unsigned* flag = (PG8_LAS unsigned*)(lds + 8192 + 2048);
#pragma unroll
        for (int ai = 0; ai < 2; ++ai)
#pragma unroll
            for (int m = 0; m < 4; ++m) {
                float s = 0.f;
#pragma unroll
                for (int bj = 0; bj < 2; ++bj)
#pragma unroll
                    for (int n = 0; n < 2; ++n) { const f32x4 x = v[ai][bj][m][n]; s += (x[0] + x[1]) + (x[2] + x[3]); }
                s += __shfl_xor(s, 16); s += __shfl_xor(s, 32);
                const float mw = s * (1.0f / 64.0f); float q = 0.f;
#pragma unroll
                for (int bj = 0; bj < 2; ++bj)
#pragma unroll
                    for (int n = 0; n < 2; ++n) { const f32x4 d = v[ai][bj][m][n] - mw; q += (d[0] * d[0] + d[1] * d[1]) + (d[2] * d[2] + d[3] * d[3]); }
                q += __shfl_xor(q, 16); q += __shfl_xor(q, 32);
                if (fq == 0) P[(ai * HALF + wr * 64 + m * 16 + fr) * 4 + wc] = (f32x2v){mw, q};
            }
        asm volatile("s_waitcnt lgkmcnt(0)" ::: "memory"); __builtin_amdgcn_s_barrier(); asm volatile("" ::: "memory");
#if defined(BROKEN_NO_WAIT)
        if (blockIdx.x >= 64) { const long long t0 = clock64(); while (clock64() - t0 < 60000) __builtin_amdgcn_s_sleep(8); }
#endif
        const int row = wid * 32 + (lane & 31);
        if (lane < 32) {
            const f32x2v a = P[row * 4 + 0], b = P[row * 4 + 1], c = P[row * 4 + 2], d = P[row * 4 + 3];
            const float mt = (a.x + b.x + c.x + d.x) * 0.25f;
            const float da = a.x - mt, db = b.x - mt, dc = c.x - mt, dd = d.x - mt;
            const float m2 = (a.y + b.y) + (c.y + d.y) + 64.0f * ((da * da + db * db) + (dc * dc + dd * dd));
            unsigned long long* slot = (unsigned long long*)xbuf + ((size_t)(u.pm * BM + row) * 4 + u.pn);
            __hip_atomic_store(slot, ((unsigned long long)__float_as_uint(m2) << 32) | __float_as_uint(mt), __ATOMIC_RELAXED, __HIP_MEMORY_SCOPE_AGENT);
        }
        asm volatile("s_waitcnt vmcnt(0)" ::: "memory");
        if (lane == 0) __hip_atomic_fetch_add(cnt + 64 * u.pm, 1u, __ATOMIC_RELAXED, __HIP_MEMORY_SCOPE_AGENT);
        if (wid == 0) {
            bool dead = false; const unsigned long long t0 = __builtin_amdgcn_s_memrealtime(); const unsigned want = 8u * (unsigned)ntn;
            for (;;) {
#if defined(BROKEN_NO_WAIT)
                break;
#endif
                if ((unsigned)__builtin_amdgcn_readfirstlane(__hip_atomic_load(cnt + 64 * u.pm, __ATOMIC_RELAXED, __HIP_MEMORY_SCOPE_AGENT)) >= want) break;
                if (__builtin_amdgcn_s_memrealtime() - t0 > 2000000ull) {
                    if (lane == 0) { unsigned expect = 0u; __hip_atomic_compare_exchange_strong(tmo + 1, &expect, code | (unsigned)(u.pm & 0xff), __ATOMIC_RELAXED, __ATOMIC_RELAXED, __HIP_MEMORY_SCOPE_AGENT);
                                     __hip_atomic_store(tmo, 1u, __ATOMIC_RELAXED, __HIP_MEMORY_SCOPE_AGENT); }
                    dead = true; break; }
                __builtin_amdgcn_s_sleep(2);
            }
            __builtin_amdgcn_fence(__ATOMIC_ACQUIRE, "agent");
            if (lane == 0) flag[0] = dead ? 1u : 0u;
        }
        asm volatile("s_waitcnt vmcnt(0) lgkmcnt(0)" ::: "memory"); __builtin_amdgcn_s_barrier(); asm volatile("" ::: "memory");
        const bool bad = flag[0] != 0u;
        if (lane < 32) {
            const unsigned long long* slot = (const unsigned long long*)xbuf + (size_t)(u.pm * BM + row) * 4; float mt[4], m2[4]; float ms = 0.f;
#pragma unroll
            for (int t = 0; t < 4; ++t) { if (t < ntn) { const unsigned long long w = __hip_atomic_load(slot + t, __ATOMIC_RELAXED, __HIP_MEMORY_SCOPE_AGENT); mt[t] = __uint_as_float((unsigned)w); m2[t] = __uint_as_float((unsigned)(w >> 32)); } else { mt[t] = 0.f; m2[t] = 0.f; } ms += mt[t]; }
            const float mean = ms / (float)ntn; float q = 0.f;
#pragma unroll
            for (int t = 0; t < 4; ++t) if (t < ntn) { const float dm = mt[t] - mean; q += m2[t] + 256.0f * dm * dm; }
            S[row] = (f32x2v){mean, 1.0f / sqrtf(q / (256.0f * (float)ntn) + eps)};
        }
        asm volatile("s_waitcnt lgkmcnt(0)" ::: "memory"); __builtin_amdgcn_s_barrier(); asm volatile("" ::: "memory");
        return bad;
    }
};
struct EpiLnRes {
    static constexpr bool PERM = false, AFTER_DRAIN = true;
    const float* base; float* out; int ldc; const float* bias; PanelStats st; unsigned poison;
    __device__ __forceinline__ void refuse(size_t i0, size_t stride, int M, int N) const { const float q = __builtin_nanf(""); for (size_t i = i0; i < (size_t)M * N; i += stride) out[(i / N) * ldc + i % N] = q;
        if (i0 == 0) { unsigned expect = 0u; __hip_atomic_compare_exchange_strong(st.tmo + 1, &expect, 0x7f0u, __ATOMIC_RELAXED, __ATOMIC_RELAXED, __HIP_MEMORY_SCOPE_AGENT); __hip_atomic_store(st.tmo, 1u, __ATOMIC_RELAXED, __HIP_MEMORY_SCOPE_AGENT); } }
    __device__ __forceinline__ void fused(f32x4 (&acc)[2][2][4][2], const Unit& u, int wr, int wc, int fr, int fq, PG8_LAS unsigned char* lds, int wid, int lane) const {
        typedef float f32x2v __attribute__((ext_vector_type(2)));
        const PG8_LAS f32x2v* S = (const PG8_LAS f32x2v*)(lds + 8192);
        const int col0 = u.pn * BM + wc * 32 + 4 * fq;
#pragma unroll
        for (int bj = 0; bj < 2; ++bj)
#pragma unroll
            for (int n = 0; n < 2; ++n) { const f32x4 bv = bias ? *(const f32x4*)(bias + col0 + bj * HALF + n * 16) : (f32x4){0.f, 0.f, 0.f, 0.f};
#pragma unroll
                for (int ai = 0; ai < 2; ++ai)
#pragma unroll
                    for (int m = 0; m < 4; ++m) acc[ai][bj][m][n] += bv; }
        const bool bad = st.run(acc, u, wr, wc, fr, fq, lds, wid, lane) || poison != 0u;
        const float qnan = __builtin_nanf("");
#pragma unroll
        for (int ai = 0; ai < 2; ++ai)
#pragma unroll
            for (int m = 0; m < 4; ++m) { const int r = ai * HALF + wr * 64 + m * 16 + fr; const f32x2v sr = S[r]; const size_t off = (size_t)(u.pm * BM + r) * ldc + col0;
#pragma unroll
                for (int bj = 0; bj < 2; ++bj)
#pragma unroll
                    for (int n = 0; n < 2; ++n) { const f32x4 bs = *(const f32x4*)(base + off + bj * HALF + n * 16); f32x4 o = bs + (acc[ai][bj][m][n] - sr.x) * sr.y;
                        if (bad) o = (f32x4){qnan, qnan, qnan, qnan}; *(f32x4*)(out + off + bj * HALF + n * 16) = o; }
                asm volatile("" ::: "memory"); }
    }
};
struct EpiLnResLn {
    static constexpr bool PERM = false, AFTER_DRAIN = true;
    const float* base; float* out; bf16_t* xn; int ldc; const float* bias; PanelStats st1, st2; unsigned poison;
    __device__ __forceinline__ void refuse(size_t i0, size_t stride, int M, int N) const { const float q = __builtin_nanf(""); for (size_t i = i0; i < (size_t)M * N; i += stride) { const size_t o = (i / N) * ldc + i % N; out[o] = q; xn[o] = (bf16_t)0x7fc0u; }
        if (i0 == 0) { unsigned expect = 0u; __hip_atomic_compare_exchange_strong(st1.tmo + 1, &expect, 0x7f0u, __ATOMIC_RELAXED, __ATOMIC_RELAXED, __HIP_MEMORY_SCOPE_AGENT); __hip_atomic_store(st1.tmo, 1u, __ATOMIC_RELAXED, __HIP_MEMORY_SCOPE_AGENT); } }
    __device__ __forceinline__ void fused(f32x4 (&acc)[2][2][4][2], const Unit& u, int wr, int wc, int fr, int fq, PG8_LAS unsigned char* lds, int wid, int lane) const {
        typedef float f32x2v __attribute__((ext_vector_type(2))); typedef unsigned u32x2v __attribute__((ext_vector_type(2)));
        const PG8_LAS f32x2v* S = (const PG8_LAS f32x2v*)(lds + 8192);
        const int col0 = u.pn * BM + wc * 32 + 4 * fq;
#pragma unroll
        for (int bj = 0; bj < 2; ++bj)
#pragma unroll
            for (int n = 0; n < 2; ++n) { const f32x4 bv = bias ? *(const f32x4*)(bias + col0 + bj * HALF + n * 16) : (f32x4){0.f, 0.f, 0.f, 0.f};
#pragma unroll
                for (int ai = 0; ai < 2; ++ai)
#pragma unroll
                    for (int m = 0; m < 4; ++m) acc[ai][bj][m][n] += bv; }
        bool bad = st1.run(acc, u, wr, wc, fr, fq, lds, wid, lane) || poison != 0u;
        const float qnan = __builtin_nanf("");
#pragma unroll
        for (int ai = 0; ai < 2; ++ai)
#pragma unroll
            for (int m = 0; m < 4; ++m) { const int r = ai * HALF + wr * 64 + m * 16 + fr; const f32x2v sr = S[r]; const size_t off = (size_t)(u.pm * BM + r) * ldc + col0;
#pragma unroll
                for (int bj = 0; bj < 2; ++bj)
#pragma unroll
                    for (int n = 0; n < 2; ++n) { const f32x4 bs = *(const f32x4*)(base + off + bj * HALF + n * 16); acc[ai][bj][m][n] = bs + (acc[ai][bj][m][n] - sr.x) * sr.y; }
                asm volatile("" : "+v"(acc[ai][0][m][0]), "+v"(acc[ai][0][m][1]), "+v"(acc[ai][1][m][0]), "+v"(acc[ai][1][m][1]));
                if (m & 1) asm volatile("" ::: "memory"); }
        const bool bad1 = bad;
        bad = st2.run(acc, u, wr, wc, fr, fq, lds, wid, lane) || bad;
#pragma unroll
        for (int ai = 0; ai < 2; ++ai)
#pragma unroll
            for (int m = 0; m < 4; ++m) { const int r = ai * HALF + wr * 64 + m * 16 + fr; const f32x2v sr = S[r]; const size_t off = (size_t)(u.pm * BM + r) * ldc + col0;
#pragma unroll
                for (int bj = 0; bj < 2; ++bj)
#pragma unroll
                    for (int n = 0; n < 2; ++n) { const f32x4 x1 = acc[ai][bj][m][n]; *(f32x4*)(out + off + bj * HALF + n * 16) = bad1 ? (f32x4){qnan, qnan, qnan, qnan} : x1;
                        const f32x4 o = (x1 - sr.x) * sr.y; u32x2v w; w.x = cvt_pk_bf16(o[0], o[1]); w.y = cvt_pk_bf16(o[2], o[3]);
                        if (bad) { w.x = 0x7fc07fc0u; w.y = 0x7fc07fc0u; } *(u32x2v*)(xn + off + bj * HALF + n * 16) = w; }
                asm volatile("" ::: "memory"); }
    }
};

template <class Epi, class Sched, bool ALIGN_EPI = false, bool SP2 = false>
__device__ __forceinline__ void gemm_phase(PG8_LAS unsigned char* lds, const Gemm g, const Sched& S, const Epi& E) {
    int tid_l = threadIdx.x; asm volatile("" : "+v"(tid_l));
    const int tid = tid_l, wid = __builtin_amdgcn_readfirstlane(tid >> 6), lane = tid & 63, wr = wid >> 2, wc = wid & 3, fr = lane & 15, fq = lane >> 4;
    const int K = g.K, nt = K / BK;
    unsigned voffA[2], voffB[2];
#pragma unroll
    for (int i = 0; i < 2; ++i) { int R, C; stage_rc(tid * 16 + i * 8192, R, C); const int Rb = Epi::PERM ? ((R & ~31) + perm32(R & 31)) : R;
        voffA[i] = (unsigned)(R * K + C) * 2u; voffB[i] = (unsigned)(Rb * K + C) * 2u; }
    const size_t kstep = (size_t)(BK * 2);
    const size_t hstep = (size_t)HALF * K * 2;
    const size_t tstep = 2 * hstep;
    const unsigned ldsw = (unsigned)wid * 1024u;
    const int aoff = lds_byte(wr * 64 + fr, fq * 8), boff = lds_byte(wc * 32 + fr, fq * 8);
#define PG8_SA(b, h) (((b) * 2 + (h)) * HTB)
#define PG8_SB(b, h) ((4 + (b) * 2 + (h)) * HTB)
#define PG8_STAGE(bufoff, gbase, voff) do { _Pragma("unroll") for (int _i = 0; _i < 2; ++_i) \
        __builtin_amdgcn_global_load_lds((const unsigned*)((const char*)(gbase) + (voff)[_i]), (PG8_LAS unsigned*)(lds + (bufoff) + ldsw + _i * 8192), 16, 0, 0); } while (0)
#define PG8_LDA(dst, b, h) do { _Pragma("unroll") for (int m = 0; m < 4; ++m) _Pragma("unroll") for (int k = 0; k < 2; ++k) dst[m][k] = *(const PG8_LAS bf16x8*)(lds + PG8_SA(b, h) + aoff + m * 2048 + k * 1024); } while (0)
#define PG8_LDB(dst, b, h) do { _Pragma("unroll") for (int n = 0; n < 2; ++n) _Pragma("unroll") for (int k = 0; k < 2; ++k) dst[n][k] = *(const PG8_LAS bf16x8*)(lds + PG8_SB(b, h) + boff + n * 2048 + k * 1024); } while (0)
#define PG8_MMA(ai, bj, At, Bt) do { __builtin_amdgcn_s_setprio(1); _Pragma("unroll") for (int m = 0; m < 4; ++m) _Pragma("unroll") for (int n = 0; n < 2; ++n) _Pragma("unroll") for (int k = 0; k < 2; ++k) \
        acc[ai][bj][m][n] = __builtin_amdgcn_mfma_f32_16x16x32_bf16(Bt[n][k], At[m][k], acc[ai][bj][m][n], 0, 0, 0); __builtin_amdgcn_s_setprio(0); } while (0)
#define PG8_WAIT_V(n) asm volatile("s_waitcnt vmcnt(" #n ")" ::: "memory")
#define PG8_WAIT_L(n) asm volatile("s_waitcnt lgkmcnt(" #n ")" ::: "memory")
#define PG8_BAR __builtin_amdgcn_s_barrier()
#define PG8_SCHED __builtin_amdgcn_sched_barrier(0)
    Unit cur, nxt; int ui = 0;
    if (!S.next(0, cur)) return;
    f32x4 acc[2][2][4][2];
#pragma unroll
    for (int a = 0; a < 2; ++a)
#pragma unroll
        for (int b = 0; b < 2; ++b)
#pragma unroll
            for (int m = 0; m < 4; ++m)
#pragma unroll
                for (int n = 0; n < 2; ++n) acc[a][b][m][n] = (f32x4){0.f, 0.f, 0.f, 0.f};
    bf16x8 At[4][2], B0[2][2], B1[2][2];
    const char* cA = (const char*)g.A + (size_t)cur.pm * tstep; const char* cB = (const char*)g.Bt + (size_t)cur.pn * tstep;
    S.a_ready(cur);
    if constexpr (SP2) {
        PG8_STAGE(PG8_SB(0, 0), cB, voffB); PG8_STAGE(PG8_SB(0, 1), cB + hstep, voffB); PG8_STAGE(PG8_SA(0, 0), cA, voffA); PG8_STAGE(PG8_SA(0, 1), cA + hstep, voffA);
        if (wr == 1) PG8_BAR;
        PG8_WAIT_V(2); PG8_BAR;
        PG8_STAGE(PG8_SB(1, 0), cB + kstep, voffB); PG8_STAGE(PG8_SA(1, 0), cA + kstep, voffA); PG8_STAGE(PG8_SB(1, 1), cB + hstep + kstep, voffB);
        PG8_WAIT_V(6); PG8_BAR;
    } else {
        PG8_STAGE(PG8_SB(0, 0), cB, voffB); PG8_STAGE(PG8_SA(0, 0), cA, voffA); PG8_STAGE(PG8_SB(0, 1), cB + hstep, voffB); PG8_STAGE(PG8_SA(0, 1), cA + hstep, voffA);
        if (wr == 1) PG8_BAR;
        PG8_WAIT_V(4); PG8_BAR;
        PG8_STAGE(PG8_SB(1, 0), cB + kstep, voffB); PG8_STAGE(PG8_SA(1, 0), cA + kstep, voffA); PG8_STAGE(PG8_SB(1, 1), cB + hstep + kstep, voffB);
        PG8_WAIT_V(6); PG8_BAR;
    }
    for (;;) {
        const bool has_next = S.next(ui + 1, nxt);
        const char* nA = has_next ? (const char*)g.A + (size_t)nxt.pm * tstep : cA; const char* nB = has_next ? (const char*)g.Bt + (size_t)nxt.pn * tstep : cB;
        for (int t = 0; t < nt; t += 2) {
            const bool last = (t == nt - 2);
            const char* a1 = cA + (size_t)(t + 1) * kstep;
            const char* a2 = last ? nA : cA + (size_t)(t + 2) * kstep; const char* b2 = last ? nB : cB + (size_t)(t + 2) * kstep;
            const char* a3 = a2 + kstep; const char* b3 = b2 + kstep;
            if (last && has_next) S.a_ready(nxt);
            if constexpr (SP2) {
            PG8_LDB(B0, 0, 0); PG8_LDB(B1, 0, 1); PG8_SCHED; PG8_LDA(At, 0, 0); PG8_STAGE(PG8_SA(1, 1), a1 + hstep, voffA);
            PG8_WAIT_V(8); PG8_WAIT_L(0); PG8_BAR; PG8_MMA(0, 0, At, B0); PG8_MMA(0, 1, At, B1); PG8_BAR; PG8_SCHED;
            PG8_LDA(At, 0, 1); PG8_STAGE(PG8_SB(0, 0), b2, voffB); PG8_STAGE(PG8_SB(0, 1), b2 + hstep, voffB); PG8_STAGE(PG8_SA(0, 0), a2, voffA);
            PG8_WAIT_V(8); PG8_WAIT_L(0); PG8_BAR; PG8_MMA(1, 0, At, B0); PG8_MMA(1, 1, At, B1); PG8_BAR; PG8_SCHED;
            PG8_LDB(B0, 1, 0); PG8_LDB(B1, 1, 1); PG8_SCHED; PG8_LDA(At, 1, 0); PG8_STAGE(PG8_SA(0, 1), a2 + hstep, voffA);
            PG8_WAIT_V(8); PG8_WAIT_L(0); PG8_BAR; PG8_MMA(0, 0, At, B0); PG8_MMA(0, 1, At, B1); PG8_BAR; PG8_SCHED;
            PG8_LDA(At, 1, 1); PG8_STAGE(PG8_SB(1, 0), b3, voffB); PG8_STAGE(PG8_SB(1, 1), b3 + hstep, voffB); PG8_STAGE(PG8_SA(1, 0), a3, voffA);
            PG8_WAIT_V(8); PG8_WAIT_L(0); PG8_BAR; PG8_MMA(1, 0, At, B0); PG8_MMA(1, 1, At, B1); PG8_BAR; PG8_SCHED;
            } else {
            PG8_LDB(B0, 0, 0); PG8_SCHED; PG8_LDA(At, 0, 0); PG8_STAGE(PG8_SA(1, 1), a1 + hstep, voffA);
            PG8_WAIT_L(8); PG8_BAR; PG8_WAIT_L(0); PG8_MMA(0, 0, At, B0); PG8_BAR; PG8_SCHED;
            PG8_LDB(B1, 0, 1); PG8_STAGE(PG8_SB(0, 0), b2, voffB);
            PG8_BAR; PG8_WAIT_L(0); PG8_MMA(0, 1, At, B1); PG8_BAR;
            PG8_LDA(At, 0, 1); PG8_STAGE(PG8_SA(0, 0), a2, voffA);
            PG8_BAR; PG8_WAIT_L(0); PG8_MMA(1, 0, At, B0); PG8_BAR; PG8_SCHED;
            PG8_STAGE(PG8_SB(0, 1), b2 + hstep, voffB);
            PG8_WAIT_V(6); PG8_BAR; PG8_MMA(1, 1, At, B1); PG8_BAR;
            PG8_LDB(B0, 1, 0); PG8_SCHED; PG8_LDA(At, 1, 0); PG8_STAGE(PG8_SA(0, 1), a2 + hstep, voffA);
            PG8_WAIT_L(8); PG8_BAR; PG8_WAIT_L(0); PG8_MMA(0, 0, At, B0); PG8_BAR; PG8_SCHED;
            PG8_LDB(B1, 1, 1); PG8_STAGE(PG8_SB(1, 0), b3, voffB);
            PG8_BAR; PG8_WAIT_L(0); PG8_MMA(0, 1, At, B1); PG8_BAR;
            PG8_LDA(At, 1, 1); PG8_STAGE(PG8_SA(1, 0), a3, voffA);
            PG8_BAR; PG8_WAIT_L(0); PG8_MMA(1, 0, At, B0); PG8_BAR; PG8_SCHED;
            PG8_STAGE(PG8_SB(1, 1), b3 + hstep, voffB);
            PG8_WAIT_V(6); PG8_BAR; PG8_MMA(1, 1, At, B1); PG8_BAR;
            }
        }
        if constexpr (ALIGN_EPI) { if (wr == 0) PG8_BAR; }
        if constexpr (!Epi::AFTER_DRAIN) { E(acc, cur, wr, wc, fr, fq); S.done(cur); }
        if (!has_next) break;
#pragma unroll
        for (int a = 0; a < 2; ++a)
#pragma unroll
            for (int b = 0; b < 2; ++b)
#pragma unroll
                for (int m = 0; m < 4; ++m)
#pragma unroll
                    for (int n = 0; n < 2; ++n) acc[a][b][m][n] = (f32x4){0.f, 0.f, 0.f, 0.f};
        cur = nxt; cA = nA; cB = nB; ++ui;
        if constexpr (ALIGN_EPI) { if (wr == 1) PG8_BAR; }
    }
    PG8_WAIT_V(0);
    if constexpr (!ALIGN_EPI) { if (wr == 0) PG8_BAR; }
    PG8_BAR;
    if constexpr (Epi::AFTER_DRAIN) { E.fused(acc, cur, wr, wc, fr, fq, lds, wid, lane); S.done(cur); }
#undef PG8_SA
#undef PG8_SB
#undef PG8_STAGE
#undef PG8_LDA
#undef PG8_LDB
#undef PG8_MMA
#undef PG8_WAIT_V
#undef PG8_WAIT_L
#undef PG8_BAR
#undef PG8_SCHED
}
}

#include <hip/hip_cooperative_groups.h>
#include <cstdio>
namespace cg = cooperative_groups;

#define LAS __attribute__((address_space(3)))
typedef unsigned short bf16;
typedef float f32x4 __attribute__((ext_vector_type(4)));
typedef float f32x2 __attribute__((ext_vector_type(2)));
typedef short bf16x8 __attribute__((ext_vector_type(8)));
typedef unsigned u32x4 __attribute__((ext_vector_type(4)));
typedef unsigned u32x2 __attribute__((ext_vector_type(2)));
typedef _Float16 h16x4 __attribute__((ext_vector_type(4)));
typedef _Float16 h16x8 __attribute__((ext_vector_type(8)));

constexpr int D = 1024, ML = 32768, MC = 512, MT = 33280, SEQ = 16384, CTXL = 256, FF = 2816, LW = 1280;
constexpr int NMOD = 9216;
constexpr size_t MiB = 1u << 20;
constexpr size_t WS_MOD = 1 * MiB, WS_ROPE = 2 * MiB, WS_XC = 6 * MiB, WS_W = 40 * MiB;
constexpr size_t WS_HB = 206 * MiB, WS_YB = 271 * MiB, WS_BIG = 336 * MiB;
constexpr size_t HL_BYTES = (size_t)MT * LW * 2;
constexpr size_t WS_SUM = WS_BIG + 2 * HL_BYTES, WS_CIN = WS_SUM + 21 * MiB;
constexpr size_t WS_LF = WS_HB, WS_LB2 = WS_HB + HL_BYTES;
constexpr size_t WS_XA = 8 * MiB, WS_XB = 531 * MiB, WS_XCH = 563 * MiB, WS_END = 564 * MiB;
constexpr size_t W1T_BYTES = 11 * MiB, W2T_BYTES = 5 * MiB + MiB / 2;
__host__ __device__ constexpr size_t off_w1t(int i, int f) { return WS_W + (size_t)(i * 2 + f) * W1T_BYTES; }
__host__ __device__ constexpr size_t off_w2t(int i, int f) { return WS_W + 88 * MiB + (size_t)(i * 2 + f) * W2T_BYTES; }
__host__ __device__ constexpr size_t off_na(int j) { return WS_W + 132 * MiB + (size_t)j * 8 * MiB; }
__host__ __device__ constexpr size_t off_lru(int j) { return WS_W + 148 * MiB + (size_t)j * 9 * MiB; }
constexpr size_t LRU_WOL = 5 * MiB, LRU_WG = 7 * MiB + MiB / 2;
constexpr size_t ACT_ELEMS = (size_t)MT * D;
constexpr int LDS_BYTES = 147456;

struct TJob { long long src_off; long long dst_off; int in_idx, map, ldn, ldk, nnt, tile0, ncol0, pad; };
constexpr int MAXJOBS = 44;
struct Args {
    const float* in[23];
    float* out;
    unsigned char* ws;
    int ph_lo, ph_hi, njobs, ntiles;
    unsigned pdesc[48];
    TJob jobs[MAXJOBS];
};

__device__ __forceinline__ float bf2f(unsigned short v) { return __uint_as_float((unsigned)v << 16); }
__device__ __forceinline__ unsigned pk2(float lo, float hi) { return pg8::cvt_pk_bf16(lo, hi); }
__device__ __forceinline__ float wave_sum(float v) {
#pragma unroll
    for (int o = 1; o < 64; o <<= 1) v += __shfl_xor(v, o);
    return v;
}
__device__ __forceinline__ float sigmoidf_(float v) { return __builtin_amdgcn_rcpf(1.0f + __expf(-v)); }

struct EpiSwiGLU {
    static constexpr bool PERM = true, AFTER_DRAIN = false;
    bf16* O;
    __device__ __forceinline__ void operator()(const f32x4 (&acc)[2][2][4][2], const pg8::Unit& u, int wr, int wc, int fr, int fq) const {
        const int row0 = u.pm * 256 + wr * 64 + fr, colh = u.pn * 128 + wc * 32 + 8 * fq;
#pragma unroll
        for (int ai = 0; ai < 2; ++ai)
#pragma unroll
            for (int m = 0; m < 4; ++m) { bf16* rowp = O + (size_t)(row0 + ai * 128 + m * 16) * FF + colh;
                float o[8];
#pragma unroll
                for (int n = 0; n < 2; ++n) { const f32x4 g = acc[ai][0][m][n], up = acc[ai][1][m][n];
                    const f32x4 ng = __builtin_elementwise_max(g, (f32x4){-14.f, -14.f, -14.f, -14.f}) * -1.4426950408889634f;
                    const f32x4 d = (f32x4){__builtin_amdgcn_exp2f(ng[0]), __builtin_amdgcn_exp2f(ng[1]), __builtin_amdgcn_exp2f(ng[2]), __builtin_amdgcn_exp2f(ng[3])} + 1.0f;
                    const float p01 = d[0] * d[1], p23 = d[2] * d[3]; const float t = __builtin_amdgcn_rcpf(p01 * p23);
                    const float i01 = t * p23, i23 = t * p01;
                    const f32x4 gu = g * up;
                    o[4 * n + 0] = gu[0] * (i01 * d[1]); o[4 * n + 1] = gu[1] * (i01 * d[0]); o[4 * n + 2] = gu[2] * (i23 * d[3]); o[4 * n + 3] = gu[3] * (i23 * d[2]); }
                u32x4 w; w.x = pk2(o[0], o[1]); w.y = pk2(o[2], o[3]); w.z = pk2(o[4], o[5]); w.w = pk2(o[6], o[7]);
                *(u32x4*)rowp = w; }
    }
};
struct EpiRope {
    static constexpr bool PERM = true, AFTER_DRAIN = false;
    bf16* Q; bf16* K; const float* ctab; const float* stab;
    __device__ __forceinline__ void operator()(const f32x4 (&acc)[2][2][4][2], const pg8::Unit& u, int wr, int wc, int fr, int fq) const {
        const int row0 = u.pm * 256 + wr * 64 + fr;
        const int i = 4 * (wc & 1) + fq;
#pragma unroll
        for (int ai = 0; ai < 2; ++ai)
#pragma unroll
            for (int m = 0; m < 4; ++m) {
                const int row = row0 + ai * 128 + m * 16;
                f32x4 cs = (f32x4){1.f, 1.f, 1.f, 1.f}, sn = (f32x4){0.f, 0.f, 0.f, 0.f};
                if (row < ML) { const int t = row & (SEQ - 1); cs = *(const f32x4*)(ctab + t * 32 + 4 * i); sn = *(const f32x4*)(stab + t * 32 + 4 * i); }
#pragma unroll
                for (int bj = 0; bj < 2; ++bj) {
                    const int c = u.pn * 256 + bj * 128 + wc * 32;
                    const bool isk = c >= 1024; const int head = (c & 1023) >> 6;
                    const float sc = isk ? 1.0f : 0.18033688011112042f;
                    bf16* dst = (isk ? K : Q) + (size_t)row * D + head * 64 + 4 * i;
                    const f32x4 x1 = acc[ai][bj][m][0], x2 = acc[ai][bj][m][1];
                    const f32x4 o1 = (x1 * cs - x2 * sn) * sc, o2 = (x1 * sn + x2 * cs) * sc;
                    u32x2 w1, w2; w1.x = pk2(o1[0], o1[1]); w1.y = pk2(o1[2], o1[3]); w2.x = pk2(o2[0], o2[1]); w2.y = pk2(o2[2], o2[3]);
                    *(u32x2*)dst = w1; *(u32x2*)(dst + 32) = w2; } }
    }
};
struct EpiGeluSplit {
    static constexpr bool PERM = true, AFTER_DRAIN = false;
    bf16* G; bf16* V;
    __device__ __forceinline__ void operator()(const f32x4 (&acc)[2][2][4][2], const pg8::Unit& u, int wr, int wc, int fr, int fq) const {
        const int row0 = u.pm * 256 + wr * 64 + fr; const bool isg = u.pn < 5;
        const int col0 = (isg ? u.pn * 256 : u.pn * 256 - LW) + wc * 32 + 8 * fq;
        bf16* base = isg ? G : V;
#pragma unroll
        for (int ai = 0; ai < 2; ++ai)
#pragma unroll
            for (int m = 0; m < 4; ++m) { bf16* rowp = base + (size_t)(row0 + ai * 128 + m * 16) * LW + col0;
#pragma unroll
                for (int bj = 0; bj < 2; ++bj) { f32x4 v0 = acc[ai][bj][m][0], v1 = acc[ai][bj][m][1];
                    if (isg) {
#pragma unroll
                        for (int e = 0; e < 4; ++e) { const float a = v0[e], b = v1[e];
                            v0[e] = a * sigmoidf_(1.5957691216f * (a + 0.044715f * a * a * a));
                            v1[e] = b * sigmoidf_(1.5957691216f * (b + 0.044715f * b * b * b)); } }
                    u32x4 w; w.x = pk2(v0[0], v0[1]); w.y = pk2(v0[2], v0[3]); w.z = pk2(v1[0], v1[1]); w.w = pk2(v1[2], v1[3]);
                    *(u32x4*)(rowp + bj * 128) = w; } }
    }
};

#ifndef PG8_ALIGN_EPI
#define PG8_ALIGN_EPI false
#endif
#ifndef PG8_USE_SP2
#define PG8_USE_SP2 true
#endif
template <class Epi>
__device__ __forceinline__ void run_gemm(LAS unsigned char* lds, const bf16* A, const bf16* Bt, int Mg, int Ng, int K, const Epi& E) {
    int bid = blockIdx.x, gsz = gridDim.x; asm volatile("" : "+s"(bid), "+s"(gsz));
    pg8::Gemm g{A, Bt, Mg, Ng, K}; pg8::StaticOrder S; S.init(Mg, Ng, gsz, bid);
    pg8::gemm_phase<Epi, pg8::StaticOrder, PG8_ALIGN_EPI, PG8_USE_SP2>(lds, g, S, E);
}

__device__ __forceinline__ const float* pick_in(const Args& a, const int z, int idx) {
    const float* p = a.in[8 + z];
    p = idx == 9 ? a.in[9 + z] : p; p = idx == 10 ? a.in[10 + z] : p; p = idx == 11 ? a.in[11 + z] : p; p = idx == 12 ? a.in[12 + z] : p;
    p = idx == 14 ? a.in[14 + z] : p; p = idx == 17 ? a.in[17 + z] : p; p = idx == 19 ? a.in[19 + z] : p; p = idx == 22 ? a.in[22 + z] : p;
    return p;
}
__device__ __forceinline__ int map_row(int map, int n) {
    if (map == 1) return 256 * (n >> 7) + (n & 127);
    if (map == 2) return 256 * (n >> 7) + 128 + (n & 127);
    if (map == 3) { const int hc = n >> 6, d = n & 63; return 64 * hc + 8 * ((d & 31) >> 2) + 4 * (d >> 5) + (d & 3); }
    return n;
}
__device__ __forceinline__ void prep_phase(const Args& a, const int z, LAS unsigned char* lds) {
    int tid_ = threadIdx.x; asm volatile("" : "+v"(tid_));
    const int tid = tid_, wave = __builtin_amdgcn_readfirstlane(tid >> 6), lane = tid & 63;
    float* MOD = (float*)((a.ws + z) + WS_MOD);
    LAS float* sc = (LAS float*)lds;
    LAS float* red = (LAS float*)(lds + 16384);
    bool have_sc = false;
    for (int it = blockIdx.x; it < 144; it += gridDim.x) {
        if (!have_sc) {
            for (int e = tid; e < 3 * D; e += 512) { const int r = e >> 10, k = e & 1023; const float v = r < 2 ? a.in[1 + z][r * D + k] : a.in[3 + z][k]; sc[e] = v * sigmoidf_(v); }
            have_sc = true; __syncthreads();
        }
        const int layer = it / 36, cg0 = (it % 36) * 256;
        const float* W = a.in[4 + z] + (size_t)layer * D * NMOD + cg0 + 4 * lane;
        f32x4 acc0 = (f32x4){0.f, 0.f, 0.f, 0.f}, acc1 = acc0, acc2 = acc0;
        const int kb = wave * 128;
        for (int k0 = 0; k0 < 128; k0 += 8) {
            f32x4 w[8];
#pragma unroll
            for (int e = 0; e < 8; ++e) w[e] = *(const f32x4*)(W + (size_t)(kb + k0 + e) * NMOD);
#pragma unroll
            for (int e = 0; e < 8; ++e) { const float s0 = sc[kb + k0 + e], s1 = sc[D + kb + k0 + e], s2 = sc[2 * D + kb + k0 + e];
                acc0 += w[e] * s0; acc1 += w[e] * s1; acc2 += w[e] * s2; }
        }
        *(LAS f32x4*)(red + (wave * 3 + 0) * 256 + 4 * lane) = acc0;
        *(LAS f32x4*)(red + (wave * 3 + 1) * 256 + 4 * lane) = acc1;
        *(LAS f32x4*)(red + (wave * 3 + 2) * 256 + 4 * lane) = acc2;
        __syncthreads();
        for (int e = tid; e < 768; e += 512) { const int r = e >> 8, c = e & 255; float s = 0.f;
#pragma unroll
            for (int w8 = 0; w8 < 8; ++w8) s += red[(w8 * 3 + r) * 256 + c];
            MOD[(size_t)(layer * 3 + r) * NMOD + cg0 + c] = s + a.in[5 + z][layer * NMOD + cg0 + c]; }
        __syncthreads();
    }
    {
        float* ctab = (float*)((a.ws + z) + WS_ROPE); float* stab = ctab + SEQ * 32;
        for (int e = blockIdx.x * 512 + tid; e < SEQ * 32; e += gridDim.x * 512) {
            const int t = e >> 5, p = e & 31; const float pos = (float)(p < 16 ? (t >> 6) : (t & 63));
            const float invf = powf(10000.0f, -(float)(p & 15) / 16.0f); const float ang = pos * invf;
            ctab[e] = cosf(ang); stab[e] = sinf(ang); }
    }
    __syncthreads();
    LAS float* T = (LAS float*)(lds + 65536);
    int jxs = 0;
    for (int tile0 = blockIdx.x; tile0 < a.ntiles; tile0 += 4 * gridDim.x) {
        const float* src[4]; bf16* dst[4]; int mapk[4], ldk[4], k0s[4], n0s[4]; bool ok[4];
#pragma unroll
        for (int q = 0; q < 4; ++q) {
            const int tile = tile0 + q * (int)gridDim.x; ok[q] = tile < a.ntiles; const int tl = ok[q] ? tile : tile0;
            if (tl < a.jobs[jxs].tile0) jxs = 0;
            while (jxs + 1 < a.njobs && tl >= a.jobs[jxs + 1].tile0) ++jxs;
            const TJob jb = a.jobs[jxs];
            const int local = tl - jb.tile0, kt = local / jb.nnt, nt = local % jb.nnt; k0s[q] = kt * 64; n0s[q] = nt * 64;
            src[q] = pick_in(a, z, jb.in_idx) + jb.src_off + (size_t)k0s[q] * jb.ldn + jb.ncol0 + n0s[q];
            dst[q] = (bf16*)((a.ws + z) + jb.dst_off); mapk[q] = jb.map; ldk[q] = jb.ldk;
            const int kk = tid >> 3, ns = (tid & 7) * 4; const float* p = src[q] + (size_t)kk * jb.ldn + ns;
            const f32x4 v0 = *(const f32x4*)p, v1 = *(const f32x4*)(p + 32);
            LAS float* t = T + q * 4160 + kk * 65 + ns; t[0] = v0[0]; t[1] = v0[1]; t[2] = v0[2]; t[3] = v0[3]; t[32] = v1[0]; t[33] = v1[1]; t[34] = v1[2]; t[35] = v1[3];
        }
        __syncthreads();
#pragma unroll
        for (int q = 0; q < 4; ++q) if (ok[q]) {
            const int nl = tid >> 3, ks = (tid & 7) * 8; const LAS float* t = T + q * 4160 + ks * 65 + nl;
            u32x4 o; o.x = pk2(t[0], t[65]); o.y = pk2(t[2 * 65], t[3 * 65]); o.z = pk2(t[4 * 65], t[5 * 65]); o.w = pk2(t[6 * 65], t[7 * 65]);
            size_t drow, dcol;
            if (mapk[q] == 4) { drow = (size_t)((k0s[q] >> 7) * 128 + n0s[q] + nl); dcol = (size_t)((k0s[q] & 127) + ks); }
            else { drow = (size_t)map_row(mapk[q], n0s[q] + nl); dcol = (size_t)(k0s[q] + ks); }
            *(u32x4*)(dst[q] + drow * ldk[q] + dcol) = o; }
        __syncthreads();
    }
}

__device__ __forceinline__ void norm_phase(const Args& a, const int z, int res_l, int res_s, float res_w, int pre_l, int pre_s, bool dry) {
    int tid_ = threadIdx.x; asm volatile("" : "+v"(tid_));
    const int tid = tid_, wave = __builtin_amdgcn_readfirstlane(tid >> 6), lane = tid & 63;
    const int gw = blockIdx.x * 8 + wave, NGW = gridDim.x * 8;
    const float* MOD = (const float*)((a.ws + z) + WS_MOD);
    const bf16* YB = (const bf16*)((a.ws + z) + WS_YB);
    bf16* HB = (bf16*)((a.ws + z) + WS_HB);
    const bool first = res_l < 0, has_pre = pre_l >= 0;
    const int rbeg = (int)(((long long)gw * MT) / NGW), rend = (int)(((long long)(gw + 1) * MT) / NGW);
    f32x4 vres[4], vsc[4], vsh[4]; int rcur = -1;
    for (int rowa = rbeg; rowa < rend; rowa += 2) {
        int rows[2] = {rowa, rowa + 1}; bool v1 = rows[1] < rend;
        const int rcl = rowa < SEQ ? 0 : (rowa < ML ? 1 : 2);
        if (v1 && (rows[1] < SEQ ? 0 : (rows[1] < ML ? 1 : 2)) != rcl) v1 = false;
        if (!v1) rows[1] = rowa;
        if (rcl != rcur) {
            rcur = rcl;
            if (!first) { const float* gate = MOD + (size_t)(res_l * 3 + rcl) * NMOD + (3 * res_s + 2) * D; const float* gpost = a.in[7 + z] + (size_t)(res_l * 3 + res_s) * D;
#pragma unroll
                for (int j = 0; j < 4; ++j) vres[j] = *(const f32x4*)(gate + j * 256 + 4 * lane) * *(const f32x4*)(gpost + j * 256 + 4 * lane) * res_w; }
            if (has_pre) { const float* mb = MOD + (size_t)(pre_l * 3 + rcl) * NMOD + (3 * pre_s) * D; const float* gpre = a.in[6 + z] + (size_t)(pre_l * 3 + pre_s) * D;
#pragma unroll
                for (int j = 0; j < 4; ++j) { vsh[j] = *(const f32x4*)(mb + j * 256 + 4 * lane); vsc[j] = (*(const f32x4*)(mb + D + j * 256 + 4 * lane) + 1.0f) * *(const f32x4*)(gpre + j * 256 + 4 * lane); } }
        }
        _Float16* x16[2];
#pragma unroll
        for (int q = 0; q < 2; ++q) { const int row = rows[q];
            x16[q] = (_Float16*)((a.ws + z) + (row < SEQ ? WS_XA : (row < ML ? WS_XB : WS_XCH))) + (size_t)(row < SEQ ? row : (row < ML ? row - SEQ : row - ML)) * D; }
        f32x4 xv[2][4]; f32x4 yv[2][4];
        if (first) {
#pragma unroll
            for (int q = 0; q < 2; ++q) { const int row = rows[q]; const float* xs = row < ML ? a.in[0 + z] + (size_t)row * D : a.in[2 + z] + (size_t)(row - ML) * D;
#pragma unroll
                for (int j = 0; j < 4; ++j) xv[q][j] = *(const f32x4*)(xs + j * 256 + 4 * lane); }
        } else {
#pragma unroll
            for (int q = 0; q < 2; ++q)
#pragma unroll
                for (int j = 0; j < 4; ++j) { const h16x4 hv = *(const h16x4*)(x16[q] + j * 256 + 4 * lane);
                    xv[q][j] = (f32x4){(float)hv[0], (float)hv[1], (float)hv[2], (float)hv[3]}; }
        }
        if (!first) {
            float ss[2] = {0.f, 0.f};
#pragma unroll
            for (int q = 0; q < 2; ++q)
#pragma unroll
                for (int j = 0; j < 4; ++j) { const u32x2 w = *(const u32x2*)(YB + (size_t)rows[q] * D + j * 256 + 4 * lane);
                    yv[q][j] = (f32x4){__uint_as_float(w.x << 16), __uint_as_float(w.x & 0xffff0000u), __uint_as_float(w.y << 16), __uint_as_float(w.y & 0xffff0000u)};
                    ss[q] += (yv[q][j][0] * yv[q][j][0] + yv[q][j][1] * yv[q][j][1]) + (yv[q][j][2] * yv[q][j][2] + yv[q][j][3] * yv[q][j][3]); }
#pragma unroll
            for (int o = 1; o < 64; o <<= 1) { ss[0] += __shfl_xor(ss[0], o); ss[1] += __shfl_xor(ss[1], o); }
#pragma unroll
            for (int q = 0; q < 2; ++q) { const float rstd = rsqrtf(ss[q] * (1.0f / D) + 1e-6f);
#pragma unroll
                for (int j = 0; j < 4; ++j) xv[q][j] += vres[j] * yv[q][j] * rstd; }
        }
#pragma unroll
        for (int q = 0; q < 2; ++q) if (q == 0 || v1) {
            if (has_pre) {
#pragma unroll
                for (int j = 0; j < 4; ++j) *(h16x4*)(x16[q] + j * 256 + 4 * lane) = (h16x4){(_Float16)xv[q][j][0], (_Float16)xv[q][j][1], (_Float16)xv[q][j][2], (_Float16)xv[q][j][3]};
            } else if (rows[q] < ML) {
#pragma unroll
                for (int j = 0; j < 4; ++j) *(f32x4*)((a.out + z) + (size_t)rows[q] * D + j * 256 + 4 * lane) = xv[q][j];
            }
        }
        if (has_pre) {
            float ss[2] = {0.f, 0.f};
#pragma unroll
            for (int q = 0; q < 2; ++q)
#pragma unroll
                for (int j = 0; j < 4; ++j) ss[q] += (xv[q][j][0] * xv[q][j][0] + xv[q][j][1] * xv[q][j][1]) + (xv[q][j][2] * xv[q][j][2] + xv[q][j][3] * xv[q][j][3]);
#pragma unroll
            for (int o = 1; o < 64; o <<= 1) { ss[0] += __shfl_xor(ss[0], o); ss[1] += __shfl_xor(ss[1], o); }
#pragma unroll
            for (int q = 0; q < 2; ++q) if (q == 0 || v1) { const float rstd = rsqrtf(ss[q] * (1.0f / D) + 1e-6f);
#pragma unroll
                for (int j = 0; j < 4; ++j) { const f32x4 h = xv[q][j] * rstd * vsc[j] + vsh[j];
                    u32x2 w; w.x = pk2(h[0], h[1]); w.y = pk2(h[2], h[3]);
                    *(u32x2*)(HB + (size_t)rows[q] * D + j * 256 + 4 * lane) = w; } }
        }
    }
}

struct KVFrag { bf16x8 k[2][2]; bf16x8 v[4]; };
__device__ __forceinline__ void attn_load(KVFrag& f, const bf16* Kb, const bf16* Vt, int T0, int krow, int h, int fr, int g) {
    const bf16* kp = Kb + (size_t)(T0 + krow) * D + h * 64 + g * 8;
#pragma unroll
    for (int t = 0; t < 2; ++t)
#pragma unroll
        for (int ks = 0; ks < 2; ++ks) f.k[t][ks] = *(const bf16x8*)(kp + (size_t)(4 * t) * D + ks * 32);
    const bf16* vp = Vt + (size_t)(h * 64 + fr) * MT + T0 + g * 8;
#pragma unroll
    for (int dt = 0; dt < 4; ++dt) f.v[dt] = *(const bf16x8*)(vp + (size_t)(dt * 16) * MT);
}
__device__ __forceinline__ void attn_step(const KVFrag& f, const bf16x8 qb0, const bf16x8 qb1, const bool lat, const LAS float* bpl, const unsigned vm,
                                          f32x4 (&o)[4], float& mrun, float& lrun) {
    f32x4 s0 = (f32x4){0.f, 0.f, 0.f, 0.f}, s1 = s0;
    s0 = __builtin_amdgcn_mfma_f32_16x16x32_bf16(f.k[0][0], qb0, s0, 0, 0, 0);
    s0 = __builtin_amdgcn_mfma_f32_16x16x32_bf16(f.k[0][1], qb1, s0, 0, 0, 0);
    s1 = __builtin_amdgcn_mfma_f32_16x16x32_bf16(f.k[1][0], qb0, s1, 0, 0, 0);
    s1 = __builtin_amdgcn_mfma_f32_16x16x32_bf16(f.k[1][1], qb1, s1, 0, 0, 0);
    float s[8] = {s0[0], s0[1], s0[2], s0[3], s1[0], s1[1], s1[2], s1[3]};
    if (lat) {
#pragma unroll
        for (int e = 0; e < 8; ++e) { const float bv = bpl[e]; s[e] = ((vm >> e) & 1u) ? s[e] + bv : -1e30f; }
    }
    float cm = fmaxf(fmaxf(fmaxf(s[0], s[1]), fmaxf(s[2], s[3])), fmaxf(fmaxf(s[4], s[5]), fmaxf(s[6], s[7])));
    if (__any(cm > mrun + 40.0f)) {
        cm = fmaxf(cm, __shfl_xor(cm, 16)); cm = fmaxf(cm, __shfl_xor(cm, 32));
        const float mnew = fmaxf(mrun, cm); const float alpha = __builtin_amdgcn_exp2f(mrun - mnew);
        lrun *= alpha; mrun = mnew;
#pragma unroll
        for (int dt = 0; dt < 4; ++dt) o[dt] = o[dt] * alpha;
    }
    float ps = 0.f;
#pragma unroll
    for (int e = 0; e < 8; ++e) { s[e] = __builtin_amdgcn_exp2f(s[e] - mrun); ps += s[e]; }
    lrun += ps;
    union { u32x4 u; bf16x8 v; } pb;
    pb.u.x = pk2(s[0], s[1]); pb.u.y = pk2(s[2], s[3]); pb.u.z = pk2(s[4], s[5]); pb.u.w = pk2(s[6], s[7]);
#pragma unroll
    for (int dt = 0; dt < 4; ++dt) o[dt] = __builtin_amdgcn_mfma_f32_16x16x32_bf16(f.v[dt], pb.v, o[dt], 0, 0, 0);
}
constexpr int A_KC = 0, A_KP = 144, A_VC = 36864, A_VP = 528, A_RP = 36864 + 33792, A_QS = 36864 + 33792 + 2560;
__device__ __forceinline__ void attn_phase(const Args& a, const int z, int j, LAS unsigned char* lds, bool dry) {
    int tid_ = threadIdx.x; asm volatile("" : "+v"(tid_));
    const int tid = tid_, wave = __builtin_amdgcn_readfirstlane(tid >> 6), lane = tid & 63, fr = lane & 15, g = lane >> 4;
    bf16* Q = (bf16*)((a.ws + z) + WS_BIG); const bf16* Kb = Q + ACT_ELEMS; const bf16* Vt = Q + 2 * ACT_ELEMS;
    const int krow = (fr >> 2) * 8 + (fr & 3);
    for (int wg = blockIdx.x; wg < 256; wg += gridDim.x) {
        const int xcd = wg & 7, idx = wg >> 3, pair = xcd * 4 + (idx >> 3), sub = idx & 7, b = pair >> 4, h = pair & 15;
        __syncthreads();
        for (int e = tid; e < 256 * 8; e += 512) { const int key = e >> 3, p = e & 7;
            *(LAS u32x4*)(lds + A_KC + key * A_KP + p * 16) = *(const u32x4*)(Kb + (size_t)(ML + b * CTXL + key) * D + h * 64 + p * 8); }
        for (int e = tid; e < 64 * 32; e += 512) { const int d = e >> 5, p = e & 31;
            *(LAS u32x4*)(lds + A_VC + d * A_VP + p * 16) = *(const u32x4*)(Vt + (size_t)(h * 64 + d) * MT + ML + b * CTXL + p * 8); }
        { const float* rpb = a.in[13 + z] + (size_t)(j * 16 + h) * 465; for (int e = tid; e < 465; e += 512) ((LAS float*)(lds + A_RP))[64 + e] = rpb[e] * 1.4426950408889634f; }
        __syncthreads();
        if (wave < 2) {
            const int qrow0 = ML + b * CTXL + (sub * 2 + wave) * 16;
            bf16* qp = Q + (size_t)(qrow0 + fr) * D + h * 64;
            const bf16x8 qb0 = *(const bf16x8*)(qp + g * 8), qb1 = *(const bf16x8*)(qp + 32 + g * 8);
            f32x4 o[4];
#pragma unroll
            for (int dt = 0; dt < 4; ++dt) o[dt] = (f32x4){0.f, 0.f, 0.f, 0.f};
            float mrun = -1e30f, lrun = 0.f;
            for (int cc = 0; cc < 8; ++cc) {
                KVFrag f;
#pragma unroll
                for (int t = 0; t < 2; ++t)
#pragma unroll
                    for (int ks = 0; ks < 2; ++ks) f.k[t][ks] = *(const LAS bf16x8*)(lds + A_KC + (cc * 32 + krow + 4 * t) * A_KP + (ks * 32 + g * 8) * 2);
#pragma unroll
                for (int dt = 0; dt < 4; ++dt) f.v[dt] = *(const LAS bf16x8*)(lds + A_VC + (dt * 16 + fr) * A_VP + (cc * 32 + g * 8) * 2);
                attn_step(f, qb0, qb1, false, nullptr, 0u, o, mrun, lrun);
            }
            lrun += __shfl_xor(lrun, 16); lrun += __shfl_xor(lrun, 32);
            const float inv = 1.0f / lrun;
            bf16* op = dry ? (bf16*)((a.ws + z) + WS_HB) + (size_t)(qrow0 + fr) * D + h * 64 : qp;
#pragma unroll
            for (int dt = 0; dt < 4; ++dt) { u32x2 w; w.x = pk2(o[dt][0] * inv, o[dt][1] * inv); w.y = pk2(o[dt][2] * inv, o[dt][3] * inv);
                *(u32x2*)(op + dt * 16 + g * 4) = w; }
        }
        for (int li = wave; li < 32; li += 8) {
            const int rg = li >> 2, cq = li & 3, rbase = sub * 32 + rg * 4;
            const int cw = cq == 0 ? 0 : (cq == 1 ? 8 : (cq == 2 ? 24 : 32));
            const int cqq = cq * 16 + fr, c0 = min(max(cqq - 8, 0), 48);
            unsigned vm = 0u;
#pragma unroll
            for (int e = 0; e < 8; ++e) { const int rel = cw + g * 8 + e - c0; vm |= (rel >= 0 && rel < 16) ? (1u << e) : 0u; }
            const LAS float* rpl = (const LAS float*)(lds + A_RP) + 64 + (cw + g * 8 - cqq + 15);
            bf16* qp = Q + (size_t)(b * SEQ + rbase * 64 + cq * 16 + fr) * D + h * 64;
            f32x4 o[4][4]; float mrun[4], lrun[4];
            LAS unsigned char* qs = lds + A_QS + wave * 8192 + lane * 16;
#pragma unroll
            for (int t = 0; t < 4; ++t) { *(LAS bf16x8*)(qs + t * 2048) = *(const bf16x8*)(qp + (size_t)t * 64 * D + g * 8); *(LAS bf16x8*)(qs + t * 2048 + 1024) = *(const bf16x8*)(qp + (size_t)t * 64 * D + 32 + g * 8);
                mrun[t] = -1e30f; lrun[t] = 0.f;
#pragma unroll
                for (int dt = 0; dt < 4; ++dt) o[t][dt] = (f32x4){0.f, 0.f, 0.f, 0.f}; }
            const int kr_lo = min(max(rbase - 4, 0), 248), kr_hi = min(max(rbase - 1, 0), 248) + 7;
            KVFrag cur, nxt;
            attn_load(cur, Kb, Vt, b * SEQ + kr_lo * 64 + cw, krow, h, fr, g);
            nxt = cur;
            for (int kr = kr_lo; kr <= kr_hi; ++kr) {
                if (kr < kr_hi) attn_load(nxt, Kb, Vt, b * SEQ + (kr + 1) * 64 + cw, krow, h, fr, g);
#pragma unroll
                for (int t = 0; t < 4; ++t) { const int r = rbase + t, r0 = min(max(r - 4, 0), 248);
                    if (kr >= r0 && kr < r0 + 8)
                        attn_step(cur, *(const LAS bf16x8*)(qs + t * 2048), *(const LAS bf16x8*)(qs + t * 2048 + 1024), true, rpl + (kr - r + 7) * 31, vm, o[t], mrun[t], lrun[t]); }
                cur = nxt;
            }
            for (int cc = 0; cc < 8; ++cc) {
                KVFrag f;
#pragma unroll
                for (int t = 0; t < 2; ++t)
#pragma unroll
                    for (int ks = 0; ks < 2; ++ks) f.k[t][ks] = *(const LAS bf16x8*)(lds + A_KC + (cc * 32 + krow + 4 * t) * A_KP + (ks * 32 + g * 8) * 2);
#pragma unroll
                for (int dt = 0; dt < 4; ++dt) f.v[dt] = *(const LAS bf16x8*)(lds + A_VC + (dt * 16 + fr) * A_VP + (cc * 32 + g * 8) * 2);
#pragma unroll
                for (int t = 0; t < 4; ++t) attn_step(f, *(const LAS bf16x8*)(qs + t * 2048), *(const LAS bf16x8*)(qs + t * 2048 + 1024), false, nullptr, 0u, o[t], mrun[t], lrun[t]);
            }
#pragma unroll
            for (int t = 0; t < 4; ++t) {
                float lt = lrun[t]; lt += __shfl_xor(lt, 16); lt += __shfl_xor(lt, 32);
                const float inv = 1.0f / lt;
                bf16* op = (dry ? (bf16*)((a.ws + z) + WS_HB) + (size_t)(b * SEQ + rbase * 64 + cq * 16 + fr) * D + h * 64 : qp) + (size_t)t * 64 * D;
#pragma unroll
                for (int dt = 0; dt < 4; ++dt) { u32x2 w; w.x = pk2(o[t][dt][0] * inv, o[t][dt][1] * inv); w.y = pk2(o[t][dt][2] * inv, o[t][dt][3] * inv);
                    *(u32x2*)(op + dt * 16 + g * 4) = w; }
            }
        }
    }
    __syncthreads();
}

constexpr int UP = 132;
constexpr int L_U32 = 0, L_UB = 33792, L_GB = 51200, L_T1 = 68608, L_T2 = 86016;
#define LRU_PREFETCH(TASK) do { const int n_ = (TASK) / 1040, c_ = (TASK) - n_ * 1040, m0_ = c_ * 32; int lo_, hi_; \
        if (m0_ < ML) { lo_ = (m0_ / SEQ) * SEQ; hi_ = lo_ + SEQ; } else { lo_ = ML + ((m0_ - ML) / CTXL) * CTXL; hi_ = lo_ + CTXL; } \
        _Pragma("unroll") for (int tap = 0; tap < 4; ++tap) { const int mr = m0_ + tokc + tap - 2; \
            pv[tap] = (mr >= lo_ && mr < hi_) ? *(const u32x4*)(V + (size_t)mr * LW + n_ * 128 + ch8) : (u32x4){0u, 0u, 0u, 0u}; } \
        if (FINAL) pg = *(const u32x4*)(G + (size_t)(m0_ + tokc) * LW + n_ * 128 + ch8); } while (0)
__device__ __forceinline__ unsigned char* lb_row_ptr(const Args& a, const int z, int row) {
    return row < SEQ ? (unsigned char*)(a.out + z) + HL_BYTES + (size_t)row * (LW * 2) : (a.ws + z) + WS_LB2 + (size_t)(row - SEQ) * (LW * 2);
}
__device__ __forceinline__ void lru_scan_phase(const Args& a, const int z, int j, LAS unsigned char* lds) {
    constexpr bool FINAL = false;
    int tid_ = threadIdx.x; asm volatile("" : "+v"(tid_));
    const int tid = tid_, wave = __builtin_amdgcn_readfirstlane(tid >> 6), lane = tid & 63, fr = lane & 15, g = lane >> 4;
    const int tokc = tid >> 4, ch8 = (tid & 15) * 8, ct = wave, ch = ct * 16 + fr;
    bf16* G = (bf16*)((a.ws + z) + WS_BIG); const bf16* V = G + (size_t)MT * LW;
    const bf16* Wg = (const bf16*)((a.ws + z) + off_lru(j) + LRU_WG);
    const float* convw = a.in[15 + z] + (size_t)j * 4 * LW; const float* convb = a.in[16 + z] + (size_t)j * LW;
    const float* b_a = a.in[18 + z] + (size_t)j * 2 * LW; const float* b_x = a.in[20 + z] + (size_t)j * 2 * LW; const float* lam = a.in[21 + z] + (size_t)j * 2 * LW;
    f32x2* SUM = (f32x2*)((a.ws + z) + WS_SUM);
    unsigned char* HLg = (unsigned char*)(a.out + z); unsigned char* LFg = (a.ws + z) + WS_LF;
    int cur_n = -1, pm0 = 0, pn = 0;
    bf16x8 bw[4][4]; float cba[2] = {0.f, 0.f}, cbx[2] = {0.f, 0.f}, csp[2] = {0.f, 0.f};
    f32x4 cw[4][2], cbias[2];
    u32x4 pv[4], pg = (u32x4){0u, 0u, 0u, 0u};
    int task = blockIdx.x, it = 0;
    if (task < 10400) LRU_PREFETCH(task);
    for (; task < 10400; ++it, task += gridDim.x) {
        const int buf = it & 1;
        const int n = task / 1040, c = task - n * 1040, m0 = c * 32;
        LAS float* U32 = (LAS float*)(lds + L_U32) + buf * 32 * UP; LAS bf16* UB = (LAS bf16*)(lds + L_UB) + buf * 32 * 136; LAS bf16* GB = (LAS bf16*)(lds + L_GB) + buf * 32 * 136; LAS _Float16* T1 = (LAS _Float16*)(lds + L_T1) + buf * 32 * 136; LAS _Float16* T2 = (LAS _Float16*)(lds + L_T2) + buf * 32 * 136;
        if (n != cur_n) {
            cur_n = n;
#pragma unroll
            for (int tap = 0; tap < 4; ++tap) { cw[tap][0] = *(const f32x4*)(convw + tap * LW + n * 128 + ch8); cw[tap][1] = *(const f32x4*)(convw + tap * LW + n * 128 + ch8 + 4); }
            cbias[0] = *(const f32x4*)(convb + n * 128 + ch8); cbias[1] = *(const f32x4*)(convb + n * 128 + ch8 + 4);
#pragma unroll
            for (int cb = 0; cb < 4; ++cb)
#pragma unroll
                for (int ks = 0; ks < 4; ++ks) bw[cb][ks] = *(const bf16x8*)(Wg + ((size_t)(cb * 10 + n) * 128 + ch) * 128 + ks * 32 + g * 8);
#pragma unroll
            for (int dir = 0; dir < 2; ++dir) { cba[dir] = b_a[dir * LW + n * 128 + ch]; cbx[dir] = b_x[dir * LW + n * 128 + ch]; csp[dir] = -8.0f * 1.4426950408889634f * log1pf(__expf(-lam[dir * LW + n * 128 + ch])); }
        }
        { f32x4 u0 = cbias[0], u1 = cbias[1];
#pragma unroll
          for (int tap = 0; tap < 4; ++tap) { const u32x4 vv = pv[tap];
              u0 += cw[tap][0] * (f32x4){__uint_as_float(vv.x << 16), __uint_as_float(vv.x & 0xffff0000u), __uint_as_float(vv.y << 16), __uint_as_float(vv.y & 0xffff0000u)};
              u1 += cw[tap][1] * (f32x4){__uint_as_float(vv.z << 16), __uint_as_float(vv.z & 0xffff0000u), __uint_as_float(vv.w << 16), __uint_as_float(vv.w & 0xffff0000u)}; }
          *(LAS f32x4*)(U32 + tokc * UP + ch8) = u0; *(LAS f32x4*)(U32 + tokc * UP + ch8 + 4) = u1;
          u32x4 w; w.x = pk2(u0[0], u0[1]); w.y = pk2(u0[2], u0[3]); w.z = pk2(u1[0], u1[1]); w.w = pk2(u1[2], u1[3]);
          *(LAS u32x4*)(UB + tokc * 136 + ch8) = w;
          }
        __syncthreads();
        if (it > 0) {
            const int pb = (buf ^ 1) * 32 * 136; const size_t go = ((size_t)(pm0 + tokc) * LW + pn * 128 + ch8) * 2;
            *(u32x4*)(HLg + go) = *(const LAS u32x4*)((const LAS bf16*)(lds + L_GB) + pb + tokc * 136 + ch8);
            *(u32x4*)(LFg + go) = *(const LAS u32x4*)((const LAS _Float16*)(lds + L_T1) + pb + tokc * 136 + ch8);
            *(u32x4*)(lb_row_ptr(a, z, pm0 + tokc) + (size_t)(pn * 128 + ch8) * 2) = *(const LAS u32x4*)((const LAS _Float16*)(lds + L_T2) + pb + tokc * 136 + ch8); }
        { const int tn = task + gridDim.x; if (tn < 10400) LRU_PREFETCH(tn); }
        f32x4 acc[2][4];
#pragma unroll
        for (int rt = 0; rt < 2; ++rt)
#pragma unroll
            for (int cb = 0; cb < 4; ++cb) acc[rt][cb] = (f32x4){0.f, 0.f, 0.f, 0.f};
#pragma unroll
        for (int ks = 0; ks < 4; ++ks) {
            bf16x8 af[2];
#pragma unroll
            for (int rt = 0; rt < 2; ++rt) af[rt] = *(const LAS bf16x8*)(UB + (rt * 16 + fr) * 136 + ks * 32 + g * 8);
#pragma unroll
            for (int cb = 0; cb < 4; ++cb)
#pragma unroll
                for (int rt = 0; rt < 2; ++rt) acc[rt][cb] = __builtin_amdgcn_mfma_f32_16x16x32_bf16(af[rt], bw[cb][ks], acc[rt][cb], 0, 0, 0);
        }
        float uv[2][4];
#pragma unroll
        for (int rt = 0; rt < 2; ++rt)
#pragma unroll
            for (int jj = 0; jj < 4; ++jj) uv[rt][jj] = U32[(rt * 16 + g * 4 + jj) * UP + ch];
        float rec[2][4];
#pragma unroll
        for (int rt = 0; rt < 2; ++rt)
#pragma unroll
            for (int jj = 0; jj < 4; ++jj) rec[rt][jj] = 0.f;
#pragma unroll
        for (int dir = 0; dir < 2; ++dir) {
            float av[2][4], bv[2][4], lav[2][4], SA[2], SB[2];
#pragma unroll
            for (int rt = 0; rt < 2; ++rt) {
#pragma unroll
                for (int jp = 0; jp < 2; ++jp) {
                    const f32x2 xr = (f32x2){acc[rt][dir * 2][2 * jp], acc[rt][dir * 2][2 * jp + 1]} + cba[dir];
                    const f32x2 xi = (f32x2){acc[rt][dir * 2 + 1][2 * jp], acc[rt][dir * 2 + 1][2 * jp + 1]} + cbx[dir];
                    const f32x2 nr = __builtin_elementwise_max(xr, (f32x2){-30.f, -30.f}) * -1.4426950408889634f;
                    const f32x2 ni = __builtin_elementwise_max(xi, (f32x2){-30.f, -30.f}) * -1.4426950408889634f;
                    const f32x2 er1 = (f32x2){__builtin_amdgcn_exp2f(nr.x), __builtin_amdgcn_exp2f(nr.y)} + 1.0f;
                    const f32x2 ei1 = (f32x2){__builtin_amdgcn_exp2f(ni.x), __builtin_amdgcn_exp2f(ni.y)} + 1.0f;
                    const f32x2 pr = er1 * ei1;
                    const f32x2 tinv = (f32x2){__builtin_amdgcn_rcpf(pr.x), __builtin_amdgcn_rcpf(pr.y)};
                    const f32x2 rg = tinv * ei1, ig = tinv * er1;
                    const f32x2 la2 = rg * csp[dir];
                    const f32x2 a_ = (f32x2){__builtin_amdgcn_exp2f(la2.x), __builtin_amdgcn_exp2f(la2.y)};
                    const f32x2 x2 = la2 * 1.3862943611198906f;
                    const f32x2 ser = -x2 * (x2 * (x2 * (x2 * 0.041666668f + 0.16666667f) + 0.5f) + 1.0f);
                    const f32x2 alt = 1.0f - a_ * a_;
                    f32x2 om; om.x = x2.x > -0.1f ? ser.x : alt.x; om.y = x2.y > -0.1f ? ser.y : alt.y;
                    om = __builtin_elementwise_max(om, (f32x2){0.f, 0.f});
                    const f32x2 sq = (f32x2){__builtin_amdgcn_sqrtf(om.x), __builtin_amdgcn_sqrtf(om.y)};
                    const f32x2 b_ = sq * ig * (f32x2){uv[rt][2 * jp], uv[rt][2 * jp + 1]};
                    av[rt][2 * jp] = a_.x; av[rt][2 * jp + 1] = a_.y; bv[rt][2 * jp] = b_.x; bv[rt][2 * jp + 1] = b_.y; lav[rt][2 * jp] = la2.x; lav[rt][2 * jp + 1] = la2.y; }
                float sa = 1.f, sb = 0.f;
#pragma unroll
                for (int q = 0; q < 4; ++q) { const int jj = dir ? 3 - q : q; sb = av[rt][jj] * sb + bv[rt][jj]; sa *= av[rt][jj]; }
                SA[rt] = sa; SB[rt] = sb;
            }
            float Hrun = 0.f, Atot = 1.f, myc[2] = {0.f, 0.f}, myab[2] = {1.f, 1.f};
#pragma unroll
            for (int q = 0; q < 8; ++q) { const int rt = dir ? 1 - (q >> 2) : (q >> 2), gg = dir ? 3 - (q & 3) : (q & 3);
                const float sa = __shfl(SA[rt], fr + 16 * gg), sb = __shfl(SB[rt], fr + 16 * gg);
                myc[rt] = (gg == g) ? Hrun : myc[rt]; myab[rt] = (gg == g) ? Atot : myab[rt];
                Hrun = sa * Hrun + sb; Atot *= sa; }
            if (g == 0) SUM[(size_t)(c * 2 + dir) * LW + n * 128 + ch] = (f32x2){Atot, Hrun};
            LAS _Float16* TL = dir ? T2 : T1;
#pragma unroll
            for (int rt = 0; rt < 2; ++rt) { float h = myc[rt], lp = __builtin_amdgcn_logf(myab[rt]);
#pragma unroll
                for (int q = 0; q < 4; ++q) { const int jj = dir ? 3 - q : q; h = av[rt][jj] * h + bv[rt][jj]; rec[rt][jj] += h;
                    lp += lav[rt][jj]; TL[(rt * 16 + g * 4 + jj) * 136 + ch] = (_Float16)lp; } }
        }
#pragma unroll
        for (int rt = 0; rt < 2; ++rt)
#pragma unroll
            for (int jj = 0; jj < 4; ++jj) GB[(rt * 16 + g * 4 + jj) * 136 + ch] = (bf16)(pk2(rec[rt][jj], 0.f) & 0xffffu);
        pm0 = m0; pn = n;
    }
    __syncthreads();
    if (it > 0) { const int pb = ((it - 1) & 1) * 32 * 136; const size_t go = ((size_t)(pm0 + tokc) * LW + pn * 128 + ch8) * 2;
        *(u32x4*)(HLg + go) = *(const LAS u32x4*)((const LAS bf16*)(lds + L_GB) + pb + tokc * 136 + ch8);
        *(u32x4*)(LFg + go) = *(const LAS u32x4*)((const LAS _Float16*)(lds + L_T1) + pb + tokc * 136 + ch8);
        *(u32x4*)(lb_row_ptr(a, z, pm0 + tokc) + (size_t)(pn * 128 + ch8) * 2) = *(const LAS u32x4*)((const LAS _Float16*)(lds + L_T2) + pb + tokc * 136 + ch8); }
    __syncthreads();
}
__device__ __forceinline__ void lru_apply_phase(const Args& a, const int z, bool dry) {
    int tid_ = threadIdx.x; asm volatile("" : "+v"(tid_));
    const int tid = tid_;
    bf16* G = (bf16*)((a.ws + z) + WS_BIG); const float* CIN = (const float*)((a.ws + z) + WS_CIN);
    const unsigned char* HLg = (const unsigned char*)(a.out + z); const unsigned char* LFg = (a.ws + z) + WS_LF;
    const int stride = (int)gridDim.x * 512;
    for (int idx0 = blockIdx.x * 512 + tid; idx0 < MT * 160; idx0 += 4 * stride) {
        u32x4 hl[4], gv[4]; h16x8 lf[4], lb[4]; f32x4 cfa[4][2], cba[4][2]; size_t go[4]; bool ok[4];
#pragma unroll
        for (int k = 0; k < 4; ++k) { const int idx = idx0 + k * stride; ok[k] = idx < MT * 160; const int id = ok[k] ? idx : idx0;
            const int row = id / 160, c8 = (id - row * 160) * 8, chunk = row >> 5; go[k] = ((size_t)row * LW + c8) * 2;
            hl[k] = *(const u32x4*)(HLg + go[k]); gv[k] = *(const u32x4*)((const unsigned char*)G + go[k]);
            lf[k] = *(const h16x8*)(LFg + go[k]); lb[k] = *(const h16x8*)(lb_row_ptr(a, z, row) + (size_t)c8 * 2);
            const float* cfp = CIN + (size_t)(chunk * 2) * LW + c8;
            cfa[k][0] = *(const f32x4*)cfp; cfa[k][1] = *(const f32x4*)(cfp + 4); cba[k][0] = *(const f32x4*)(cfp + LW); cba[k][1] = *(const f32x4*)(cfp + LW + 4); }
#pragma unroll
        for (int k = 0; k < 4; ++k) if (ok[k]) {
            const unsigned hw[4] = {hl[k].x, hl[k].y, hl[k].z, hl[k].w}, gw[4] = {gv[k].x, gv[k].y, gv[k].z, gv[k].w};
            float r[8];
#pragma unroll
            for (int e = 0; e < 8; ++e) { const float hv = (e & 1) ? __uint_as_float(hw[e >> 1] & 0xffff0000u) : __uint_as_float(hw[e >> 1] << 16);
                const float gg = (e & 1) ? __uint_as_float(gw[e >> 1] & 0xffff0000u) : __uint_as_float(gw[e >> 1] << 16);
                r[e] = (hv + __builtin_amdgcn_exp2f((float)lf[k][e]) * cfa[k][e >> 2][e & 3] + __builtin_amdgcn_exp2f((float)lb[k][e]) * cba[k][e >> 2][e & 3]) * gg; }
            u32x4 w; w.x = pk2(r[0], r[1]); w.y = pk2(r[2], r[3]); w.z = pk2(r[4], r[5]); w.w = pk2(r[6], r[7]);
            *(u32x4*)((unsigned char*)G + (dry ? HL_BYTES : 0) + go[k]) = w;
        }
    }
}
__device__ __forceinline__ void lru_carry_phase(const Args& a, const int z, LAS unsigned char* lds) {
    int tid_ = threadIdx.x; asm volatile("" : "+v"(tid_));
    const int tid = tid_, seg = tid >> 4, cl = tid & 15;
    const f32x2* SUM = (const f32x2*)((a.ws + z) + WS_SUM); float* CIN = (float*)((a.ws + z) + WS_CIN);
    LAS f32x2* SEG = (LAS f32x2*)lds;
    for (int wg = blockIdx.x; wg < 320; wg += gridDim.x) {
        const int chain = wg * 16 + cl, b = chain / 2560, dir = (chain / LW) & 1, ch = chain % LW;
        f32x2 v[17]; float A = 1.f, Hh = 0.f;
#pragma unroll
        for (int e = 0; e < 17; ++e) { const int s = seg * 17 + e; int c;
            if (s < 8) c = 1024 + b * 8 + (dir ? 7 - s : s); else { const int li = s - 8; c = b * 512 + (dir ? 511 - li : li); }
            v[e] = (s < 520) ? SUM[(size_t)(c * 2 + dir) * LW + ch] : (f32x2){1.f, 0.f}; }
#pragma unroll
        for (int e = 0; e < 17; ++e) { Hh = v[e][0] * Hh + v[e][1]; A *= v[e][0]; }
        __syncthreads();
        SEG[seg * 16 + cl] = (f32x2){A, Hh};
        __syncthreads();
        float Hc = 0.f;
        for (int q = 0; q < seg; ++q) { const f32x2 sv = SEG[q * 16 + cl]; Hc = sv[0] * Hc + sv[1]; }
#pragma unroll
        for (int e = 0; e < 17; ++e) { const int s = seg * 17 + e; int c;
            if (s < 8) c = 1024 + b * 8 + (dir ? 7 - s : s); else { const int li = s - 8; c = b * 512 + (dir ? 511 - li : li); }
            if (s < 520) CIN[(size_t)(c * 2 + dir) * LW + ch] = Hc;
            Hc = v[e][0] * Hc + v[e][1]; }
    }
    __syncthreads();
}

#define XB_TMO      128
#define XB_XCNT(j)  (256  + 64 * (j))
#define XB_XSUB(j)  (1280 + 64 * (j))
#define XB_XGEN(j)  (2304 + 64 * (j))
#define XB_TOP      3328
#define XB_TOPGEN   3392
#define XCD_BAR_WORDS 3456
#define XB_SPIN_CAP (1u << 18)
__device__ __forceinline__ unsigned xb_ld(unsigned* p)              { return __hip_atomic_load(p, __ATOMIC_RELAXED, __HIP_MEMORY_SCOPE_AGENT); }
__device__ __forceinline__ unsigned xb_add(unsigned* p, unsigned v) { return __hip_atomic_fetch_add(p, v, __ATOMIC_RELAXED, __HIP_MEMORY_SCOPE_AGENT); }
__device__ __forceinline__ unsigned xb_xcc_id() { return (unsigned)__builtin_amdgcn_s_getreg((3 << 11) | 20) & 0xFu; }
#define XB_SPIN(cond, bar) do { unsigned _sp = 0; while (cond) { __builtin_amdgcn_s_sleep(1); \
    if ((++_sp & 255u) == 0u) { if (xb_ld(&(bar)[XB_TMO])) break; if (_sp > XB_SPIN_CAP) { atomicAdd(&(bar)[XB_TMO], 1u); break; } } } } while (0)
struct XcdBarrier { unsigned* bar; unsigned x; volatile LAS unsigned* st; };
__device__ __forceinline__ XcdBarrier xcd_barrier_post(unsigned* bar, volatile LAS unsigned* st) {
    XcdBarrier b; b.bar = bar; b.x = xb_xcc_id(); b.st = st;
    if (threadIdx.x == 0) (void)xb_add(&bar[XB_XCNT(b.x)], 1u);
    return b;
}
__device__ __forceinline__ void xcd_barrier_complete(unsigned* bar, unsigned x, unsigned& nloc, unsigned& nx) {
    const unsigned G = gridDim.x * gridDim.y * gridDim.z;
    unsigned sum, cnt, mine, sp = 0u;
    for (;;) {
        sum = 0u; cnt = 0u; mine = 0u;
#pragma unroll
        for (unsigned j = 0; j < 16; ++j) { const unsigned c = xb_ld(&bar[XB_XCNT(j)]); sum += c; cnt += (c > 0u) ? 1u : 0u; mine = (j == x) ? c : mine; }
        if (sum == G) break;
        __builtin_amdgcn_s_sleep(1);
        if ((++sp & 255u) == 0u) { if (xb_ld(&bar[XB_TMO])) break; if (sp > XB_SPIN_CAP) { atomicAdd(&bar[XB_TMO], 1u); break; } }
    }
    nloc = mine > 0u ? mine : 1u; nx = cnt > 0u ? cnt : 1u;
}
__device__ __forceinline__ void xcd_barrier(const XcdBarrier& b) {
    asm volatile("s_waitcnt vmcnt(0)" ::: "memory");
    __syncthreads();
    if (threadIdx.x == 0) {
        unsigned* bar = b.bar;
        __builtin_amdgcn_s_waitcnt(0);
        unsigned nloc = b.st[0], nx = b.st[1];
        if (nloc == 0u) { xcd_barrier_complete(bar, b.x, nloc, nx); b.st[0] = nloc; b.st[1] = nx; }
        const unsigned old = xb_add(&bar[XB_XSUB(b.x)], 1u);
        const unsigned gen = old / nloc;
        if (old + 1u == (gen + 1u) * nloc) {
            __builtin_amdgcn_fence(__ATOMIC_RELEASE, "agent");
            asm volatile("s_waitcnt vmcnt(0)" ::: "memory");
            const unsigned og = xb_add(&bar[XB_TOP], 1u);
            const unsigned tg = og / nx;
            if (og + 1u == (tg + 1u) * nx) xb_add(&bar[XB_TOPGEN], 1u);
            else XB_SPIN(xb_ld(&bar[XB_TOPGEN]) == tg, bar);
            __builtin_amdgcn_fence(__ATOMIC_ACQUIRE, "agent");
            xb_add(&bar[XB_XGEN(b.x)], 1u);
            asm volatile("s_waitcnt vmcnt(0)" ::: "memory");
        } else {
            XB_SPIN(xb_ld(&bar[XB_XGEN(b.x)]) == gen, bar);
            __builtin_amdgcn_fence(__ATOMIC_ACQUIRE, "agent");
            asm volatile("s_waitcnt vmcnt(0)" ::: "memory");
        }
    }
    __syncthreads();
}
#ifndef DBL_MASK
#define DBL_MASK 0
#endif
#ifndef EN_MASK
#define EN_MASK 0xffff
#endif
#define EN(t) ((EN_MASK >> (t)) & 1)
enum { PT_PREP = 0, PT_NORM = 1, PT_G1 = 2, PT_PLAIN = 3, PT_QK = 4, PT_ATT = 5, PT_IN = 6, PT_L2 = 7, PT_L3 = 8, PT_L4 = 9 };
__global__ void __launch_bounds__(512, 2) mega_fwd(Args a) {
    extern __shared__ __attribute__((aligned(16))) unsigned char lds_raw[];
    LAS unsigned char* lds = (LAS unsigned char*)lds_raw;
    cg::grid_group grid = cg::this_grid();
    volatile LAS unsigned* bst = (volatile LAS unsigned*)(lds + LDS_BYTES - 64);
    if (threadIdx.x < 2) bst[threadIdx.x] = 0u;
    __syncthreads();
    const XcdBarrier xbar = xcd_barrier_post((unsigned*)a.ws, bst);
    for (int ph = a.ph_lo; ph < a.ph_hi; ++ph) {
        int z; asm volatile("s_mov_b32 %0, 0" : "=s"(z));
        bf16* HB = (bf16*)((a.ws + z) + WS_HB); bf16* YB = (bf16*)((a.ws + z) + WS_YB); bf16* BIG = (bf16*)((a.ws + z) + WS_BIG);
        const unsigned pd = a.pdesc[ph + z];
        const int type = pd & 0xff, i = (pd >> 8) & 0xff, s = (pd >> 16) & 0xff, sub = (pd >> 24) & 0xff, j = i >> 1;
        for (int rep = ((DBL_MASK >> type) & 1) ? 0 : 1; rep < 2; ++rep) {
        const bool dry = rep == 0;
        if (rep == 1 && DBL_MASK) __syncthreads();
        if (type == PT_PREP && EN(PT_PREP)) prep_phase(a, z, lds);
        else if (type == PT_NORM && EN(PT_NORM)) {
            int res_l = (s > 0) ? i : i - 1, res_s = (s > 0) ? s - 1 : 2;
            const float res_w = (res_s == 1) ? 1.0f : 0.5f;
            norm_phase(a, z, res_l, res_s, res_w, i < 4 ? i : -1, s, dry);
        } else if (type == PT_G1 && EN(PT_G1)) {
            const bf16* W1t = (const bf16*)((a.ws + z) + WS_W) + (size_t)(i * 2 + (s >> 1)) * (W1T_BYTES / 2);
            EpiSwiGLU E{BIG}; run_gemm(lds, HB, W1t, (i == 3 && s == 2) ? ML : MT, 2 * FF, D, E);
        } else if (type == PT_PLAIN && EN(PT_PLAIN)) {
            const bf16* A = BIG; const bf16* Bt; int Mg = MT, Ng = D, K; bf16* O = YB; int ldc = D;
            if (sub == 0) { Bt = (const bf16*)((a.ws + z) + WS_W + 88 * MiB) + (size_t)(i * 2 + (s >> 1)) * (W2T_BYTES / 2); K = FF; }
            else if (sub == 1) { Bt = (const bf16*)((a.ws + z) + WS_W + 132 * MiB) + (size_t)j * (4 * MiB) + 3 * MiB; K = D; }
            else if (sub == 2) { Bt = (const bf16*)((a.ws + z) + WS_W + 148 * MiB) + (size_t)j * (9 * MiB / 2) + LRU_WOL / 2; K = LW; }
            else { A = (const bf16*)((a.ws + z) + WS_W + 132 * MiB) + (size_t)j * (4 * MiB) + 2 * MiB; Bt = HB; Mg = D; Ng = MT; K = D; O = BIG + 2 * ACT_ELEMS; ldc = MT; }
            if (i == 3 && s >= 1 && sub != 3) Mg = ML;
            pg8::EpiBf16<0> E{O, ldc, nullptr, 0, 0}; run_gemm(lds, A, Bt, Mg, Ng, K, E);
        } else if (type == PT_QK && EN(PT_QK)) {
            const bf16* Wn = (const bf16*)((a.ws + z) + WS_W + 132 * MiB) + (size_t)j * (4 * MiB);
            EpiRope E{BIG, BIG + ACT_ELEMS, (const float*)((a.ws + z) + WS_ROPE), (const float*)((a.ws + z) + WS_ROPE) + SEQ * 32};
            run_gemm(lds, HB, Wn, MT, 2048, D, E);
        } else if (type == PT_ATT && EN(PT_ATT)) attn_phase(a, z, j, lds, dry);
        else if (type == PT_IN && EN(PT_IN)) {
            const bf16* Wl = (const bf16*)((a.ws + z) + WS_W + 148 * MiB) + (size_t)j * (9 * MiB / 2);
            EpiGeluSplit E{BIG, BIG + (size_t)MT * LW}; run_gemm(lds, HB, Wl, MT, 2 * LW, D, E);
        } else if (type == PT_L2 && EN(PT_L2)) lru_scan_phase(a, z, j, lds);
        else if (type == PT_L3 && EN(PT_L3)) lru_carry_phase(a, z, lds);
        else if (type == PT_L4 && EN(PT_L4)) lru_apply_phase(a, z, dry);
        }
        if (ph + 1 < a.ph_hi) { if (ph == a.ph_lo) grid.sync(); else xcd_barrier(xbar); }
    }
}
constexpr int N_PHASES = 48;

#ifndef MK_MULTI
#define MK_MULTI 0
#endif
extern "C" void kernel_launch(void* const* d_in, const int* in_sizes, int n_in, void* d_out, int out_size, void* d_ws, size_t ws_size, hipStream_t stream) {
    static int grid = 0;
    if (grid == 0) {
        int dev = 0, cus = 0, per_cu = 0;
        hipGetDevice(&dev);
        hipDeviceGetAttribute(&cus, hipDeviceAttributeMultiprocessorCount, dev);
        if (hipFuncSetAttribute((const void*)mega_fwd, hipFuncAttributeMaxDynamicSharedMemorySize, LDS_BYTES) != hipSuccess) { fprintf(stderr, "hipFuncSetAttribute failed\n"); grid = -1; return; }
        if (hipOccupancyMaxActiveBlocksPerMultiprocessor(&per_cu, (const void*)mega_fwd, 512, LDS_BYTES) != hipSuccess || per_cu < 1) { fprintf(stderr, "occupancy query: %d\n", per_cu); per_cu = 1; }
        (void)hipGetLastError();
        grid = cus * per_cu;
        if (ws_size < WS_END || n_in != 23) { fprintf(stderr, "kernel_launch: ws %zu n_in %d\n", ws_size, n_in); grid = -1; return; }
    }
    if (grid < 0) return;
    Args a{};
    for (int i = 0; i < 23; ++i) a.in[i] = (const float*)d_in[i];
    a.out = (float*)d_out; a.ws = (unsigned char*)d_ws;
    int nj = 0, tiles = 0;
    auto add = [&](int in_idx, long long src_off, size_t dst_off, int K, int N, int ldn, int ldk, int map, int ncol0) {
        TJob& t = a.jobs[nj++]; t.src_off = src_off; t.dst_off = (long long)dst_off; t.in_idx = in_idx; t.map = map; t.ldn = ldn; t.ldk = ldk; t.nnt = N / 64; t.tile0 = tiles; t.ncol0 = ncol0; t.pad = 0;
        tiles += (K / 64) * (N / 64);
    };
    for (int i = 0; i < 4; ++i) for (int f = 0; f < 2; ++f) {
        add(8, (long long)(i * 2 + f) * D * FF, off_w1t(i, f), D, FF, FF, D, 1, 0);
        add(9, (long long)(i * 2 + f) * D * FF, off_w1t(i, f), D, FF, FF, D, 2, 0);
        add(10, (long long)(i * 2 + f) * FF * D, off_w2t(i, f), FF, D, D, FF, 0, 0);
    }
    for (int j = 0; j < 2; ++j) {
        add(11, (long long)j * D * 3 * D, off_na(j), D, 2 * D, 3 * D, D, 3, 0);
        add(11, (long long)j * D * 3 * D, off_na(j) + 4 * MiB, D, D, 3 * D, D, 0, 2 * D);
        add(12, (long long)j * D * D, off_na(j) + 6 * MiB, D, D, D, D, 0, 0);
        add(14, (long long)j * D * 2 * LW, off_lru(j), D, 2 * LW, 2 * LW, D, 0, 0);
        add(22, (long long)j * LW * D, off_lru(j) + LRU_WOL, LW, D, D, LW, 0, 0);
        for (int d = 0; d < 2; ++d) {
            add(17, (long long)(j * 2 + d) * 10 * 128 * 128, off_lru(j) + LRU_WG + (size_t)(d * 2 + 0) * 10 * 128 * 128 * 2, LW, 128, 128, 128, 4, 0);
            add(19, (long long)(j * 2 + d) * 10 * 128 * 128, off_lru(j) + LRU_WG + (size_t)(d * 2 + 1) * 10 * 128 * 128 * 2, LW, 128, 128, 128, 4, 0);
        }
    }
    a.njobs = nj; a.ntiles = tiles;
    {
        int np = 0;
        auto P = [&](int type, int i, int s, int sub) { a.pdesc[np++] = (unsigned)type | ((unsigned)i << 8) | ((unsigned)s << 16) | ((unsigned)sub << 24); };
        P(PT_PREP, 0, 0, 0);
        for (int i = 0; i < 4; ++i) for (int s = 0; s < 3; ++s) {
            P(PT_NORM, i, s, 0);
            if (s != 1) { P(PT_G1, i, s, 0); P(PT_PLAIN, i, s, 0); }
            else if ((i & 1) == 0) { P(PT_QK, i, s, 0); P(PT_PLAIN, i, s, 3); P(PT_ATT, i, s, 0); P(PT_PLAIN, i, s, 1); }
            else { P(PT_IN, i, s, 0); P(PT_L2, i, s, 0); P(PT_L3, i, s, 0); P(PT_L4, i, s, 0); P(PT_PLAIN, i, s, 2); }
        }
        P(PT_NORM, 4, 0, 0);
        if (np != N_PHASES) { fprintf(stderr, "phase count %d\n", np); return; }
    }
#if MK_MULTI
    for (int p = 0; p < N_PHASES; ++p) { a.ph_lo = p; a.ph_hi = p + 1; hipLaunchKernelGGL(mega_fwd, dim3(grid), dim3(512), LDS_BYTES, stream, a); }
#else
    a.ph_lo = 0; a.ph_hi = N_PHASES;
    if (hipMemsetAsync(d_ws, 0, 16384, stream) != hipSuccess) { fprintf(stderr, "memset failed\n"); return; }
    void* kargs[] = {&a};
    hipError_t e = hipLaunchCooperativeKernel((const void*)mega_fwd, dim3(grid), dim3(512), kargs, LDS_BYTES, stream);
    if (e != hipSuccess) fprintf(stderr, "cooperative launch failed: %s (grid %d)\n", hipGetErrorString(e), grid);
#endif
}
```

```cpp
#include <hip/hip_runtime.h>
namespace pg8 {
#define PG8_LAS __attribute__((address_space(3)))
typedef unsigned short bf16_t;
typedef short bf16x8 __attribute__((ext_vector_type(8)));
typedef float f32x4 __attribute__((ext_vector_type(4)));
typedef unsigned u32x4 __attribute__((ext_vector_type(4)));
constexpr int BM = 256, BK = 64, HALF = 128, HTB = HALF * BK * 2  , STAGE_BYTES = 8 * HTB, NXCD = 8, WGM = 8;

__host__ __device__ __forceinline__ int lds_byte(int r, int c) { const int st = (r >> 4) * 2 + (c >> 5), rr = r & 15, cc = c & 31, ob = rr * 64 + cc * 2; return st * 1024 + (ob ^ (((ob >> 9) & 1) << 5)); }
__host__ __device__ __forceinline__ void stage_rc(int b, int& R, int& C) { const int st = b / 1024, sb = b % 1024, swz = sb ^ (((sb >> 9) & 1) << 5); R = (st >> 1) * 16 + swz / 64; C = (st & 1) * 32 + (swz % 64) / 2; }
__host__ __device__ __forceinline__ int perm32(int rho) { const int n = rho >> 4, i = rho & 15; return 8 * (i >> 2) + 4 * n + (i & 3); }

struct Unit { int pm, pn; };
struct Gemm { const bf16_t* A; const bf16_t* Bt; int M, N, K; };

struct StaticOrder {
    int nM, nN, nwg, G, c;
    __host__ __device__ void init(int M, int N, int G_, int c_) { nM = M / BM; nN = N / BM; nwg = nM * nN; G = G_; c = c_; }
    __host__ __device__ bool next(int i, Unit& u) const {
        const long L = (long)i * G + c; if (L >= nwg) return false;
        int wgid = (int)L; { const int q = nwg / NXCD, r = nwg % NXCD, xcd = wgid % NXCD, off = wgid / NXCD; wgid = (xcd < r ? xcd * (q + 1) : r * (q + 1) + (xcd - r) * q) + off; }
        const int nig = WGM * nN, gid = wgid / nig, fm = gid * WGM, gsz = (nM - fm) < WGM ? (nM - fm) : WGM;
        u.pm = fm + ((wgid % nig) % gsz); u.pn = (wgid % nig) / gsz; return true;
    }
    __device__ __forceinline__ void a_ready(const Unit&) const {}
    __device__ __forceinline__ void done(const Unit&) const {}
};
struct CountedOrder : StaticOrder {
    const unsigned* ready; unsigned need; unsigned* tmo;
    __device__ __forceinline__ void a_ready(const Unit& u) const {
        if (threadIdx.x < 64) {
            const unsigned long long t0 = __builtin_amdgcn_s_memrealtime(); unsigned polls = 0;
            while ((unsigned)__builtin_amdgcn_readfirstlane(__hip_atomic_load(ready + 64 * u.pm, __ATOMIC_RELAXED, __HIP_MEMORY_SCOPE_AGENT)) < need) {
                if ((++polls & 255u) == 0u && __builtin_amdgcn_readfirstlane(__hip_atomic_load(tmo, __ATOMIC_RELAXED, __HIP_MEMORY_SCOPE_AGENT)) != 0u) break;
                if (__builtin_amdgcn_s_memrealtime() - t0 > 2000000ull) {
                    if (threadIdx.x == 0) { unsigned expect = 0u; __hip_atomic_compare_exchange_strong(tmo + 1, &expect, 0x600u | (unsigned)(u.pm & 0xff), __ATOMIC_RELAXED, __ATOMIC_RELAXED, __HIP_MEMORY_SCOPE_AGENT); __hip_atomic_store(tmo, 1u, __ATOMIC_RELAXED, __HIP_MEMORY_SCOPE_AGENT); }
                    break; }
                __builtin_amdgcn_s_sleep(2); }
            __builtin_amdgcn_fence(__ATOMIC_ACQUIRE, "agent");
            asm volatile("s_waitcnt vmcnt(0)" ::: "memory");
        }
#if !defined(BROKEN_HOOK_NO_BARRIER)
        asm volatile("" ::: "memory"); __builtin_amdgcn_s_barrier(); asm volatile("" ::: "memory");
#endif
    }
};

__device__ __forceinline__ unsigned cvt_pk_bf16(float lo, float hi) { unsigned r; asm volatile("v_cvt_pk_bf16_f32 %0, %1, %2" : "=v"(r) : "v"(lo), "v"(hi)); return r; }
typedef float f32x2 __attribute__((ext_vector_type(2)));
__device__ __forceinline__ f32x2 gelu_pk(f32x2 v) {
    const f32x2 av = __builtin_elementwise_abs(v), d = av * 0.2316418882f + 1.0f;
    f32x2 t; t.x = __builtin_amdgcn_rcpf(d.x); t.y = __builtin_amdgcn_rcpf(d.y);
    f32x2 q = t * 0.5307027145f + (-0.7265760135f); q = q * t + 0.7107068705f; q = q * t + (-0.142248368f); q = q * t + 0.127414796f; q = q * t;
    const f32x2 s = (v * v) * (-0.72134752044f);
    f32x2 e; e.x = __builtin_amdgcn_exp2f(s.x); e.y = __builtin_amdgcn_exp2f(s.y);
    const f32x2 m = v * (q * e), r = v - m;
    f32x2 o; o.x = v.x < 0.f ? m.x : r.x; o.y = v.y < 0.f ? m.y : r.y; return o;
}

struct EpiF32 {
    static constexpr bool PERM = false, AFTER_DRAIN = false;
    float* C; int ldc; const float* bias;
    __device__ __forceinline__ void operator()(const f32x4 (&acc)[2][2][4][2], const Unit& u, int wr, int wc, int fr, int fq) const {
        const int row0 = u.pm * BM + wr * 64 + fr, col0 = u.pn * BM + wc * 32 + 4 * fq;
        f32x4 bv[2][2];
#pragma unroll
        for (int bj = 0; bj < 2; ++bj)
#pragma unroll
            for (int n = 0; n < 2; ++n) bv[bj][n] = bias ? *(const f32x4*)(bias + col0 + bj * HALF + n * 16) : (f32x4){0.f, 0.f, 0.f, 0.f};
#pragma unroll
        for (int ai = 0; ai < 2; ++ai)
#pragma unroll
            for (int m = 0; m < 4; ++m) { float* rowp = C + (size_t)(row0 + ai * HALF + m * 16) * ldc + col0;
#pragma unroll
                for (int bj = 0; bj < 2; ++bj)
#pragma unroll
                    for (int n = 0; n < 2; ++n) *(f32x4*)(rowp + bj * HALF + n * 16) = acc[ai][bj][m][n] + bv[bj][n]; }
    }
};
template <int ACT  > struct EpiBf16 {
    static constexpr bool PERM = true, AFTER_DRAIN = false;
    bf16_t* O; int ldc; const float* bias; int split_cols; size_t split_stride;
    __device__ __forceinline__ void operator()(const f32x4 (&acc)[2][2][4][2], const Unit& u, int wr, int wc, int fr, int fq) const {
        const int row0 = u.pm * BM + wr * 64 + fr; int colt = u.pn * BM; bf16_t* base = O;
        if (split_cols) { const int t = colt / split_cols; base += (size_t)t * split_stride; colt -= t * split_cols; }
        const int col0 = colt + wc * 32 + 8 * fq, bcol0 = u.pn * BM + wc * 32 + 8 * fq;
        f32x4 bv[2][2];
#pragma unroll
        for (int bj = 0; bj < 2; ++bj)
#pragma unroll
            for (int n = 0; n < 2; ++n) bv[bj][n] = bias ? *(const f32x4*)(bias + bcol0 + bj * HALF + 4 * n) : (f32x4){0.f, 0.f, 0.f, 0.f};
#pragma unroll
        for (int ai = 0; ai < 2; ++ai)
#pragma unroll
            for (int m = 0; m < 4; ++m) { bf16_t* rowp = base + (size_t)(row0 + ai * HALF + m * 16) * ldc + col0;
#pragma unroll
                for (int bj = 0; bj < 2; ++bj) { f32x4 v0 = acc[ai][bj][m][0] + bv[bj][0], v1 = acc[ai][bj][m][1] + bv[bj][1];
                    if (ACT == 1) { f32x2 a = gelu_pk((f32x2){v0[0], v0[1]}), b = gelu_pk((f32x2){v0[2], v0[3]}), c = gelu_pk((f32x2){v1[0], v1[1]}), d = gelu_pk((f32x2){v1[2], v1[3]});
                        v0 = (f32x4){a.x, a.y, b.x, b.y}; v1 = (f32x4){c.x, c.y, d.x, d.y}; }
                    if (ACT == 2) {
#pragma unroll
                        for (int j = 0; j < 4; ++j) { v0[j] = 0.5f * v0[j] * (1.0f + erff(v0[j] * 0.70710678f)); v1[j] = 0.5f * v1[j] * (1.0f + erff(v1[j] * 0.70710678f)); } }
                    u32x4 w; w.x = cvt_pk_bf16(v0[0], v0[1]); w.y = cvt_pk_bf16(v0[2], v0[3]); w.z = cvt_pk_bf16(v1[0], v1[1]); w.w = cvt_pk_bf16(v1[2], v1[3]);
                    *(u32x4*)(rowp + bj * HALF) = w; } }
    }
};

struct PanelStats {
    unsigned* xbuf;
    unsigned* cnt;
    unsigned* tmo;
    int ntn; float eps;
    unsigned code;
    __device__ __forceinline__ bool run(const f32x4 (&v)[2][2][4][2], const Unit& u, int wr, int wc, int fr, int fq, PG8_LAS unsigned char* lds, int wid, int lane) const {
        typedef float f32x2v __attribute__((ext_vector_type(2)));
        PG8_LAS f32x2v* P = (PG8_LAS f32x2v*)lds;
        PG8_LAS f32x2v* S = (PG8_LAS f32x2v*)(lds + 8192);
        PG8_LAS unsigned* flag = (PG8_LAS unsigned*)(lds + 8192 + 2048);
#pragma unroll
        for (int ai = 0; ai < 2; ++ai)
#pragma unroll
            for (int m = 0; m < 4; ++m) {
                float s = 0.f;
#pragma unroll
                for (int bj = 0; bj < 2; ++bj)
#pragma unroll
                    for (int n = 0; n < 2; ++n) { const f32x4 x = v[ai][bj][m][n]; s += (x[0] + x[1]) + (x[2] + x[3]); }
                s += __shfl_xor(s, 16); s += __shfl_xor(s, 32);
                const float mw = s * (1.0f / 64.0f); float q = 0.f;
#pragma unroll
                for (int bj = 0; bj < 2; ++bj)
#pragma unroll
                    for (int n = 0; n < 2; ++n) { const f32x4 d = v[ai][bj][m][n] - mw; q += (d[0] * d[0] + d[1] * d[1]) + (d[2] * d[2] + d[3] * d[3]); }
                q += __shfl_xor(q, 16); q += __shfl_xor(q, 32);
                if (fq == 0) P[(ai * HALF + wr * 64 + m * 16 + fr) * 4 + wc] = (f32x2v){mw, q};
            }
        asm volatile("s_waitcnt lgkmcnt(0)" ::: "memory"); __builtin_amdgcn_s_barrier(); asm volatile("" ::: "memory");
#if defined(BROKEN_NO_WAIT)
        if (blockIdx.x >= 64) { const long long t0 = clock64(); while (clock64() - t0 < 60000) __builtin_amdgcn_s_sleep(8); }
#endif
        const int row = wid * 32 + (lane & 31);
        if (lane < 32) {
            const f32x2v a = P[row * 4 + 0], b = P[row * 4 + 1], c = P[row * 4 + 2], d = P[row * 4 + 3];
            const float mt = (a.x + b.x + c.x + d.x) * 0.25f;
            const float da = a.x - mt, db = b.x - mt, dc = c.x - mt, dd = d.x - mt;
            const float m2 = (a.y + b.y) + (c.y + d.y) + 64.0f * ((da * da + db * db) + (dc * dc + dd * dd));
            unsigned long long* slot = (unsigned long long*)xbuf + ((size_t)(u.pm * BM + row) * 4 + u.pn);
            __hip_atomic_store(slot, ((unsigned long long)__float_as_uint(m2) << 32) | __float_as_uint(mt), __ATOMIC_RELAXED, __HIP_MEMORY_SCOPE_AGENT);
        }
        asm volatile("s_waitcnt vmcnt(0)" ::: "memory");
        if (lane == 0) __hip_atomic_fetch_add(cnt + 64 * u.pm, 1u, __ATOMIC_RELAXED, __HIP_MEMORY_SCOPE_AGENT);
        if (wid == 0) {
            bool dead = false; const unsigned long long t0 = __builtin_amdgcn_s_memrealtime(); const unsigned want = 8u * (unsigned)ntn;
            for (;;) {
#if defined(BROKEN_NO_WAIT)
                break;
#endif
                if ((unsigned)__builtin_amdgcn_readfirstlane(__hip_atomic_load(cnt + 64 * u.pm, __ATOMIC_RELAXED, __HIP_MEMORY_SCOPE_AGENT)) >= want) break;
                if (__builtin_amdgcn_s_memrealtime() - t0 > 2000000ull) {
                    if (lane == 0) { unsigned expect = 0u; __hip_atomic_compare_exchange_strong(tmo + 1, &expect, code | (unsigned)(u.pm & 0xff), __ATOMIC_RELAXED, __ATOMIC_RELAXED, __HIP_MEMORY_SCOPE_AGENT);
                                     __hip_atomic_store(tmo, 1u, __ATOMIC_RELAXED, __HIP_MEMORY_SCOPE_AGENT); }
                    dead = true; break; }
                __builtin_amdgcn_s_sleep(2);
            }
            __builtin_amdgcn_fence(__ATOMIC_ACQUIRE, "agent");
            if (lane == 0) flag[0] = dead ? 1u : 0u;
        }
        asm volatile("s_waitcnt vmcnt(0) lgkmcnt(0)" ::: "memory"); __builtin_amdgcn_s_barrier(); asm volatile("" ::: "memory");
        const bool bad = flag[0] != 0u;
        if (lane < 32) {
            const unsigned long long* slot = (const unsigned long long*)xbuf + (size_t)(u.pm * BM + row) * 4; float mt[4], m2[4]; float ms = 0.f;
#pragma unroll
            for (int t = 0; t < 4; ++t) { if (t < ntn) { const unsigned long long w = __hip_atomic_load(slot + t, __ATOMIC_RELAXED, __HIP_MEMORY_SCOPE_AGENT); mt[t] = __uint_as_float((unsigned)w); m2[t] = __uint_as_float((unsigned)(w >> 32)); } else { mt[t] = 0.f; m2[t] = 0.f; } ms += mt[t]; }
            const float mean = ms / (float)ntn; float q = 0.f;
#pragma unroll
            for (int t = 0; t < 4; ++t) if (t < ntn) { const float dm = mt[t] - mean; q += m2[t] + 256.0f * dm * dm; }
            S[row] = (f32x2v){mean, 1.0f / sqrtf(q / (256.0f * (float)ntn) + eps)};
        }
        asm volatile("s_waitcnt lgkmcnt(0)" ::: "memory"); __builtin_amdgcn_s_barrier(); asm volatile("" ::: "memory");
        return bad;
    }
};
struct EpiLnRes {
    static constexpr bool PERM = false, AFTER_DRAIN = true;
    const float* base; float* out; int ldc; const float* bias; PanelStats st; unsigned poison;
    __device__ __forceinline__ void refuse(size_t i0, size_t stride, int M, int N) const { const float q = __builtin_nanf(""); for (size_t i = i0; i < (size_t)M * N; i += stride) out[(i / N) * ldc + i % N] = q;
        if (i0 == 0) { unsigned expect = 0u; __hip_atomic_compare_exchange_strong(st.tmo + 1, &expect, 0x7f0u, __ATOMIC_RELAXED, __ATOMIC_RELAXED, __HIP_MEMORY_SCOPE_AGENT); __hip_atomic_store(st.tmo, 1u, __ATOMIC_RELAXED, __HIP_MEMORY_SCOPE_AGENT); } }
    __device__ __forceinline__ void fused(f32x4 (&acc)[2][2][4][2], const Unit& u, int wr, int wc, int fr, int fq, PG8_LAS unsigned char* lds, int wid, int lane) const {
        typedef float f32x2v __attribute__((ext_vector_type(2)));
        const PG8_LAS f32x2v* S = (const PG8_LAS f32x2v*)(lds + 8192);
        const int col0 = u.pn * BM + wc * 32 + 4 * fq;
#pragma unroll
        for (int bj = 0; bj < 2; ++bj)
#pragma unroll
            for (int n = 0; n < 2; ++n) { const f32x4 bv = bias ? *(const f32x4*)(bias + col0 + bj * HALF + n * 16) : (f32x4){0.f, 0.f, 0.f, 0.f};
#pragma unroll
                for (int ai = 0; ai < 2; ++ai)
#pragma unroll
                    for (int m = 0; m < 4; ++m) acc[ai][bj][m][n] += bv; }
        const bool bad = st.run(acc, u, wr, wc, fr, fq, lds, wid, lane) || poison != 0u;
        const float qnan = __builtin_nanf("");
#pragma unroll
        for (int ai = 0; ai < 2; ++ai)
#pragma unroll
            for (int m = 0; m < 4; ++m) { const int r = ai * HALF + wr * 64 + m * 16 + fr; const f32x2v sr = S[r]; const size_t off = (size_t)(u.pm * BM + r) * ldc + col0;
#pragma unroll
                for (int bj = 0; bj < 2; ++bj)
#pragma unroll
                    for (int n = 0; n < 2; ++n) { const f32x4 bs = *(const f32x4*)(base + off + bj * HALF + n * 16); f32x4 o = bs + (acc[ai][bj][m][n] - sr.x) * sr.y;
                        if (bad) o = (f32x4){qnan, qnan, qnan, qnan}; *(f32x4*)(out + off + bj * HALF + n * 16) = o; }
                asm volatile("" ::: "memory"); }
    }
};
struct EpiLnResLn {
    static constexpr bool PERM = false, AFTER_DRAIN = true;
    const float* base; float* out; bf16_t* xn; int ldc; const float* bias; PanelStats st1, st2; unsigned poison;
    __device__ __forceinline__ void refuse(size_t i0, size_t stride, int M, int N) const { const float q = __builtin_nanf(""); for (size_t i = i0; i < (size_t)M * N; i += stride) { const size_t o = (i / N) * ldc + i % N; out[o] = q; xn[o] = (bf16_t)0x7fc0u; }
        if (i0 == 0) { unsigned expect = 0u; __hip_atomic_compare_exchange_strong(st1.tmo + 1, &expect, 0x7f0u, __ATOMIC_RELAXED, __ATOMIC_RELAXED, __HIP_MEMORY_SCOPE_AGENT); __hip_atomic_store(st1.tmo, 1u, __ATOMIC_RELAXED, __HIP_MEMORY_SCOPE_AGENT); } }
    __device__ __forceinline__ void fused(f32x4 (&acc)[2][2][4][2], const Unit& u, int wr, int wc, int fr, int fq, PG8_LAS unsigned char* lds, int wid, int lane) const {
        typedef float f32x2v __attribute__((ext_vector_type(2))); typedef unsigned u32x2v __attribute__((ext_vector_type(2)));
        const PG8_LAS f32x2v* S = (const PG8_LAS f32x2v*)(lds + 8192);
        const int col0 = u.pn * BM + wc * 32 + 4 * fq;
#pragma unroll
        for (int bj = 0; bj < 2; ++bj)
#pragma unroll
            for (int n = 0; n < 2; ++n) { const f32x4 bv = bias ? *(const f32x4*)(bias + col0 + bj * HALF + n * 16) : (f32x4){0.f, 0.f, 0.f, 0.f};
#pragma unroll
                for (int ai = 0; ai < 2; ++ai)
#pragma unroll
                    for (int m = 0; m < 4; ++m) acc[ai][bj][m][n] += bv; }
        bool bad = st1.run(acc, u, wr, wc, fr, fq, lds, wid, lane) || poison != 0u;
        const float qnan = __builtin_nanf("");
#pragma unroll
        for (int ai = 0; ai < 2; ++ai)
#pragma unroll
            for (int m = 0; m < 4; ++m) { const int r = ai * HALF + wr * 64 + m * 16 + fr; const f32x2v sr = S[r]; const size_t off = (size_t)(u.pm * BM + r) * ldc + col0;
#pragma unroll
                for (int bj = 0; bj < 2; ++bj)
#pragma unroll
                    for (int n = 0; n < 2; ++n) { const f32x4 bs = *(const f32x4*)(base + off + bj * HALF + n * 16); acc[ai][bj][m][n] = bs + (acc[ai][bj][m][n] - sr.x) * sr.y; }
                asm volatile("" : "+v"(acc[ai][0][m][0]), "+v"(acc[ai][0][m][1]), "+v"(acc[ai][1][m][0]), "+v"(acc[ai][1][m][1]));
                if (m & 1) asm volatile("" ::: "memory"); }
        const bool bad1 = bad;
        bad = st2.run(acc, u, wr, wc, fr, fq, lds, wid, lane) || bad;
#pragma unroll
        for (int ai = 0; ai < 2; ++ai)
#pragma unroll
            for (int m = 0; m < 4; ++m) { const int r = ai * HALF + wr * 64 + m * 16 + fr; const f32x2v sr = S[r]; const size_t off = (size_t)(u.pm * BM + r) * ldc + col0;
#pragma unroll
                for (int bj = 0; bj < 2; ++bj)
#pragma unroll
                    for (int n = 0; n < 2; ++n) { const f32x4 x1 = acc[ai][bj][m][n]; *(f32x4*)(out + off + bj * HALF + n * 16) = bad1 ? (f32x4){qnan, qnan, qnan, qnan} : x1;
                        const f32x4 o = (x1 - sr.x) * sr.y; u32x2v w; w.x = cvt_pk_bf16(o[0], o[1]); w.y = cvt_pk_bf16(o[2], o[3]);
                        if (bad) { w.x = 0x7fc07fc0u; w.y = 0x7fc07fc0u; } *(u32x2v*)(xn + off + bj * HALF + n * 16) = w; }
                asm volatile("" ::: "memory"); }
    }
};

template <class Epi, class Sched, bool ALIGN_EPI = false, bool SP2 = false>
__device__ __forceinline__ void gemm_phase(PG8_LAS unsigned char* lds, const Gemm g, const Sched& S, const Epi& E) {
    int tid_l = threadIdx.x; asm volatile("" : "+v"(tid_l));
    const int tid = tid_l, wid = __builtin_amdgcn_readfirstlane(tid >> 6), lane = tid & 63, wr = wid >> 2, wc = wid & 3, fr = lane & 15, fq = lane >> 4;
    const int K = g.K, nt = K / BK;
    unsigned voffA[2], voffB[2];
#pragma unroll
    for (int i = 0; i < 2; ++i) { int R, C; stage_rc(tid * 16 + i * 8192, R, C); const int Rb = Epi::PERM ? ((R & ~31) + perm32(R & 31)) : R;
        voffA[i] = (unsigned)(R * K + C) * 2u; voffB[i] = (unsigned)(Rb * K + C) * 2u; }
    const size_t kstep = (size_t)(BK * 2);
    const size_t hstep = (size_t)HALF * K * 2;
    const size_t tstep = 2 * hstep;
    const unsigned ldsw = (unsigned)wid * 1024u;
    const int aoff = lds_byte(wr * 64 + fr, fq * 8), boff = lds_byte(wc * 32 + fr, fq * 8);
#define PG8_SA(b, h) (((b) * 2 + (h)) * HTB)
#define PG8_SB(b, h) ((4 + (b) * 2 + (h)) * HTB)
#define PG8_STAGE(bufoff, gbase, voff) do { _Pragma("unroll") for (int _i = 0; _i < 2; ++_i) \
        __builtin_amdgcn_global_load_lds((const unsigned*)((const char*)(gbase) + (voff)[_i]), (PG8_LAS unsigned*)(lds + (bufoff) + ldsw + _i * 8192), 16, 0, 0); } while (0)
#define PG8_LDA(dst, b, h) do { _Pragma("unroll") for (int m = 0; m < 4; ++m) _Pragma("unroll") for (int k = 0; k < 2; ++k) dst[m][k] = *(const PG8_LAS bf16x8*)(lds + PG8_SA(b, h) + aoff + m * 2048 + k * 1024); } while (0)
#define PG8_LDB(dst, b, h) do { _Pragma("unroll") for (int n = 0; n < 2; ++n) _Pragma("unroll") for (int k = 0; k < 2; ++k) dst[n][k] = *(const PG8_LAS bf16x8*)(lds + PG8_SB(b, h) + boff + n * 2048 + k * 1024); } while (0)
#define PG8_MMA(ai, bj, At, Bt) do { __builtin_amdgcn_s_setprio(1); _Pragma("unroll") for (int m = 0; m < 4; ++m) _Pragma("unroll") for (int n = 0; n < 2; ++n) _Pragma("unroll") for (int k = 0; k < 2; ++k) \
        acc[ai][bj][m][n] = __builtin_amdgcn_mfma_f32_16x16x32_bf16(Bt[n][k], At[m][k], acc[ai][bj][m][n], 0, 0, 0); __builtin_amdgcn_s_setprio(0); } while (0)
#define PG8_WAIT_V(n) asm volatile("s_waitcnt vmcnt(" #n ")" ::: "memory")
#define PG8_WAIT_L(n) asm volatile("s_waitcnt lgkmcnt(" #n ")" ::: "memory")
#define PG8_BAR __builtin_amdgcn_s_barrier()
#define PG8_SCHED __builtin_amdgcn_sched_barrier(0)
    Unit cur, nxt; int ui = 0;
    if (!S.next(0, cur)) return;
    f32x4 acc[2][2][4][2];
#pragma unroll
    for (int a = 0; a < 2; ++a)
#pragma unroll
        for (int b = 0; b < 2; ++b)
#pragma unroll
            for (int m = 0; m < 4; ++m)
#pragma unroll
                for (int n = 0; n < 2; ++n) acc[a][b][m][n] = (f32x4){0.f, 0.f, 0.f, 0.f};
    bf16x8 At[4][2], B0[2][2], B1[2][2];
    const char* cA = (const char*)g.A + (size_t)cur.pm * tstep; const char* cB = (const char*)g.Bt + (size_t)cur.pn * tstep;
    S.a_ready(cur);
    if constexpr (SP2) {
        PG8_STAGE(PG8_SB(0, 0), cB, voffB); PG8_STAGE(PG8_SB(0, 1), cB + hstep, voffB); PG8_STAGE(PG8_SA(0, 0), cA, voffA); PG8_STAGE(PG8_SA(0, 1), cA + hstep, voffA);
        if (wr == 1) PG8_BAR;
        PG8_WAIT_V(2); PG8_BAR;
        PG8_STAGE(PG8_SB(1, 0), cB + kstep, voffB); PG8_STAGE(PG8_SA(1, 0), cA + kstep, voffA); PG8_STAGE(PG8_SB(1, 1), cB + hstep + kstep, voffB);
        PG8_WAIT_V(6); PG8_BAR;
    } else {
        PG8_STAGE(PG8_SB(0, 0), cB, voffB); PG8_STAGE(PG8_SA(0, 0), cA, voffA); PG8_STAGE(PG8_SB(0, 1), cB + hstep, voffB); PG8_STAGE(PG8_SA(0, 1), cA + hstep, voffA);
        if (wr == 1) PG8_BAR;
        PG8_WAIT_V(4); PG8_BAR;
        PG8_STAGE(PG8_SB(1, 0), cB + kstep, voffB); PG8_STAGE(PG8_SA(1, 0), cA + kstep, voffA); PG8_STAGE(PG8_SB(1, 1), cB + hstep + kstep, voffB);
        PG8_WAIT_V(6); PG8_BAR;
    }
    for (;;) {
        const bool has_next = S.next(ui + 1, nxt);
        const char* nA = has_next ? (const char*)g.A + (size_t)nxt.pm * tstep : cA; const char* nB = has_next ? (const char*)g.Bt + (size_t)nxt.pn * tstep : cB;
        for (int t = 0; t < nt; t += 2) {
            const bool last = (t == nt - 2);
            const char* a1 = cA + (size_t)(t + 1) * kstep;
            const char* a2 = last ? nA : cA + (size_t)(t + 2) * kstep; const char* b2 = last ? nB : cB + (size_t)(t + 2) * kstep;
            const char* a3 = a2 + kstep; const char* b3 = b2 + kstep;
            if (last && has_next) S.a_ready(nxt);
            if constexpr (SP2) {
            PG8_LDB(B0, 0, 0); PG8_LDB(B1, 0, 1); PG8_SCHED; PG8_LDA(At, 0, 0); PG8_STAGE(PG8_SA(1, 1), a1 + hstep, voffA);
            PG8_WAIT_V(8); PG8_WAIT_L(0); PG8_BAR; PG8_MMA(0, 0, At, B0); PG8_MMA(0, 1, At, B1); PG8_BAR; PG8_SCHED;
            PG8_LDA(At, 0, 1); PG8_STAGE(PG8_SB(0, 0), b2, voffB); PG8_STAGE(PG8_SB(0, 1), b2 + hstep, voffB); PG8_STAGE(PG8_SA(0, 0), a2, voffA);
            PG8_WAIT_V(8); PG8_WAIT_L(0); PG8_BAR; PG8_MMA(1, 0, At, B0); PG8_MMA(1, 1, At, B1); PG8_BAR; PG8_SCHED;
            PG8_LDB(B0, 1, 0); PG8_LDB(B1, 1, 1); PG8_SCHED; PG8_LDA(At, 1, 0); PG8_STAGE(PG8_SA(0, 1), a2 + hstep, voffA);
            PG8_WAIT_V(8); PG8_WAIT_L(0); PG8_BAR; PG8_MMA(0, 0, At, B0); PG8_MMA(0, 1, At, B1); PG8_BAR; PG8_SCHED;
            PG8_LDA(At, 1, 1); PG8_STAGE(PG8_SB(1, 0), b3, voffB); PG8_STAGE(PG8_SB(1, 1), b3 + hstep, voffB); PG8_STAGE(PG8_SA(1, 0), a3, voffA);
            PG8_WAIT_V(8); PG8_WAIT_L(0); PG8_BAR; PG8_MMA(1, 0, At, B0); PG8_MMA(1, 1, At, B1); PG8_BAR; PG8_SCHED;
            } else {
            PG8_LDB(B0, 0, 0); PG8_SCHED; PG8_LDA(At, 0, 0); PG8_STAGE(PG8_SA(1, 1), a1 + hstep, voffA);
            PG8_WAIT_L(8); PG8_BAR; PG8_WAIT_L(0); PG8_MMA(0, 0, At, B0); PG8_BAR; PG8_SCHED;
            PG8_LDB(B1, 0, 1); PG8_STAGE(PG8_SB(0, 0), b2, voffB);
            PG8_BAR; PG8_WAIT_L(0); PG8_MMA(0, 1, At, B1); PG8_BAR;
            PG8_LDA(At, 0, 1); PG8_STAGE(PG8_SA(0, 0), a2, voffA);
            PG8_BAR; PG8_WAIT_L(0); PG8_MMA(1, 0, At, B0); PG8_BAR; PG8_SCHED;
            PG8_STAGE(PG8_SB(0, 1), b2 + hstep, voffB);
            PG8_WAIT_V(6); PG8_BAR; PG8_MMA(1, 1, At, B1); PG8_BAR;
            PG8_LDB(B0, 1, 0); PG8_SCHED; PG8_LDA(At, 1, 0); PG8_STAGE(PG8_SA(0, 1), a2 + hstep, voffA);
            PG8_WAIT_L(8); PG8_BAR; PG8_WAIT_L(0); PG8_MMA(0, 0, At, B0); PG8_BAR; PG8_SCHED;
            PG8_LDB(B1, 1, 1); PG8_STAGE(PG8_SB(1, 0), b3, voffB);
            PG8_BAR; PG8_WAIT_L(0); PG8_MMA(0, 1, At, B1); PG8_BAR;
            PG8_LDA(At, 1, 1); PG8_STAGE(PG8_SA(1, 0), a3, voffA);
            PG8_BAR; PG8_WAIT_L(0); PG8_MMA(1, 0, At, B0); PG8_BAR; PG8_SCHED;
            PG8_STAGE(PG8_SB(1, 1), b3 + hstep, voffB);
            PG8_WAIT_V(6); PG8_BAR; PG8_MMA(1, 1, At, B1); PG8_BAR;
            }
        }
        if constexpr (ALIGN_EPI) { if (wr == 0) PG8_BAR; }
        if constexpr (!Epi::AFTER_DRAIN) { E(acc, cur, wr, wc, fr, fq); S.done(cur); }
        if (!has_next) break;
#pragma unroll
        for (int a = 0; a < 2; ++a)
#pragma unroll
            for (int b = 0; b < 2; ++b)
#pragma unroll
                for (int m = 0; m < 4; ++m)
#pragma unroll
                    for (int n = 0; n < 2; ++n) acc[a][b][m][n] = (f32x4){0.f, 0.f, 0.f, 0.f};
        cur = nxt; cA = nA; cB = nB; ++ui;
        if constexpr (ALIGN_EPI) { if (wr == 1) PG8_BAR; }
    }
    PG8_WAIT_V(0);
    if constexpr (!ALIGN_EPI) { if (wr == 0) PG8_BAR; }
    PG8_BAR;
    if constexpr (Epi::AFTER_DRAIN) { E.fused(acc, cur, wr, wc, fr, fq, lds, wid, lane); S.done(cur); }
#undef PG8_SA
#undef PG8_SB
#undef PG8_STAGE
#undef PG8_LDA
#undef PG8_LDB
#undef PG8_MMA
#undef PG8_WAIT_V
#undef PG8_WAIT_L
#undef PG8_BAR
#undef PG8_SCHED
}
}

#include <hip/hip_cooperative_groups.h>
#include <cstdio>
namespace cg = cooperative_groups;

#define LAS __attribute__((address_space(3)))
typedef unsigned short bf16;
typedef float f32x4 __attribute__((ext_vector_type(4)));
typedef float f32x2 __attribute__((ext_vector_type(2)));
typedef short bf16x8 __attribute__((ext_vector_type(8)));
typedef unsigned u32x4 __attribute__((ext_vector_type(4)));
typedef unsigned u32x2 __attribute__((ext_vector_type(2)));
typedef _Float16 h16x4 __attribute__((ext_vector_type(4)));
typedef _Float16 h16x8 __attribute__((ext_vector_type(8)));

constexpr int D = 1024, ML = 32768, MC = 512, MT = 33280, SEQ = 16384, CTXL = 256, FF = 2816, LW = 1280;
constexpr int NMOD = 9216;
constexpr size_t MiB = 1u << 20;
constexpr size_t WS_MOD = 1 * MiB, WS_ROPE = 2 * MiB, WS_XC = 6 * MiB, WS_W = 40 * MiB;
constexpr size_t WS_HB = 206 * MiB, WS_YB = 271 * MiB, WS_BIG = 336 * MiB;
constexpr size_t HL_BYTES = (size_t)MT * LW * 2;
constexpr size_t WS_SUM = WS_BIG + 2 * HL_BYTES, WS_CIN = WS_SUM + 21 * MiB;
constexpr size_t WS_LF = WS_HB, WS_LB2 = WS_HB + HL_BYTES;
constexpr size_t WS_XA = 8 * MiB, WS_XB = 531 * MiB, WS_XCH = 563 * MiB, WS_END = 564 * MiB;
constexpr size_t W1T_BYTES = 11 * MiB, W2T_BYTES = 5 * MiB + MiB / 2;
__host__ __device__ constexpr size_t off_w1t(int i, int f) { return WS_W + (size_t)(i * 2 + f) * W1T_BYTES; }
__host__ __device__ constexpr size_t off_w2t(int i, int f) { return WS_W + 88 * MiB + (size_t)(i * 2 + f) * W2T_BYTES; }
__host__ __device__ constexpr size_t off_na(int j) { return WS_W + 132 * MiB + (size_t)j * 8 * MiB; }
__host__ __device__ constexpr size_t off_lru(int j) { return WS_W + 148 * MiB + (size_t)j * 9 * MiB; }
constexpr size_t LRU_WOL = 5 * MiB, LRU_WG = 7 * MiB + MiB / 2;
constexpr size_t ACT_ELEMS = (size_t)MT * D;
constexpr int LDS_BYTES = 147456;

struct TJob { long long src_off; long long dst_off; int in_idx, map, ldn, ldk, nnt, tile0, ncol0, pad; };
constexpr int MAXJOBS = 44;
struct Args {
    const float* in[23];
    float* out;
    unsigned char* ws;
    int ph_lo, ph_hi, njobs, ntiles;
    unsigned pdesc[48];
    TJob jobs[MAXJOBS];
};

__device__ __forceinline__ float bf2f(unsigned short v) { return __uint_as_float((unsigned)v << 16); }
__device__ __forceinline__ unsigned pk2(float lo, float hi) { return pg8::cvt_pk_bf16(lo, hi); }
__device__ __forceinline__ float wave_sum(float v) {
#pragma unroll
    for (int o = 1; o < 64; o <<= 1) v += __shfl_xor(v, o);
    return v;
}
__device__ __forceinline__ float sigmoidf_(float v) { return __builtin_amdgcn_rcpf(1.0f + __expf(-v)); }

struct EpiSwiGLU {
    static constexpr bool PERM = true, AFTER_DRAIN = false;
    bf16* O;
    __device__ __forceinline__ void operator()(const f32x4 (&acc)[2][2][4][2], const pg8::Unit& u, int wr, int wc, int fr, int fq) const {
        const int row0 = u.pm * 256 + wr * 64 + fr, colh = u.pn * 128 + wc * 32 + 8 * fq;
#pragma unroll
        for (int ai = 0; ai < 2; ++ai)
#pragma unroll
            for (int m = 0; m < 4; ++m) { bf16* rowp = O + (size_t)(row0 + ai * 128 + m * 16) * FF + colh;
                float o[8];
#pragma unroll
                for (int n = 0; n < 2; ++n) { const f32x4 g = acc[ai][0][m][n], up = acc[ai][1][m][n];
                    const f32x4 ng = __builtin_elementwise_max(g, (f32x4){-14.f, -14.f, -14.f, -14.f}) * -1.4426950408889634f;
                    const f32x4 d = (f32x4){__builtin_amdgcn_exp2f(ng[0]), __builtin_amdgcn_exp2f(ng[1]), __builtin_amdgcn_exp2f(ng[2]), __builtin_amdgcn_exp2f(ng[3])} + 1.0f;
                    const float p01 = d[0] * d[1], p23 = d[2] * d[3]; const float t = __builtin_amdgcn_rcpf(p01 * p23);
                    const float i01 = t * p23, i23 = t * p01;
                    const f32x4 gu = g * up;
                    o[4 * n + 0] = gu[0] * (i01 * d[1]); o[4 * n + 1] = gu[1] * (i01 * d[0]); o[4 * n + 2] = gu[2] * (i23 * d[3]); o[4 * n + 3] = gu[3] * (i23 * d[2]); }
                u32x4 w; w.x = pk2(o[0], o[1]); w.y = pk2(o[2], o[3]); w.z = pk2(o[4], o[5]); w.w = pk2(o[6], o[7]);
                *(u32x4*)rowp = w; }
    }
};
struct EpiRope {
    static constexpr bool PERM = true, AFTER_DRAIN = false;
    bf16* Q; bf16* K; const float* ctab; const float* stab;
    __device__ __forceinline__ void operator()(const f32x4 (&acc)[2][2][4][2], const pg8::Unit& u, int wr, int wc, int fr, int fq) const {
        const int row0 = u.pm * 256 + wr * 64 + fr;
        const int i = 4 * (wc & 1) + fq;
#pragma unroll
        for (int ai = 0; ai < 2; ++ai)
#pragma unroll
            for (int m = 0; m < 4; ++m) {
                const int row = row0 + ai * 128 + m * 16;
                f32x4 cs = (f32x4){1.f, 1.f, 1.f, 1.f}, sn = (f32x4){0.f, 0.f, 0.f, 0.f};
                if (row < ML) { const int t = row & (SEQ - 1); cs = *(const f32x4*)(ctab + t * 32 + 4 * i); sn = *(const f32x4*)(stab + t * 32 + 4 * i); }
#pragma unroll
                for (int bj = 0; bj < 2; ++bj) {
                    const int c = u.pn * 256 + bj * 128 + wc * 32;
                    const bool isk = c >= 1024; const int head = (c & 1023) >> 6;
                    const float sc = isk ? 1.0f : 0.18033688011112042f;
                    bf16* dst = (isk ? K : Q) + (size_t)row * D + head * 64 + 4 * i;
                    const f32x4 x1 = acc[ai][bj][m][0], x2 = acc[ai][bj][m][1];
                    const f32x4 o1 = (x1 * cs - x2 * sn) * sc, o2 = (x1 * sn + x2 * cs) * sc;
                    u32x2 w1, w2; w1.x = pk2(o1[0], o1[1]); w1.y = pk2(o1[2], o1[3]); w2.x = pk2(o2[0], o2[1]); w2.y = pk2(o2[2], o2[3]);
                    *(u32x2*)dst = w1; *(u32x2*)(dst + 32) = w2; } }
    }
};
struct EpiGeluSplit {
    static constexpr bool PERM = true, AFTER_DRAIN = false;
    bf16* G; bf16* V;
    __device__ __forceinline__ void operator()(const f32x4 (&acc)[2][2][4][2], const pg8::Unit& u, int wr, int wc, int fr, int fq) const {
        const int row0 = u.pm * 256 + wr * 64 + fr; const bool isg = u.pn < 5;
        const int col0 = (isg ? u.pn * 256 : u.pn * 256 - LW) + wc * 32 + 8 * fq;
        bf16* base = isg ? G : V;
#pragma unroll
        for (int ai = 0; ai < 2; ++ai)
#pragma unroll
            for (int m = 0; m < 4; ++m) { bf16* rowp = base + (size_t)(row0 + ai * 128 + m * 16) * LW + col0;
#pragma unroll
                for (int bj = 0; bj < 2; ++bj) { f32x4 v0 = acc[ai][bj][m][0], v1 = acc[ai][bj][m][1];
                    if (isg) {
#pragma unroll
                        for (int e = 0; e < 4; ++e) { const float a = v0[e], b = v1[e];
                            v0[e] = a * sigmoidf_(1.5957691216f * (a + 0.044715f * a * a * a));
                            v1[e] = b * sigmoidf_(1.5957691216f * (b + 0.044715f * b * b * b)); } }
                    u32x4 w; w.x = pk2(v0[0], v0[1]); w.y = pk2(v0[2], v0[3]); w.z = pk2(v1[0], v1[1]); w.w = pk2(v1[2], v1[3]);
                    *(u32x4*)(rowp + bj * 128) = w; } }
    }
};

#ifndef PG8_ALIGN_EPI
#define PG8_ALIGN_EPI false
#endif
#ifndef PG8_USE_SP2
#define PG8_USE_SP2 true
#endif
template <class Epi>
__device__ __forceinline__ void run_gemm(LAS unsigned char* lds, const bf16* A, const bf16* Bt, int Mg, int Ng, int K, const Epi& E) {
    int bid = blockIdx.x, gsz = gridDim.x; asm volatile("" : "+s"(bid), "+s"(gsz));
    pg8::Gemm g{A, Bt, Mg, Ng, K}; pg8::StaticOrder S; S.init(Mg, Ng, gsz, bid);
    pg8::gemm_phase<Epi, pg8::StaticOrder, PG8_ALIGN_EPI, PG8_USE_SP2>(lds, g, S, E);
}

__device__ __forceinline__ const float* pick_in(const Args& a, const int z, int idx) {
    const float* p = a.in[8 + z];
    p = idx == 9 ? a.in[9 + z] : p; p = idx == 10 ? a.in[10 + z] : p; p = idx == 11 ? a.in[11 + z] : p; p = idx == 12 ? a.in[12 + z] : p;
    p = idx == 14 ? a.in[14 + z] : p; p = idx == 17 ? a.in[17 + z] : p; p = idx == 19 ? a.in[19 + z] : p; p = idx == 22 ? a.in[22 + z] : p;
    return p;
}
__device__ __forceinline__ int map_row(int map, int n) {
    if (map == 1) return 256 * (n >> 7) + (n & 127);
    if (map == 2) return 256 * (n >> 7) + 128 + (n & 127);
    if (map == 3) { const int hc = n >> 6, d = n & 63; return 64 * hc + 8 * ((d & 31) >> 2) + 4 * (d >> 5) + (d & 3); }
    return n;
}
__device__ __forceinline__ void prep_phase(const Args& a, const int z, LAS unsigned char* lds) {
    int tid_ = threadIdx.x; asm volatile("" : "+v"(tid_));
    const int tid = tid_, wave = __builtin_amdgcn_readfirstlane(tid >> 6), lane = tid & 63;
    float* MOD = (float*)((a.ws + z) + WS_MOD);
    LAS float* sc = (LAS float*)lds;
    LAS float* red = (LAS float*)(lds + 16384);
    bool have_sc = false;
    for (int it = blockIdx.x; it < 144; it += gridDim.x) {
        if (!have_sc) {
            for (int e = tid; e < 3 * D; e += 512) { const int r = e >> 10, k = e & 1023; const float v = r < 2 ? a.in[1 + z][r * D + k] : a.in[3 + z][k]; sc[e] = v * sigmoidf_(v); }
            have_sc = true; __syncthreads();
        }
        const int layer = it / 36, cg0 = (it % 36) * 256;
        const float* W = a.in[4 + z] + (size_t)layer * D * NMOD + cg0 + 4 * lane;
        f32x4 acc0 = (f32x4){0.f, 0.f, 0.f, 0.f}, acc1 = acc0, acc2 = acc0;
        const int kb = wave * 128;
        for (int k0 = 0; k0 < 128; k0 += 8) {
            f32x4 w[8];
#pragma unroll
            for (int e = 0; e < 8; ++e) w[e] = *(const f32x4*)(W + (size_t)(kb + k0 + e) * NMOD);
#pragma unroll
            for (int e = 0; e < 8; ++e) { const float s0 = sc[kb + k0 + e], s1 = sc[D + kb + k0 + e], s2 = sc[2 * D + kb + k0 + e];
                acc0 += w[e] * s0; acc1 += w[e] * s1; acc2 += w[e] * s2; }
        }
        *(LAS f32x4*)(red + (wave * 3 + 0) * 256 + 4 * lane) = acc0;
        *(LAS f32x4*)(red + (wave * 3 + 1) * 256 + 4 * lane) = acc1;
        *(LAS f32x4*)(red + (wave * 3 + 2) * 256 + 4 * lane) = acc2;
        __syncthreads();
        for (int e = tid; e < 768; e += 512) { const int r = e >> 8, c = e & 255; float s = 0.f;
#pragma unroll
            for (int w8 = 0; w8 < 8; ++w8) s += red[(w8 * 3 + r) * 256 + c];
            MOD[(size_t)(layer * 3 + r) * NMOD + cg0 + c] = s + a.in[5 + z][layer * NMOD + cg0 + c]; }
        __syncthreads();
    }
    {
        float* ctab = (float*)((a.ws + z) + WS_ROPE); float* stab = ctab + SEQ * 32;
        for (int e = blockIdx.x * 512 + tid; e < SEQ * 32; e += gridDim.x * 512) {
            const int t = e >> 5, p = e & 31; const float pos = (float)(p < 16 ? (t >> 6) : (t & 63));
            const float invf = powf(10000.0f, -(float)(p & 15) / 16.0f); const float ang = pos * invf;
            ctab[e] = cosf(ang); stab[e] = sinf(ang); }
    }
    __syncthreads();
    LAS float* T = (LAS float*)(lds + 65536);
    int jxs = 0;
    for (int tile0 = blockIdx.x; tile0 < a.ntiles; tile0 += 2 * gridDim.x) {
        bf16* dst[2]; int mapk[2], ldk[2], k0s[2], n0s[2]; bool ok[2];
#pragma unroll
        for (int q = 0; q < 2; ++q) {
            const int tile = tile0 + q * (int)gridDim.x; ok[q] = tile < a.ntiles; const int tl = ok[q] ? tile : tile0;
            if (tl < a.jobs[jxs].tile0) jxs = 0;
            while (jxs + 1 < a.njobs && tl >= a.jobs[jxs + 1].tile0) ++jxs;
            const TJob jb = a.jobs[jxs];
            const int local = tl - jb.tile0, kt = local / jb.nnt, nt = local % jb.nnt; k0s[q] = kt * 64; n0s[q] = nt * 128;
            dst[q] = (bf16*)((a.ws + z) + jb.dst_off); mapk[q] = jb.map; ldk[q] = jb.ldk;
            const int kk = tid >> 3, nj = (tid & 7) * 4;
            const float* p = pick_in(a, z, jb.in_idx) + jb.src_off + (size_t)(k0s[q] + kk) * jb.ldn + jb.ncol0 + n0s[q] + nj;
            LAS float* t = T + q * 8256 + kk * 129 + nj;
#pragma unroll
            for (int j = 0; j < 4; ++j) { const f32x4 v = *(const f32x4*)(p + 32 * j); t[32 * j] = v[0]; t[32 * j + 1] = v[1]; t[32 * j + 2] = v[2]; t[32 * j + 3] = v[3]; }
        }
        __syncthreads();
#pragma unroll
        for (int q = 0; q < 2; ++q) if (ok[q]) {
            const int nl = tid >> 2, ks = (tid & 3) * 16; const LAS float* t = T + q * 8256 + ks * 129 + nl;
            u32x4 o0, o1;
            o0.x = pk2(t[0], t[129]); o0.y = pk2(t[2 * 129], t[3 * 129]); o0.z = pk2(t[4 * 129], t[5 * 129]); o0.w = pk2(t[6 * 129], t[7 * 129]);
            o1.x = pk2(t[8 * 129], t[9 * 129]); o1.y = pk2(t[10 * 129], t[11 * 129]); o1.z = pk2(t[12 * 129], t[13 * 129]); o1.w = pk2(t[14 * 129], t[15 * 129]);
            size_t drow, dcol;
            if (mapk[q] == 4) { drow = (size_t)((k0s[q] >> 7) * 128 + n0s[q] + nl); dcol = (size_t)((k0s[q] & 127) + ks); }
            else { drow = (size_t)map_row(mapk[q], n0s[q] + nl); dcol = (size_t)(k0s[q] + ks); }
            bf16* dp = dst[q] + drow * ldk[q] + dcol;
            *(u32x4*)dp = o0; *(u32x4*)(dp + 8) = o1; }
        __syncthreads();
    }
}

__device__ __forceinline__ void norm_phase(const Args& a, const int z, int res_l, int res_s, float res_w, int pre_l, int pre_s, bool dry) {
    int tid_ = threadIdx.x; asm volatile("" : "+v"(tid_));
    const int tid = tid_, wave = __builtin_amdgcn_readfirstlane(tid >> 6), lane = tid & 63;
    const int gw = blockIdx.x * 8 + wave, NGW = gridDim.x * 8;
    const float* MOD = (const float*)((a.ws + z) + WS_MOD);
    const bf16* YB = (const bf16*)((a.ws + z) + WS_YB);
    bf16* HB = (bf16*)((a.ws + z) + WS_HB);
    const bool first = res_l < 0, has_pre = pre_l >= 0;
    const int rbeg = (int)(((long long)gw * MT) / NGW), rend = (int)(((long long)(gw + 1) * MT) / NGW);
    f32x4 vres[4], vsc[4], vsh[4]; int rcur = -1;
    for (int rowa = rbeg; rowa < rend; rowa += 2) {
        int rows[2] = {rowa, rowa + 1}; bool v1 = rows[1] < rend;
        const int rcl = rowa < SEQ ? 0 : (rowa < ML ? 1 : 2);
        if (v1 && (rows[1] < SEQ ? 0 : (rows[1] < ML ? 1 : 2)) != rcl) v1 = false;
        if (!v1) rows[1] = rowa;
        if (rcl != rcur) {
            rcur = rcl;
            if (!first) { const float* gate = MOD + (size_t)(res_l * 3 + rcl) * NMOD + (3 * res_s + 2) * D; const float* gpost = a.in[7 + z] + (size_t)(res_l * 3 + res_s) * D;
#pragma unroll
                for (int j = 0; j < 4; ++j) vres[j] = *(const f32x4*)(gate + j * 256 + 4 * lane) * *(const f32x4*)(gpost + j * 256 + 4 * lane) * res_w; }
            if (has_pre) { const float* mb = MOD + (size_t)(pre_l * 3 + rcl) * NMOD + (3 * pre_s) * D; const float* gpre = a.in[6 + z] + (size_t)(pre_l * 3 + pre_s) * D;
#pragma unroll
                for (int j = 0; j < 4; ++j) { vsh[j] = *(const f32x4*)(mb + j * 256 + 4 * lane); vsc[j] = (*(const f32x4*)(mb + D + j * 256 + 4 * lane) + 1.0f) * *(const f32x4*)(gpre + j * 256 + 4 * lane); } }
        }
        _Float16* x16[2];
#pragma unroll
        for (int q = 0; q < 2; ++q) { const int row = rows[q];
            x16[q] = (_Float16*)((a.ws + z) + (row < SEQ ? WS_XA : (row < ML ? WS_XB : WS_XCH))) + (size_t)(row < SEQ ? row : (row < ML ? row - SEQ : row - ML)) * D; }
        f32x4 xv[2][4]; f32x4 yv[2][4];
        if (first) {
#pragma unroll
            for (int q = 0; q < 2; ++q) { const int row = rows[q]; const float* xs = row < ML ? a.in[0 + z] + (size_t)row * D : a.in[2 + z] + (size_t)(row - ML) * D;
#pragma unroll
                for (int j = 0; j < 4; ++j) xv[q][j] = *(const f32x4*)(xs + j * 256 + 4 * lane); }
        } else {
#pragma unroll
            for (int q = 0; q < 2; ++q)
#pragma unroll
                for (int j = 0; j < 4; ++j) { const h16x4 hv = *(const h16x4*)(x16[q] + j * 256 + 4 * lane);
                    xv[q][j] = (f32x4){(float)hv[0], (float)hv[1], (float)hv[2], (float)hv[3]}; }
        }
        if (!first) {
            float ss[2] = {0.f, 0.f};
#pragma unroll
            for (int q = 0; q < 2; ++q)
#pragma unroll
                for (int j = 0; j < 4; ++j) { const u32x2 w = *(const u32x2*)(YB + (size_t)rows[q] * D + j * 256 + 4 * lane);
                    yv[q][j] = (f32x4){__uint_as_float(w.x << 16), __uint_as_float(w.x & 0xffff0000u), __uint_as_float(w.y << 16), __uint_as_float(w.y & 0xffff0000u)};
                    ss[q] += (yv[q][j][0] * yv[q][j][0] + yv[q][j][1] * yv[q][j][1]) + (yv[q][j][2] * yv[q][j][2] + yv[q][j][3] * yv[q][j][3]); }
#pragma unroll
            for (int o = 1; o < 64; o <<= 1) { ss[0] += __shfl_xor(ss[0], o); ss[1] += __shfl_xor(ss[1], o); }
#pragma unroll
            for (int q = 0; q < 2; ++q) { const float rstd = rsqrtf(ss[q] * (1.0f / D) + 1e-6f);
#pragma unroll
                for (int j = 0; j < 4; ++j) xv[q][j] += vres[j] * yv[q][j] * rstd; }
        }
#pragma unroll
        for (int q = 0; q < 2; ++q) if (q == 0 || v1) {
            if (has_pre) {
#pragma unroll
                for (int j = 0; j < 4; ++j) *(h16x4*)(x16[q] + j * 256 + 4 * lane) = (h16x4){(_Float16)xv[q][j][0], (_Float16)xv[q][j][1], (_Float16)xv[q][j][2], (_Float16)xv[q][j][3]};
            } else if (rows[q] < ML) {
#pragma unroll
                for (int j = 0; j < 4; ++j) *(f32x4*)((a.out + z) + (size_t)rows[q] * D + j * 256 + 4 * lane) = xv[q][j];
            }
        }
        if (has_pre) {
            float ss[2] = {0.f, 0.f};
#pragma unroll
            for (int q = 0; q < 2; ++q)
#pragma unroll
                for (int j = 0; j < 4; ++j) ss[q] += (xv[q][j][0] * xv[q][j][0] + xv[q][j][1] * xv[q][j][1]) + (xv[q][j][2] * xv[q][j][2] + xv[q][j][3] * xv[q][j][3]);
#pragma unroll
            for (int o = 1; o < 64; o <<= 1) { ss[0] += __shfl_xor(ss[0], o); ss[1] += __shfl_xor(ss[1], o); }
#pragma unroll
            for (int q = 0; q < 2; ++q) if (q == 0 || v1) { const float rstd = rsqrtf(ss[q] * (1.0f / D) + 1e-6f);
#pragma unroll
                for (int j = 0; j < 4; ++j) { const f32x4 h = xv[q][j] * rstd * vsc[j] + vsh[j];
                    u32x2 w; w.x = pk2(h[0], h[1]); w.y = pk2(h[2], h[3]);
                    *(u32x2*)(HB + (size_t)rows[q] * D + j * 256 + 4 * lane) = w; } }
        }
    }
}

struct KVFrag { bf16x8 k[2][2]; bf16x8 v[4]; };
__device__ __forceinline__ void attn_load(KVFrag& f, const bf16* Kb, const bf16* Vt, int T0, int krow, int h, int fr, int g) {
    const bf16* kp = Kb + (size_t)(T0 + krow) * D + h * 64 + g * 8;
#pragma unroll
    for (int t = 0; t < 2; ++t)
#pragma unroll
        for (int ks = 0; ks < 2; ++ks) f.k[t][ks] = *(const bf16x8*)(kp + (size_t)(4 * t) * D + ks * 32);
    const bf16* vp = Vt + (size_t)(h * 64 + fr) * MT + T0 + g * 8;
#pragma unroll
    for (int dt = 0; dt < 4; ++dt) f.v[dt] = *(const bf16x8*)(vp + (size_t)(dt * 16) * MT);
}
__device__ __forceinline__ void attn_step(const KVFrag& f, const bf16x8 qb0, const bf16x8 qb1, const bool lat, const LAS float* bpl, const unsigned vm,
                                          f32x4 (&o)[4], float& mrun, float& lrun) {
    f32x4 s0 = (f32x4){0.f, 0.f, 0.f, 0.f}, s1 = s0;
    s0 = __builtin_amdgcn_mfma_f32_16x16x32_bf16(f.k[0][0], qb0, s0, 0, 0, 0);
    s0 = __builtin_amdgcn_mfma_f32_16x16x32_bf16(f.k[0][1], qb1, s0, 0, 0, 0);
    s1 = __builtin_amdgcn_mfma_f32_16x16x32_bf16(f.k[1][0], qb0, s1, 0, 0, 0);
    s1 = __builtin_amdgcn_mfma_f32_16x16x32_bf16(f.k[1][1], qb1, s1, 0, 0, 0);
    float s[8] = {s0[0], s0[1], s0[2], s0[3], s1[0], s1[1], s1[2], s1[3]};
    if (lat) {
#pragma unroll
        for (int e = 0; e < 8; ++e) { const float bv = bpl[e]; s[e] = ((vm >> e) & 1u) ? s[e] + bv : -1e30f; }
    }
    float cm = fmaxf(fmaxf(fmaxf(s[0], s[1]), fmaxf(s[2], s[3])), fmaxf(fmaxf(s[4], s[5]), fmaxf(s[6], s[7])));
    if (__any(cm > mrun + 40.0f)) {
        cm = fmaxf(cm, __shfl_xor(cm, 16)); cm = fmaxf(cm, __shfl_xor(cm, 32));
        const float mnew = fmaxf(mrun, cm); const float alpha = __builtin_amdgcn_exp2f(mrun - mnew);
        lrun *= alpha; mrun = mnew;
#pragma unroll
        for (int dt = 0; dt < 4; ++dt) o[dt] = o[dt] * alpha;
    }
    float ps = 0.f;
#pragma unroll
    for (int e = 0; e < 8; ++e) { s[e] = __builtin_amdgcn_exp2f(s[e] - mrun); ps += s[e]; }
    lrun += ps;
    union { u32x4 u; bf16x8 v; } pb;
    pb.u.x = pk2(s[0], s[1]); pb.u.y = pk2(s[2], s[3]); pb.u.z = pk2(s[4], s[5]); pb.u.w = pk2(s[6], s[7]);
#pragma unroll
    for (int dt = 0; dt < 4; ++dt) o[dt] = __builtin_amdgcn_mfma_f32_16x16x32_bf16(f.v[dt], pb.v, o[dt], 0, 0, 0);
}
constexpr int A_KC = 0, A_KP = 144, A_VC = 36864, A_VP = 528, A_RP = 36864 + 33792, A_QS = 36864 + 33792 + 2560;
__device__ __forceinline__ void attn_phase(const Args& a, const int z, int j, LAS unsigned char* lds, bool dry) {
    int tid_ = threadIdx.x; asm volatile("" : "+v"(tid_));
    const int tid = tid_, wave = __builtin_amdgcn_readfirstlane(tid >> 6), lane = tid & 63, fr = lane & 15, g = lane >> 4;
    bf16* Q = (bf16*)((a.ws + z) + WS_BIG); const bf16* Kb = Q + ACT_ELEMS; const bf16* Vt = Q + 2 * ACT_ELEMS;
    const int krow = (fr >> 2) * 8 + (fr & 3);
    for (int wg = blockIdx.x; wg < 256; wg += gridDim.x) {
        const int xcd = wg & 7, idx = wg >> 3, pair = xcd * 4 + (idx >> 3), sub = idx & 7, b = pair >> 4, h = pair & 15;
        __syncthreads();
        for (int e = tid; e < 256 * 8; e += 512) { const int key = e >> 3, p = e & 7;
            *(LAS u32x4*)(lds + A_KC + key * A_KP + p * 16) = *(const u32x4*)(Kb + (size_t)(ML + b * CTXL + key) * D + h * 64 + p * 8); }
        for (int e = tid; e < 64 * 32; e += 512) { const int d = e >> 5, p = e & 31;
            *(LAS u32x4*)(lds + A_VC + d * A_VP + p * 16) = *(const u32x4*)(Vt + (size_t)(h * 64 + d) * MT + ML + b * CTXL + p * 8); }
        { const float* rpb = a.in[13 + z] + (size_t)(j * 16 + h) * 465; for (int e = tid; e < 465; e += 512) ((LAS float*)(lds + A_RP))[64 + e] = rpb[e] * 1.4426950408889634f; }
        __syncthreads();
        if (wave < 2) {
            const int qrow0 = ML + b * CTXL + (sub * 2 + wave) * 16;
            bf16* qp = Q + (size_t)(qrow0 + fr) * D + h * 64;
            const bf16x8 qb0 = *(const bf16x8*)(qp + g * 8), qb1 = *(const bf16x8*)(qp + 32 + g * 8);
            f32x4 o[4];
#pragma unroll
            for (int dt = 0; dt < 4; ++dt) o[dt] = (f32x4){0.f, 0.f, 0.f, 0.f};
            float mrun = -1e30f, lrun = 0.f;
            for (int cc = 0; cc < 8; ++cc) {
                KVFrag f;
#pragma unroll
                for (int t = 0; t < 2; ++t)
#pragma unroll
                    for (int ks = 0; ks < 2; ++ks) f.k[t][ks] = *(const LAS bf16x8*)(lds + A_KC + (cc * 32 + krow + 4 * t) * A_KP + (ks * 32 + g * 8) * 2);
#pragma unroll
                for (int dt = 0; dt < 4; ++dt) f.v[dt] = *(const LAS bf16x8*)(lds + A_VC + (dt * 16 + fr) * A_VP + (cc * 32 + g * 8) * 2);
                attn_step(f, qb0, qb1, false, nullptr, 0u, o, mrun, lrun);
            }
            lrun += __shfl_xor(lrun, 16); lrun += __shfl_xor(lrun, 32);
            const float inv = 1.0f / lrun;
            bf16* op = dry ? (bf16*)((a.ws + z) + WS_HB) + (size_t)(qrow0 + fr) * D + h * 64 : qp;
#pragma unroll
            for (int dt = 0; dt < 4; ++dt) { u32x2 w; w.x = pk2(o[dt][0] * inv, o[dt][1] * inv); w.y = pk2(o[dt][2] * inv, o[dt][3] * inv);
                *(u32x2*)(op + dt * 16 + g * 4) = w; }
        }
        for (int li = wave; li < 32; li += 8) {
            const int rg = li >> 2, cq = li & 3, rbase = sub * 32 + rg * 4;
            const int cw = cq == 0 ? 0 : (cq == 1 ? 8 : (cq == 2 ? 24 : 32));
            const int cqq = cq * 16 + fr, c0 = min(max(cqq - 8, 0), 48);
            unsigned vm = 0u;
#pragma unroll
            for (int e = 0; e < 8; ++e) { const int rel = cw + g * 8 + e - c0; vm |= (rel >= 0 && rel < 16) ? (1u << e) : 0u; }
            const LAS float* rpl = (const LAS float*)(lds + A_RP) + 64 + (cw + g * 8 - cqq + 15);
            bf16* qp = Q + (size_t)(b * SEQ + rbase * 64 + cq * 16 + fr) * D + h * 64;
            f32x4 o[4][4]; float mrun[4], lrun[4];
            LAS unsigned char* qs = lds + A_QS + wave * 8192 + lane * 16;
#pragma unroll
            for (int t = 0; t < 4; ++t) { *(LAS bf16x8*)(qs + t * 2048) = *(const bf16x8*)(qp + (size_t)t * 64 * D + g * 8); *(LAS bf16x8*)(qs + t * 2048 + 1024) = *(const bf16x8*)(qp + (size_t)t * 64 * D + 32 + g * 8);
                mrun[t] = -1e30f; lrun[t] = 0.f;
#pragma unroll
                for (int dt = 0; dt < 4; ++dt) o[t][dt] = (f32x4){0.f, 0.f, 0.f, 0.f}; }
            const int kr_lo = min(max(rbase - 4, 0), 248), kr_hi = min(max(rbase - 1, 0), 248) + 7;
            KVFrag cur, nxt;
            attn_load(cur, Kb, Vt, b * SEQ + kr_lo * 64 + cw, krow, h, fr, g);
            nxt = cur;
            for (int kr = kr_lo; kr <= kr_hi; ++kr) {
                if (kr < kr_hi) attn_load(nxt, Kb, Vt, b * SEQ + (kr + 1) * 64 + cw, krow, h, fr, g);
#pragma unroll
                for (int t = 0; t < 4; ++t) { const int r = rbase + t, r0 = min(max(r - 4, 0), 248);
                    if (kr >= r0 && kr < r0 + 8)
                        attn_step(cur, *(const LAS bf16x8*)(qs + t * 2048), *(const LAS bf16x8*)(qs + t * 2048 + 1024), true, rpl + (kr - r + 7) * 31, vm, o[t], mrun[t], lrun[t]); }
                cur = nxt;
            }
            for (int cc = 0; cc < 8; ++cc) {
                KVFrag f;
#pragma unroll
                for (int t = 0; t < 2; ++t)
#pragma unroll
                    for (int ks = 0; ks < 2; ++ks) f.k[t][ks] = *(const LAS bf16x8*)(lds + A_KC + (cc * 32 + krow + 4 * t) * A_KP + (ks * 32 + g * 8) * 2);
#pragma unroll
                for (int dt = 0; dt < 4; ++dt) f.v[dt] = *(const LAS bf16x8*)(lds + A_VC + (dt * 16 + fr) * A_VP + (cc * 32 + g * 8) * 2);
#pragma unroll
                for (int t = 0; t < 4; ++t) attn_step(f, *(const LAS bf16x8*)(qs + t * 2048), *(const LAS bf16x8*)(qs + t * 2048 + 1024), false, nullptr, 0u, o[t], mrun[t], lrun[t]);
            }
#pragma unroll
            for (int t = 0; t < 4; ++t) {
                float lt = lrun[t]; lt += __shfl_xor(lt, 16); lt += __shfl_xor(lt, 32);
                const float inv = 1.0f / lt;
                bf16* op = (dry ? (bf16*)((a.ws + z) + WS_HB) + (size_t)(b * SEQ + rbase * 64 + cq * 16 + fr) * D + h * 64 : qp) + (size_t)t * 64 * D;
#pragma unroll
                for (int dt = 0; dt < 4; ++dt) { u32x2 w; w.x = pk2(o[t][dt][0] * inv, o[t][dt][1] * inv); w.y = pk2(o[t][dt][2] * inv, o[t][dt][3] * inv);
                    *(u32x2*)(op + dt * 16 + g * 4) = w; }
            }
        }
    }
    __syncthreads();
}

constexpr int UP = 132;
constexpr int L_U32 = 0, L_UB = 33792, L_GB = 51200, L_T1 = 68608, L_T2 = 86016;
#define LRU_PREFETCH(TASK) do { const int n_ = (TASK) / 1040, c_ = (TASK) - n_ * 1040, m0_ = c_ * 32; int lo_, hi_; \
        if (m0_ < ML) { lo_ = (m0_ / SEQ) * SEQ; hi_ = lo_ + SEQ; } else { lo_ = ML + ((m0_ - ML) / CTXL) * CTXL; hi_ = lo_ + CTXL; } \
        _Pragma("unroll") for (int tap = 0; tap < 4; ++tap) { const int mr = m0_ + tokc + tap - 2; \
            pv[tap] = (mr >= lo_ && mr < hi_) ? *(const u32x4*)(V + (size_t)mr * LW + n_ * 128 + ch8) : (u32x4){0u, 0u, 0u, 0u}; } \
        if (FINAL) pg = *(const u32x4*)(G + (size_t)(m0_ + tokc) * LW + n_ * 128 + ch8); } while (0)
__device__ __forceinline__ unsigned char* lb_row_ptr(const Args& a, const int z, int row) {
    return row < SEQ ? (unsigned char*)(a.out + z) + HL_BYTES + (size_t)row * (LW * 2) : (a.ws + z) + WS_LB2 + (size_t)(row - SEQ) * (LW * 2);
}
__device__ __forceinline__ void lru_scan_phase(const Args& a, const int z, int j, LAS unsigned char* lds) {
    constexpr bool FINAL = false;
    int tid_ = threadIdx.x; asm volatile("" : "+v"(tid_));
    const int tid = tid_, wave = __builtin_amdgcn_readfirstlane(tid >> 6), lane = tid & 63, fr = lane & 15, g = lane >> 4;
    const int tokc = tid >> 4, ch8 = (tid & 15) * 8, ct = wave, ch = ct * 16 + fr;
    bf16* G = (bf16*)((a.ws + z) + WS_BIG); const bf16* V = G + (size_t)MT * LW;
    const bf16* Wg = (const bf16*)((a.ws + z) + off_lru(j) + LRU_WG);
    const float* convw = a.in[15 + z] + (size_t)j * 4 * LW; const float* convb = a.in[16 + z] + (size_t)j * LW;
    const float* b_a = a.in[18 + z] + (size_t)j * 2 * LW; const float* b_x = a.in[20 + z] + (size_t)j * 2 * LW; const float* lam = a.in[21 + z] + (size_t)j * 2 * LW;
    f32x2* SUM = (f32x2*)((a.ws + z) + WS_SUM);
    unsigned char* HLg = (unsigned char*)(a.out + z); unsigned char* LFg = (a.ws + z) + WS_LF;
    int cur_n = -1, pm0 = 0, pn = 0;
    bf16x8 bw[4][4]; float cba[2] = {0.f, 0.f}, cbx[2] = {0.f, 0.f}, csp[2] = {0.f, 0.f};
    f32x4 cw[4][2], cbias[2];
    u32x4 pv[4], pg = (u32x4){0u, 0u, 0u, 0u};
    int task = blockIdx.x, it = 0;
    if (task < 10400) LRU_PREFETCH(task);
    for (; task < 10400; ++it, task += gridDim.x) {
        const int buf = it & 1;
        const int n = task / 1040, c = task - n * 1040, m0 = c * 32;
        LAS float* U32 = (LAS float*)(lds + L_U32) + buf * 32 * UP; LAS bf16* UB = (LAS bf16*)(lds + L_UB) + buf * 32 * 136; LAS bf16* GB = (LAS bf16*)(lds + L_GB) + buf * 32 * 136; LAS _Float16* T1 = (LAS _Float16*)(lds + L_T1) + buf * 32 * 136; LAS _Float16* T2 = (LAS _Float16*)(lds + L_T2) + buf * 32 * 136;
        if (n != cur_n) {
            cur_n = n;
#pragma unroll
            for (int tap = 0; tap < 4; ++tap) { cw[tap][0] = *(const f32x4*)(convw + tap * LW + n * 128 + ch8); cw[tap][1] = *(const f32x4*)(convw + tap * LW + n * 128 + ch8 + 4); }
            cbias[0] = *(const f32x4*)(convb + n * 128 + ch8); cbias[1] = *(const f32x4*)(convb + n * 128 + ch8 + 4);
#pragma unroll
            for (int cb = 0; cb < 4; ++cb)
#pragma unroll
                for (int ks = 0; ks < 4; ++ks) bw[cb][ks] = *(const bf16x8*)(Wg + ((size_t)(cb * 10 + n) * 128 + ch) * 128 + ks * 32 + g * 8);
#pragma unroll
            for (int dir = 0; dir < 2; ++dir) { cba[dir] = b_a[dir * LW + n * 128 + ch]; cbx[dir] = b_x[dir * LW + n * 128 + ch]; csp[dir] = -8.0f * 1.4426950408889634f * log1pf(__expf(-lam[dir * LW + n * 128 + ch])); }
        }
        { f32x4 u0 = cbias[0], u1 = cbias[1];
#pragma unroll
          for (int tap = 0; tap < 4; ++tap) { const u32x4 vv = pv[tap];
              u0 += cw[tap][0] * (f32x4){__uint_as_float(vv.x << 16), __uint_as_float(vv.x & 0xffff0000u), __uint_as_float(vv.y << 16), __uint_as_float(vv.y & 0xffff0000u)};
              u1 += cw[tap][1] * (f32x4){__uint_as_float(vv.z << 16), __uint_as_float(vv.z & 0xffff0000u), __uint_as_float(vv.w << 16), __uint_as_float(vv.w & 0xffff0000u)}; }
          *(LAS f32x4*)(U32 + tokc * UP + ch8) = u0; *(LAS f32x4*)(U32 + tokc * UP + ch8 + 4) = u1;
          u32x4 w; w.x = pk2(u0[0], u0[1]); w.y = pk2(u0[2], u0[3]); w.z = pk2(u1[0], u1[1]); w.w = pk2(u1[2], u1[3]);
          *(LAS u32x4*)(UB + tokc * 136 + ch8) = w;
          }
        __syncthreads();
        if (it > 0) {
            const int pb = (buf ^ 1) * 32 * 136; const size_t go = ((size_t)(pm0 + tokc) * LW + pn * 128 + ch8) * 2;
            *(u32x4*)(HLg + go) = *(const LAS u32x4*)((const LAS bf16*)(lds + L_GB) + pb + tokc * 136 + ch8);
            *(u32x4*)(LFg + go) = *(const LAS u32x4*)((const LAS _Float16*)(lds + L_T1) + pb + tokc * 136 + ch8);
            *(u32x4*)(lb_row_ptr(a, z, pm0 + tokc) + (size_t)(pn * 128 + ch8) * 2) = *(const LAS u32x4*)((const LAS _Float16*)(lds + L_T2) + pb + tokc * 136 + ch8); }
        { const int tn = task + gridDim.x; if (tn < 10400) LRU_PREFETCH(tn); }
        f32x4 acc[2][4];
#pragma unroll
        for (int rt = 0; rt < 2; ++rt)
#pragma unroll
            for (int cb = 0; cb < 4; ++cb) acc[rt][cb] = (f32x4){0.f, 0.f, 0.f, 0.f};
#pragma unroll
        for (int ks = 0; ks < 4; ++ks) {
            bf16x8 af[2];
#pragma unroll
            for (int rt = 0; rt < 2; ++rt) af[rt] = *(const LAS bf16x8*)(UB + (rt * 16 + fr) * 136 + ks * 32 + g * 8);
#pragma unroll
            for (int cb = 0; cb < 4; ++cb)
#pragma unroll
                for (int rt = 0; rt < 2; ++rt) acc[rt][cb] = __builtin_amdgcn_mfma_f32_16x16x32_bf16(af[rt], bw[cb][ks], acc[rt][cb], 0, 0, 0);
        }
        float uv[2][4];
#pragma unroll
        for (int rt = 0; rt < 2; ++rt)
#pragma unroll
            for (int jj = 0; jj < 4; ++jj) uv[rt][jj] = U32[(rt * 16 + g * 4 + jj) * UP + ch];
        float rec[2][4];
#pragma unroll
        for (int rt = 0; rt < 2; ++rt)
#pragma unroll
            for (int jj = 0; jj < 4; ++jj) rec[rt][jj] = 0.f;
#pragma unroll
        for (int dir = 0; dir < 2; ++dir) {
            float av[2][4], bv[2][4], lav[2][4], SA[2], SB[2];
#pragma unroll
            for (int rt = 0; rt < 2; ++rt) {
#pragma unroll
                for (int jp = 0; jp < 2; ++jp) {
                    const f32x2 xr = (f32x2){acc[rt][dir * 2][2 * jp], acc[rt][dir * 2][2 * jp + 1]} + cba[dir];
                    const f32x2 xi = (f32x2){acc[rt][dir * 2 + 1][2 * jp], acc[rt][dir * 2 + 1][2 * jp + 1]} + cbx[dir];
                    const f32x2 nr = __builtin_elementwise_max(xr, (f32x2){-30.f, -30.f}) * -1.4426950408889634f;
                    const f32x2 ni = __builtin_elementwise_max(xi, (f32x2){-30.f, -30.f}) * -1.4426950408889634f;
                    const f32x2 er1 = (f32x2){__builtin_amdgcn_exp2f(nr.x), __builtin_amdgcn_exp2f(nr.y)} + 1.0f;
                    const f32x2 ei1 = (f32x2){__builtin_amdgcn_exp2f(ni.x), __builtin_amdgcn_exp2f(ni.y)} + 1.0f;
                    const f32x2 pr = er1 * ei1;
                    const f32x2 tinv = (f32x2){__builtin_amdgcn_rcpf(pr.x), __builtin_amdgcn_rcpf(pr.y)};
                    const f32x2 rg = tinv * ei1, ig = tinv * er1;
                    const f32x2 la2 = rg * csp[dir];
                    const f32x2 a_ = (f32x2){__builtin_amdgcn_exp2f(la2.x), __builtin_amdgcn_exp2f(la2.y)};
                    const f32x2 x2 = la2 * 1.3862943611198906f;
                    const f32x2 ser = -x2 * (x2 * (x2 * (x2 * 0.041666668f + 0.16666667f) + 0.5f) + 1.0f);
                    const f32x2 alt = 1.0f - a_ * a_;
                    f32x2 om; om.x = x2.x > -0.1f ? ser.x : alt.x; om.y = x2.y > -0.1f ? ser.y : alt.y;
                    om = __builtin_elementwise_max(om, (f32x2){0.f, 0.f});
                    const f32x2 sq = (f32x2){__builtin_amdgcn_sqrtf(om.x), __builtin_amdgcn_sqrtf(om.y)};
                    const f32x2 b_ = sq * ig * (f32x2){uv[rt][2 * jp], uv[rt][2 * jp + 1]};
                    av[rt][2 * jp] = a_.x; av[rt][2 * jp + 1] = a_.y; bv[rt][2 * jp] = b_.x; bv[rt][2 * jp + 1] = b_.y; lav[rt][2 * jp] = la2.x; lav[rt][2 * jp + 1] = la2.y; }
                float sa = 1.f, sb = 0.f;
#pragma unroll
                for (int q = 0; q < 4; ++q) { const int jj = dir ? 3 - q : q; sb = av[rt][jj] * sb + bv[rt][jj]; sa *= av[rt][jj]; }
                SA[rt] = sa; SB[rt] = sb;
            }
            float Hrun = 0.f, Atot = 1.f, myc[2] = {0.f, 0.f}, myab[2] = {1.f, 1.f};
#pragma unroll
            for (int q = 0; q < 8; ++q) { const int rt = dir ? 1 - (q >> 2) : (q >> 2), gg = dir ? 3 - (q & 3) : (q & 3);
                const float sa = __shfl(SA[rt], fr + 16 * gg), sb = __shfl(SB[rt], fr + 16 * gg);
                myc[rt] = (gg == g) ? Hrun : myc[rt]; myab[rt] = (gg == g) ? Atot : myab[rt];
                Hrun = sa * Hrun + sb; Atot *= sa; }
            if (g == 0) SUM[(size_t)(c * 2 + dir) * LW + n * 128 + ch] = (f32x2){Atot, Hrun};
            LAS _Float16* TL = dir ? T2 : T1;
#pragma unroll
            for (int rt = 0; rt < 2; ++rt) { float h = myc[rt], lp = __builtin_amdgcn_logf(myab[rt]);
#pragma unroll
                for (int q = 0; q < 4; ++q) { const int jj = dir ? 3 - q : q; h = av[rt][jj] * h + bv[rt][jj]; rec[rt][jj] += h;
                    lp += lav[rt][jj]; TL[(rt * 16 + g * 4 + jj) * 136 + ch] = (_Float16)lp; } }
        }
#pragma unroll
        for (int rt = 0; rt < 2; ++rt)
#pragma unroll
            for (int jj = 0; jj < 4; ++jj) GB[(rt * 16 + g * 4 + jj) * 136 + ch] = (bf16)(pk2(rec[rt][jj], 0.f) & 0xffffu);
        pm0 = m0; pn = n;
    }
    __syncthreads();
    if (it > 0) { const int pb = ((it - 1) & 1) * 32 * 136; const size_t go = ((size_t)(pm0 + tokc) * LW + pn * 128 + ch8) * 2;
        *(u32x4*)(HLg + go) = *(const LAS u32x4*)((const LAS bf16*)(lds + L_GB) + pb + tokc * 136 + ch8);
        *(u32x4*)(LFg + go) = *(const LAS u32x4*)((const LAS _Float16*)(lds + L_T1) + pb + tokc * 136 + ch8);
        *(u32x4*)(lb_row_ptr(a, z, pm0 + tokc) + (size_t)(pn * 128 + ch8) * 2) = *(const LAS u32x4*)((const LAS _Float16*)(lds + L_T2) + pb + tokc * 136 + ch8); }
    __syncthreads();
}
__device__ __forceinline__ void lru_apply_phase(const Args& a, const int z, bool dry) {
    int tid_ = threadIdx.x; asm volatile("" : "+v"(tid_));
    const int tid = tid_;
    bf16* G = (bf16*)((a.ws + z) + WS_BIG); const float* CIN = (const float*)((a.ws + z) + WS_CIN);
    const unsigned char* HLg = (const unsigned char*)(a.out + z); const unsigned char* LFg = (a.ws + z) + WS_LF;
    const int stride = (int)gridDim.x * 512;
    for (int idx0 = blockIdx.x * 512 + tid; idx0 < MT * 160; idx0 += 4 * stride) {
        u32x4 hl[4], gv[4]; h16x8 lf[4], lb[4]; f32x4 cfa[4][2], cba[4][2]; size_t go[4]; bool ok[4];
#pragma unroll
        for (int k = 0; k < 4; ++k) { const int idx = idx0 + k * stride; ok[k] = idx < MT * 160; const int id = ok[k] ? idx : idx0;
            const int row = id / 160, c8 = (id - row * 160) * 8, chunk = row >> 5; go[k] = ((size_t)row * LW + c8) * 2;
            hl[k] = *(const u32x4*)(HLg + go[k]); gv[k] = *(const u32x4*)((const unsigned char*)G + go[k]);
            lf[k] = *(const h16x8*)(LFg + go[k]); lb[k] = *(const h16x8*)(lb_row_ptr(a, z, row) + (size_t)c8 * 2);
            const float* cfp = CIN + (size_t)(chunk * 2) * LW + c8;
            cfa[k][0] = *(const f32x4*)cfp; cfa[k][1] = *(const f32x4*)(cfp + 4); cba[k][0] = *(const f32x4*)(cfp + LW); cba[k][1] = *(const f32x4*)(cfp + LW + 4); }
#pragma unroll
        for (int k = 0; k < 4; ++k) if (ok[k]) {
            const unsigned hw[4] = {hl[k].x, hl[k].y, hl[k].z, hl[k].w}, gw[4] = {gv[k].x, gv[k].y, gv[k].z, gv[k].w};
            float r[8];
#pragma unroll
            for (int e = 0; e < 8; ++e) { const float hv = (e & 1) ? __uint_as_float(hw[e >> 1] & 0xffff0000u) : __uint_as_float(hw[e >> 1] << 16);
                const float gg = (e & 1) ? __uint_as_float(gw[e >> 1] & 0xffff0000u) : __uint_as_float(gw[e >> 1] << 16);
                r[e] = (hv + __builtin_amdgcn_exp2f((float)lf[k][e]) * cfa[k][e >> 2][e & 3] + __builtin_amdgcn_exp2f((float)lb[k][e]) * cba[k][e >> 2][e & 3]) * gg; }
            u32x4 w; w.x = pk2(r[0], r[1]); w.y = pk2(r[2], r[3]); w.z = pk2(r[4], r[5]); w.w = pk2(r[6], r[7]);
            *(u32x4*)((unsigned char*)G + (dry ? HL_BYTES : 0) + go[k]) = w;
        }
    }
}
__device__ __forceinline__ void lru_carry_phase(const Args& a, const int z, LAS unsigned char* lds) {
    int tid_ = threadIdx.x; asm volatile("" : "+v"(tid_));
    const int tid = tid_, seg = tid >> 4, cl = tid & 15;
    const f32x2* SUM = (const f32x2*)((a.ws + z) + WS_SUM); float* CIN = (float*)((a.ws + z) + WS_CIN);
    LAS f32x2* SEG = (LAS f32x2*)lds;
    for (int wg = blockIdx.x; wg < 320; wg += gridDim.x) {
        const int chain = wg * 16 + cl, b = chain / 2560, dir = (chain / LW) & 1, ch = chain % LW;
        f32x2 v[17]; float A = 1.f, Hh = 0.f;
#pragma unroll
        for (int e = 0; e < 17; ++e) { const int s = seg * 17 + e; int c;
            if (s < 8) c = 1024 + b * 8 + (dir ? 7 - s : s); else { const int li = s - 8; c = b * 512 + (dir ? 511 - li : li); }
            v[e] = (s < 520) ? SUM[(size_t)(c * 2 + dir) * LW + ch] : (f32x2){1.f, 0.f}; }
#pragma unroll
        for (int e = 0; e < 17; ++e) { Hh = v[e][0] * Hh + v[e][1]; A *= v[e][0]; }
        __syncthreads();
        SEG[seg * 16 + cl] = (f32x2){A, Hh};
        __syncthreads();
        float Hc = 0.f;
        for (int q = 0; q < seg; ++q) { const f32x2 sv = SEG[q * 16 + cl]; Hc = sv[0] * Hc + sv[1]; }
#pragma unroll
        for (int e = 0; e < 17; ++e) { const int s = seg * 17 + e; int c;
            if (s < 8) c = 1024 + b * 8 + (dir ? 7 - s : s); else { const int li = s - 8; c = b * 512 + (dir ? 511 - li : li); }
            if (s < 520) CIN[(size_t)(c * 2 + dir) * LW + ch] = Hc;
            Hc = v[e][0] * Hc + v[e][1]; }
    }
    __syncthreads();
}

#define XB_TMO      128
#define XB_XCNT(j)  (256  + 64 * (j))
#define XB_XSUB(j)  (1280 + 64 * (j))
#define XB_XGEN(j)  (2304 + 64 * (j))
#define XB_TOP      3328
#define XB_TOPGEN   3392
#define XCD_BAR_WORDS 3456
#define XB_SPIN_CAP (1u << 18)
__device__ __forceinline__ unsigned xb_ld(unsigned* p)              { return __hip_atomic_load(p, __ATOMIC_RELAXED, __HIP_MEMORY_SCOPE_AGENT); }
__device__ __forceinline__ unsigned xb_add(unsigned* p, unsigned v) { return __hip_atomic_fetch_add(p, v, __ATOMIC_RELAXED, __HIP_MEMORY_SCOPE_AGENT); }
__device__ __forceinline__ unsigned xb_xcc_id() { return (unsigned)__builtin_amdgcn_s_getreg((3 << 11) | 20) & 0xFu; }
#define XB_SPIN(cond, bar) do { unsigned _sp = 0; while (cond) { __builtin_amdgcn_s_sleep(1); \
    if ((++_sp & 255u) == 0u) { if (xb_ld(&(bar)[XB_TMO])) break; if (_sp > XB_SPIN_CAP) { atomicAdd(&(bar)[XB_TMO], 1u); break; } } } } while (0)
struct XcdBarrier { unsigned* bar; unsigned x; volatile LAS unsigned* st; };
__device__ __forceinline__ XcdBarrier xcd_barrier_post(unsigned* bar, volatile LAS unsigned* st) {
    XcdBarrier b; b.bar = bar; b.x = xb_xcc_id(); b.st = st;
    if (threadIdx.x == 0) (void)xb_add(&bar[XB_XCNT(b.x)], 1u);
    return b;
}
__device__ __forceinline__ void xcd_barrier_complete(unsigned* bar, unsigned x, unsigned& nloc, unsigned& nx) {
    const unsigned G = gridDim.x * gridDim.y * gridDim.z;
    unsigned sum, cnt, mine, sp = 0u;
    for (;;) {
        sum = 0u; cnt = 0u; mine = 0u;
#pragma unroll
        for (unsigned j = 0; j < 16; ++j) { const unsigned c = xb_ld(&bar[XB_XCNT(j)]); sum += c; cnt += (c > 0u) ? 1u : 0u; mine = (j == x) ? c : mine; }
        if (sum == G) break;
        __builtin_amdgcn_s_sleep(1);
        if ((++sp & 255u) == 0u) { if (xb_ld(&bar[XB_TMO])) break; if (sp > XB_SPIN_CAP) { atomicAdd(&bar[XB_TMO], 1u); break; } }
    }
    nloc = mine > 0u ? mine : 1u; nx = cnt > 0u ? cnt : 1u;
}
__device__ __forceinline__ void xcd_barrier(const XcdBarrier& b) {
    asm volatile("s_waitcnt vmcnt(0)" ::: "memory");
    __syncthreads();
    if (threadIdx.x == 0) {
        unsigned* bar = b.bar;
        __builtin_amdgcn_s_waitcnt(0);
        unsigned nloc = b.st[0], nx = b.st[1];
        if (nloc == 0u) { xcd_barrier_complete(bar, b.x, nloc, nx); b.st[0] = nloc; b.st[1] = nx; }
        const unsigned old = xb_add(&bar[XB_XSUB(b.x)], 1u);
        const unsigned gen = old / nloc;
        if (old + 1u == (gen + 1u) * nloc) {
            __builtin_amdgcn_fence(__ATOMIC_RELEASE, "agent");
            asm volatile("s_waitcnt vmcnt(0)" ::: "memory");
            const unsigned og = xb_add(&bar[XB_TOP], 1u);
            const unsigned tg = og / nx;
            if (og + 1u == (tg + 1u) * nx) xb_add(&bar[XB_TOPGEN], 1u);
            else XB_SPIN(xb_ld(&bar[XB_TOPGEN]) == tg, bar);
            __builtin_amdgcn_fence(__ATOMIC_ACQUIRE, "agent");
            xb_add(&bar[XB_XGEN(b.x)], 1u);
            asm volatile("s_waitcnt vmcnt(0)" ::: "memory");
        } else {
            XB_SPIN(xb_ld(&bar[XB_XGEN(b.x)]) == gen, bar);
            __builtin_amdgcn_fence(__ATOMIC_ACQUIRE, "agent");
            asm volatile("s_waitcnt vmcnt(0)" ::: "memory");
        }
    }
    __syncthreads();
}
#ifndef DBL_MASK
#define DBL_MASK 0
#endif
#ifndef EN_MASK
#define EN_MASK 0xffff
#endif
#define EN(t) ((EN_MASK >> (t)) & 1)
enum { PT_PREP = 0, PT_NORM = 1, PT_G1 = 2, PT_PLAIN = 3, PT_QK = 4, PT_ATT = 5, PT_IN = 6, PT_L2 = 7, PT_L3 = 8, PT_L4 = 9 };
__global__ void __launch_bounds__(512, 2) mega_fwd(Args a) {
    extern __shared__ __attribute__((aligned(16))) unsigned char lds_raw[];
    LAS unsigned char* lds = (LAS unsigned char*)lds_raw;
    cg::grid_group grid = cg::this_grid();
    volatile LAS unsigned* bst = (volatile LAS unsigned*)(lds + LDS_BYTES - 64);
    if (threadIdx.x < 2) bst[threadIdx.x] = 0u;
    __syncthreads();
    const XcdBarrier xbar = xcd_barrier_post((unsigned*)a.ws, bst);
    for (int ph = a.ph_lo; ph < a.ph_hi; ++ph) {
        int z; asm volatile("s_mov_b32 %0, 0" : "=s"(z));
        bf16* HB = (bf16*)((a.ws + z) + WS_HB); bf16* YB = (bf16*)((a.ws + z) + WS_YB); bf16* BIG = (bf16*)((a.ws + z) + WS_BIG);
        const unsigned pd = a.pdesc[ph + z];
        const int type = pd & 0xff, i = (pd >> 8) & 0xff, s = (pd >> 16) & 0xff, sub = (pd >> 24) & 0xff, j = i >> 1;
        for (int rep = ((DBL_MASK >> type) & 1) ? 0 : 1; rep < 2; ++rep) {
        const bool dry = rep == 0;
        if (rep == 1 && DBL_MASK) __syncthreads();
        if (type == PT_PREP && EN(PT_PREP)) prep_phase(a, z, lds);
        else if (type == PT_NORM && EN(PT_NORM)) {
            int res_l = (s > 0) ? i : i - 1, res_s = (s > 0) ? s - 1 : 2;
            const float res_w = (res_s == 1) ? 1.0f : 0.5f;
            norm_phase(a, z, res_l, res_s, res_w, i < 4 ? i : -1, s, dry);
        } else if (type == PT_G1 && EN(PT_G1)) {
            const bf16* W1t = (const bf16*)((a.ws + z) + WS_W) + (size_t)(i * 2 + (s >> 1)) * (W1T_BYTES / 2);
            EpiSwiGLU E{BIG}; run_gemm(lds, HB, W1t, (i == 3 && s == 2) ? ML : MT, 2 * FF, D, E);
        } else if (type == PT_PLAIN && EN(PT_PLAIN)) {
            const bf16* A = BIG; const bf16* Bt; int Mg = MT, Ng = D, K; bf16* O = YB; int ldc = D;
            if (sub == 0) { Bt = (const bf16*)((a.ws + z) + WS_W + 88 * MiB) + (size_t)(i * 2 + (s >> 1)) * (W2T_BYTES / 2); K = FF; }
            else if (sub == 1) { Bt = (const bf16*)((a.ws + z) + WS_W + 132 * MiB) + (size_t)j * (4 * MiB) + 3 * MiB; K = D; }
            else if (sub == 2) { Bt = (const bf16*)((a.ws + z) + WS_W + 148 * MiB) + (size_t)j * (9 * MiB / 2) + LRU_WOL / 2; K = LW; }
            else { A = (const bf16*)((a.ws + z) + WS_W + 132 * MiB) + (size_t)j * (4 * MiB) + 2 * MiB; Bt = HB; Mg = D; Ng = MT; K = D; O = BIG + 2 * ACT_ELEMS; ldc = MT; }
            if (i == 3 && s >= 1 && sub != 3) Mg = ML;
            pg8::EpiBf16<0> E{O, ldc, nullptr, 0, 0}; run_gemm(lds, A, Bt, Mg, Ng, K, E);
        } else if (type == PT_QK && EN(PT_QK)) {
            const bf16* Wn = (const bf16*)((a.ws + z) + WS_W + 132 * MiB) + (size_t)j * (4 * MiB);
            EpiRope E{BIG, BIG + ACT_ELEMS, (const float*)((a.ws + z) + WS_ROPE), (const float*)((a.ws + z) + WS_ROPE) + SEQ * 32};
            run_gemm(lds, HB, Wn, MT, 2048, D, E);
        } else if (type == PT_ATT && EN(PT_ATT)) attn_phase(a, z, j, lds, dry);
        else if (type == PT_IN && EN(PT_IN)) {
            const bf16* Wl = (const bf16*)((a.ws + z) + WS_W + 148 * MiB) + (size_t)j * (9 * MiB / 2);
            EpiGeluSplit E{BIG, BIG + (size_t)MT * LW}; run_gemm(lds, HB, Wl, MT, 2 * LW, D, E);
        } else if (type == PT_L2 && EN(PT_L2)) lru_scan_phase(a, z, j, lds);
        else if (type == PT_L3 && EN(PT_L3)) lru_carry_phase(a, z, lds);
        else if (type == PT_L4 && EN(PT_L4)) lru_apply_phase(a, z, dry);
        }
        if (ph + 1 < a.ph_hi) { if (ph == a.ph_lo) grid.sync(); else xcd_barrier(xbar); }
    }
}
constexpr int N_PHASES = 48;

#ifndef MK_MULTI
#define MK_MULTI 0
#endif
extern "C" void kernel_launch(void* const* d_in, const int* in_sizes, int n_in, void* d_out, int out_size, void* d_ws, size_t ws_size, hipStream_t stream) {
    static int grid = 0;
    if (grid == 0) {
        int dev = 0, cus = 0, per_cu = 0;
        hipGetDevice(&dev);
        hipDeviceGetAttribute(&cus, hipDeviceAttributeMultiprocessorCount, dev);
        if (hipFuncSetAttribute((const void*)mega_fwd, hipFuncAttributeMaxDynamicSharedMemorySize, LDS_BYTES) != hipSuccess) { fprintf(stderr, "hipFuncSetAttribute failed\n"); grid = -1; return; }
        if (hipOccupancyMaxActiveBlocksPerMultiprocessor(&per_cu, (const void*)mega_fwd, 512, LDS_BYTES) != hipSuccess || per_cu < 1) { fprintf(stderr, "occupancy query: %d\n", per_cu); per_cu = 1; }
        (void)hipGetLastError();
        grid = cus * per_cu;
        if (ws_size < WS_END || n_in != 23) { fprintf(stderr, "kernel_launch: ws %zu n_in %d\n", ws_size, n_in); grid = -1; return; }
    }
    if (grid < 0) return;
    Args a{};
    for (int i = 0; i < 23; ++i) a.in[i] = (const float*)d_in[i];
    a.out = (float*)d_out; a.ws = (unsigned char*)d_ws;
    int nj = 0, tiles = 0;
    auto add = [&](int in_idx, long long src_off, size_t dst_off, int K, int N, int ldn, int ldk, int map, int ncol0) {
        TJob& t = a.jobs[nj++]; t.src_off = src_off; t.dst_off = (long long)dst_off; t.in_idx = in_idx; t.map = map; t.ldn = ldn; t.ldk = ldk; t.nnt = N / 128; t.tile0 = tiles; t.ncol0 = ncol0; t.pad = 0;
        tiles += (K / 64) * (N / 128);
    };
    for (int i = 0; i < 4; ++i) for (int f = 0; f < 2; ++f) {
        add(8, (long long)(i * 2 + f) * D * FF, off_w1t(i, f), D, FF, FF, D, 1, 0);
        add(9, (long long)(i * 2 + f) * D * FF, off_w1t(i, f), D, FF, FF, D, 2, 0);
        add(10, (long long)(i * 2 + f) * FF * D, off_w2t(i, f), FF, D, D, FF, 0, 0);
    }
    for (int j = 0; j < 2; ++j) {
        add(11, (long long)j * D * 3 * D, off_na(j), D, 2 * D, 3 * D, D, 3, 0);
        add(11, (long long)j * D * 3 * D, off_na(j) + 4 * MiB, D, D, 3 * D, D, 0, 2 * D);
        add(12, (long long)j * D * D, off_na(j) + 6 * MiB, D, D, D, D, 0, 0);
        add(14, (long long)j * D * 2 * LW, off_lru(j), D, 2 * LW, 2 * LW, D, 0, 0);
        add(22, (long long)j * LW * D, off_lru(j) + LRU_WOL, LW, D, D, LW, 0, 0);
        for (int d = 0; d < 2; ++d) {
            add(17, (long long)(j * 2 + d) * 10 * 128 * 128, off_lru(j) + LRU_WG + (size_t)(d * 2 + 0) * 10 * 128 * 128 * 2, LW, 128, 128, 128, 4, 0);
            add(19, (long long)(j * 2 + d) * 10 * 128 * 128, off_lru(j) + LRU_WG + (size_t)(d * 2 + 1) * 10 * 128 * 128 * 2, LW, 128, 128, 128, 4, 0);
        }
    }
    a.njobs = nj; a.ntiles = tiles;
    {
        int np = 0;
        auto P = [&](int type, int i, int s, int sub) { a.pdesc[np++] = (unsigned)type | ((unsigned)i << 8) | ((unsigned)s << 16) | ((unsigned)sub << 24); };
        P(PT_PREP, 0, 0, 0);
        for (int i = 0; i < 4; ++i) for (int s = 0; s < 3; ++s) {
            P(PT_NORM, i, s, 0);
            if (s != 1) { P(PT_G1, i, s, 0); P(PT_PLAIN, i, s, 0); }
            else if ((i & 1) == 0) { P(PT_QK, i, s, 0); P(PT_PLAIN, i, s, 3); P(PT_ATT, i, s, 0); P(PT_PLAIN, i, s, 1); }
            else { P(PT_IN, i, s, 0); P(PT_L2, i, s, 0); P(PT_L3, i, s, 0); P(PT_L4, i, s, 0); P(PT_PLAIN, i, s, 2); }
        }
        P(PT_NORM, 4, 0, 0);
        if (np != N_PHASES) { fprintf(stderr, "phase count %d\n", np); return; }
    }
#if MK_MULTI
    for (int p = 0; p < N_PHASES; ++p) { a.ph_lo = p; a.ph_hi = p + 1; hipLaunchKernelGGL(mega_fwd, dim3(grid), dim3(512), LDS_BYTES, stream, a); }
#else
    a.ph_lo = 0; a.ph_hi = N_PHASES;
    if (hipMemsetAsync(d_ws, 0, 16384, stream) != hipSuccess) { fprintf(stderr, "memset failed\n"); return; }
    void* kargs[] = {&a};
    hipError_t e = hipLaunchCooperativeKernel((const void*)mega_fwd, dim3(grid), dim3(512), kargs, LDS_BYTES, stream);
    if (e != hipSuccess) fprintf(stderr, "cooperative launch failed: %s (grid %d)\n", hipGetErrorString(e), grid);
#endif
}
```

```cpp
#include <hip/hip_runtime.h>
namespace pg8 {
#define PG8_LAS __attribute__((address_space(3)))
typedef unsigned short bf16_t;
typedef short bf16x8 __attribute__((ext_vector_type(8)));
typedef float f32x4 __attribute__((ext_vector_type(4)));
typedef unsigned u32x4 __attribute__((ext_vector_type(4)));
constexpr int BM = 256, BK = 64, HALF = 128, HTB = HALF * BK * 2  , STAGE_BYTES = 8 * HTB, NXCD = 8, WGM = 8;

__host__ __device__ __forceinline__ int lds_byte(int r, int c) { const int st = (r >> 4) * 2 + (c >> 5), rr = r & 15, cc = c & 31, ob = rr * 64 + cc * 2; return st * 1024 + (ob ^ (((ob >> 9) & 1) << 5)); }
__host__ __device__ __forceinline__ void stage_rc(int b, int& R, int& C) { const int st = b / 1024, sb = b % 1024, swz = sb ^ (((sb >> 9) & 1) << 5); R = (st >> 1) * 16 + swz / 64; C = (st & 1) * 32 + (swz % 64) / 2; }
__host__ __device__ __forceinline__ int perm32(int rho) { const int n = rho >> 4, i = rho & 15; return 8 * (i >> 2) + 4 * n + (i & 3); }

struct Unit { int pm, pn; };
struct Gemm { const bf16_t* A; const bf16_t* Bt; int M, N, K; };

struct StaticOrder {
    int nM, nN, nwg, G, c;
    __host__ __device__ void init(int M, int N, int G_, int c_) { nM = M / BM; nN = N / BM; nwg = nM * nN; G = G_; c = c_; }
    __host__ __device__ bool next(int i, Unit& u) const {
        const long L = (long)i * G + c; if (L >= nwg) return false;
        int wgid = (int)L; { const int q = nwg / NXCD, r = nwg % NXCD, xcd = wgid % NXCD, off = wgid / NXCD; wgid = (xcd < r ? xcd * (q + 1) : r * (q + 1) + (xcd - r) * q) + off; }
        const int nig = WGM * nN, gid = wgid / nig, fm = gid * WGM, gsz = (nM - fm) < WGM ? (nM - fm) : WGM;
        u.pm = fm + ((wgid % nig) % gsz); u.pn = (wgid % nig) / gsz; return true;
    }
    __device__ __forceinline__ void a_ready(const Unit&) const {}
    __device__ __forceinline__ void done(const Unit&) const {}
};
struct CountedOrder : StaticOrder {
    const unsigned* ready; unsigned need; unsigned* tmo;
    __device__ __forceinline__ void a_ready(const Unit& u) const {
        if (threadIdx.x < 64) {
            const unsigned long long t0 = __builtin_amdgcn_s_memrealtime(); unsigned polls = 0;
            while ((unsigned)__builtin_amdgcn_readfirstlane(__hip_atomic_load(ready + 64 * u.pm, __ATOMIC_RELAXED, __HIP_MEMORY_SCOPE_AGENT)) < need) {
                if ((++polls & 255u) == 0u && __builtin_amdgcn_readfirstlane(__hip_atomic_load(tmo, __ATOMIC_RELAXED, __HIP_MEMORY_SCOPE_AGENT)) != 0u) break;
                if (__builtin_amdgcn_s_memrealtime() - t0 > 2000000ull) {
                    if (threadIdx.x == 0) { unsigned expect = 0u; __hip_atomic_compare_exchange_strong(tmo + 1, &expect, 0x600u | (unsigned)(u.pm & 0xff), __ATOMIC_RELAXED, __ATOMIC_RELAXED, __HIP_MEMORY_SCOPE_AGENT); __hip_atomic_store(tmo, 1u, __ATOMIC_RELAXED, __HIP_MEMORY_SCOPE_AGENT); }
                    break; }
                __builtin_amdgcn_s_sleep(2); }
            __builtin_amdgcn_fence(__ATOMIC_ACQUIRE, "agent");
            asm volatile("s_waitcnt vmcnt(0)" ::: "memory");
        }
#if !defined(BROKEN_HOOK_NO_BARRIER)
        asm volatile("" ::: "memory"); __builtin_amdgcn_s_barrier(); asm volatile("" ::: "memory");
#endif
    }
};

__device__ __forceinline__ unsigned cvt_pk_bf16(float lo, float hi) { unsigned r; asm volatile("v_cvt_pk_bf16_f32 %0, %1, %2" : "=v"(r) : "v"(lo), "v"(hi)); return r; }
typedef float f32x2 __attribute__((ext_vector_type(2)));
__device__ __forceinline__ f32x2 gelu_pk(f32x2 v) {
    const f32x2 av = __builtin_elementwise_abs(v), d = av * 0.2316418882f + 1.0f;
    f32x2 t; t.x = __builtin_amdgcn_rcpf(d.x); t.y = __builtin_amdgcn_rcpf(d.y);
    f32x2 q = t * 0.5307027145f + (-0.7265760135f); q = q * t + 0.7107068705f; q = q * t + (-0.142248368f); q = q * t + 0.127414796f; q = q * t;
    const f32x2 s = (v * v) * (-0.72134752044f);
    f32x2 e; e.x = __builtin_amdgcn_exp2f(s.x); e.y = __builtin_amdgcn_exp2f(s.y);
    const f32x2 m = v * (q * e), r = v - m;
    f32x2 o; o.x = v.x < 0.f ? m.x : r.x; o.y = v.y < 0.f ? m.y : r.y; return o;
}

struct EpiF32 {
    static constexpr bool PERM = false, AFTER_DRAIN = false;
    float* C; int ldc; const float* bias;
    __device__ __forceinline__ void operator()(const f32x4 (&acc)[2][2][4][2], const Unit& u, int wr, int wc, int fr, int fq) const {
        const int row0 = u.pm * BM + wr * 64 + fr, col0 = u.pn * BM + wc * 32 + 4 * fq;
        f32x4 bv[2][2];
#pragma unroll
        for (int bj = 0; bj < 2; ++bj)
#pragma unroll
            for (int n = 0; n < 2; ++n) bv[bj][n] = bias ? *(const f32x4*)(bias + col0 + bj * HALF + n * 16) : (f32x4){0.f, 0.f, 0.f, 0.f};
#pragma unroll
        for (int ai = 0; ai < 2; ++ai)
#pragma unroll
            for (int m = 0; m < 4; ++m) { float* rowp = C + (size_t)(row0 + ai * HALF + m * 16) * ldc + col0;
#pragma unroll
                for (int bj = 0; bj < 2; ++bj)
#pragma unroll
                    for (int n = 0; n < 2; ++n) *(f32x4*)(rowp + bj * HALF + n * 16) = acc[ai][bj][m][n] + bv[bj][n]; }
    }
};
template <int ACT  > struct EpiBf16 {
    static constexpr bool PERM = true, AFTER_DRAIN = false;
    bf16_t* O; int ldc; const float* bias; int split_cols; size_t split_stride;
    __device__ __forceinline__ void operator()(const f32x4 (&acc)[2][2][4][2], const Unit& u, int wr, int wc, int fr, int fq) const {
        const int row0 = u.pm * BM + wr * 64 + fr; int colt = u.pn * BM; bf16_t* base = O;
        if (split_cols) { const int t = colt / split_cols; base += (size_t)t * split_stride; colt -= t * split_cols; }
        const int col0 = colt + wc * 32 + 8 * fq, bcol0 = u.pn * BM + wc * 32 + 8 * fq;
        f32x4 bv[2][2];
#pragma unroll
        for (int bj = 0; bj < 2; ++bj)
#pragma unroll
            for (int n = 0; n < 2; ++n) bv[bj][n] = bias ? *(const f32x4*)(bias + bcol0 + bj * HALF + 4 * n) : (f32x4){0.f, 0.f, 0.f, 0.f};
#pragma unroll
        for (int ai = 0; ai < 2; ++ai)
#pragma unroll
            for (int m = 0; m < 4; ++m) { bf16_t* rowp = base + (size_t)(row0 + ai * HALF + m * 16) * ldc + col0;
#pragma unroll
                for (int bj = 0; bj < 2; ++bj) { f32x4 v0 = acc[ai][bj][m][0] + bv[bj][0], v1 = acc[ai][bj][m][1] + bv[bj][1];
                    if (ACT == 1) { f32x2 a = gelu_pk((f32x2){v0[0], v0[1]}), b = gelu_pk((f32x2){v0[2], v0[3]}), c = gelu_pk((f32x2){v1[0], v1[1]}), d = gelu_pk((f32x2){v1[2], v1[3]});
                        v0 = (f32x4){a.x, a.y, b.x, b.y}; v1 = (f32x4){c.x, c.y, d.x, d.y}; }
                    if (ACT == 2) {
#pragma unroll
                        for (int j = 0; j < 4; ++j) { v0[j] = 0.5f * v0[j] * (1.0f + erff(v0[j] * 0.70710678f)); v1[j] = 0.5f * v1[j] * (1.0f + erff(v1[j] * 0.70710678f)); } }
                    u32x4 w; w.x = cvt_pk_bf16(v0[0], v0[1]); w.y = cvt_pk_bf16(v0[2], v0[3]); w.z = cvt_pk_bf16(v1[0], v1[1]); w.w = cvt_pk_bf16(v1[2], v1[3]);
                    *(u32x4*)(rowp + bj * HALF) = w; } }
    }
};

struct PanelStats {
    unsigned* xbuf;
    unsigned* cnt;
    unsigned* tmo;
    int ntn; float eps;
    unsigned code;
    __device__ __forceinline__ bool run(const f32x4 (&v)[2][2][4][2], const Unit& u, int wr, int wc, int fr, int fq, PG8_LAS unsigned char* lds, int wid, int lane) const {
        typedef float f32x2v __attribute__((ext_vector_type(2)));
        PG8_LAS f32x2v* P = (PG8_LAS f32x2v*)lds;
        PG8_LAS f32x2v* S = (PG8_LAS f32x2v*)(lds + 8192);
        PG8_LAS unsigned* flag = (PG8_LAS unsigned*)(lds + 8192 + 2048);
#pragma unroll
        for (int ai = 0; ai < 2; ++ai)
#pragma unroll
            for (int m = 0; m < 4; ++m) {
                float s = 0.f;
#pragma unroll
                for (int bj = 0; bj < 2; ++bj)
#pragma unroll
                    for (int n = 0; n < 2; ++n) { const f32x4 x = v[ai][bj][m][n]; s += (x[0] + x[1]) + (x[2] + x[3]); }
                s += __shfl_xor(s, 16); s += __shfl_xor(s, 32);
                const float mw = s * (1.0f / 64.0f); float q = 0.f;
#pragma unroll
                for (int bj = 0; bj < 2; ++bj)
#pragma unroll
                    for (int n = 0; n < 2; ++n) { const f32x4 d = v[ai][bj][m][n] - mw; q += (d[0] * d[0] + d[1] * d[1]) + (d[2] * d[2] + d[3] * d[3]); }
                q += __shfl_xor(q, 16); q += __shfl_xor(q, 32);
                if (fq == 0) P[(ai * HALF + wr * 64 + m * 16 + fr) * 4 + wc] = (f32x2v){mw, q};
            }
        asm volatile("s_waitcnt lgkmcnt(0)" ::: "memory"); __builtin_amdgcn_s_barrier(); asm volatile("" ::: "memory");
#if defined(BROKEN_NO_WAIT)
        if (blockIdx.x >= 64) { const long long t0 = clock64(); while (clock64() - t0 < 60000) __builtin_amdgcn_s_sleep(8); }
#endif
        const int row = wid * 32 + (lane & 31);
        if (lane < 32) {
            const f32x2v a = P[row * 4 + 0], b = P[row * 4 + 1], c = P[row * 4 + 2], d = P[row * 4 + 3];
            const float mt = (a.x + b.x + c.x + d.x) * 0.25f;
            const float da = a.x - mt, db = b.x - mt, dc = c.x - mt, dd = d.x - mt;
            const float m2 = (a.y + b.y) + (c.y + d.y) + 64.0f * ((da * da + db * db) + (dc * dc + dd * dd));
            unsigned long long* slot = (unsigned long long*)xbuf + ((size_t)(u.pm * BM + row) * 4 + u.pn);
            __hip_atomic_store(slot, ((unsigned long long)__float_as_uint(m2) << 32) | __float_as_uint(mt), __ATOMIC_RELAXED, __HIP_MEMORY_SCOPE_AGENT);
        }
        asm volatile("s_waitcnt vmcnt(0)" ::: "memory");
        if (lane == 0) __hip_atomic_fetch_add(cnt + 64 * u.pm, 1u, __ATOMIC_RELAXED, __HIP_MEMORY_SCOPE_AGENT);
        if (wid == 0) {
            bool dead = false; const unsigned long long t0 = __builtin_amdgcn_s_memrealtime(); const unsigned want = 8u * (unsigned)ntn;
            for (;;) {
#if defined(BROKEN_NO_WAIT)
                break;
#endif
                if ((unsigned)__builtin_amdgcn_readfirstlane(__hip_atomic_load(cnt + 64 * u.pm, __ATOMIC_RELAXED, __HIP_MEMORY_SCOPE_AGENT)) >= want) break;
                if (__builtin_amdgcn_s_memrealtime() - t0 > 2000000ull) {
                    if (lane == 0) { unsigned expect = 0u; __hip_atomic_compare_exchange_strong(tmo + 1, &expect, code | (unsigned)(u.pm & 0xff), __ATOMIC_RELAXED, __ATOMIC_RELAXED, __HIP_MEMORY_SCOPE_AGENT);
                                     __hip_atomic_store(tmo, 1u, __ATOMIC_RELAXED, __HIP_MEMORY_SCOPE_AGENT); }
                    dead = true; break; }
                __builtin_amdgcn_s_sleep(2);
            }
            __builtin_amdgcn_fence(__ATOMIC_ACQUIRE, "agent");
            if (lane == 0) flag[0] = dead ? 1u : 0u;
        }
        asm volatile("s_waitcnt vmcnt(0) lgkmcnt(0)" ::: "memory"); __builtin_amdgcn_s_barrier(); asm volatile("" ::: "memory");
        const bool bad = flag[0] != 0u;
        if (lane < 32) {
            const unsigned long long* slot = (const unsigned long long*)xbuf + (size_t)(u.pm * BM + row) * 4; float mt[4], m2[4]; float ms = 0.f;
#pragma unroll
            for (int t = 0; t < 4; ++t) { if (t < ntn) { const unsigned long long w = __hip_atomic_load(slot + t, __ATOMIC_RELAXED, __HIP_MEMORY_SCOPE_AGENT); mt[t] = __uint_as_float((unsigned)w); m2[t] = __uint_as_float((unsigned)(w >> 32)); } else { mt[t] = 0.f; m2[t] = 0.f; } ms += mt[t]; }
            const float mean = ms / (float)ntn; float q = 0.f;
#pragma unroll
            for (int t = 0; t < 4; ++t) if (t < ntn) { const float dm = mt[t] - mean; q += m2[t] + 256.0f * dm * dm; }
            S[row] = (f32x2v){mean, 1.0f / sqrtf(q / (256.0f * (float)ntn) + eps)};
        }
        asm volatile("s_waitcnt lgkmcnt(0)" ::: "memory"); __builtin_amdgcn_s_barrier(); asm volatile("" ::: "memory");
        return bad;
    }
};
struct EpiLnRes {
    static constexpr bool PERM = false, AFTER_DRAIN = true;
    const float* base; float* out; int ldc; const float* bias; PanelStats st; unsigned poison;
    __device__ __forceinline__ void refuse(size_t i0, size_t stride, int M, int N) const { const float q = __builtin_nanf(""); for (size_t i = i0; i < (size_t)M * N; i += stride) out[(i / N) * ldc + i % N] = q;
        if (i0 == 0) { unsigned expect = 0u; __hip_atomic_compare_exchange_strong(st.tmo + 1, &expect, 0x7f0u, __ATOMIC_RELAXED, __ATOMIC_RELAXED, __HIP_MEMORY_SCOPE_AGENT); __hip_atomic_store(st.tmo, 1u, __ATOMIC_RELAXED, __HIP_MEMORY_SCOPE_AGENT); } }
    __device__ __forceinline__ void fused(f32x4 (&acc)[2][2][4][2], const Unit& u, int wr, int wc, int fr, int fq, PG8_LAS unsigned char* lds, int wid, int lane) const {
        typedef float f32x2v __attribute__((ext_vector_type(2)));
        const PG8_LAS f32x2v* S = (const PG8_LAS f32x2v*)(lds + 8192);
        const int col0 = u.pn * BM + wc * 32 + 4 * fq;
#pragma unroll
        for (int bj = 0; bj < 2; ++bj)
#pragma unroll
            for (int n = 0; n < 2; ++n) { const f32x4 bv = bias ? *(const f32x4*)(bias + col0 + bj * HALF + n * 16) : (f32x4){0.f, 0.f, 0.f, 0.f};
#pragma unroll
                for (int ai = 0; ai < 2; ++ai)
#pragma unroll
                    for (int m = 0; m < 4; ++m) acc[ai][bj][m][n] += bv; }
        const bool bad = st.run(acc, u, wr, wc, fr, fq, lds, wid, lane) || poison != 0u;
        const float qnan = __builtin_nanf("");
#pragma unroll
        for (int ai = 0; ai < 2; ++ai)
#pragma unroll
            for (int m = 0; m < 4; ++m) { const int r = ai * HALF + wr * 64 + m * 16 + fr; const f32x2v sr = S[r]; const size_t off = (size_t)(u.pm * BM + r) * ldc + col0;
#pragma unroll
                for (int bj = 0; bj < 2; ++bj)
#pragma unroll
                    for (int n = 0; n < 2; ++n) { const f32x4 bs = *(const f32x4*)(base + off + bj * HALF + n * 16); f32x4 o = bs + (acc[ai][bj][m][n] - sr.x) * sr.y;
                        if (bad) o = (f32x4){qnan, qnan, qnan, qnan}; *(f32x4*)(out + off + bj * HALF + n * 16) = o; }
                asm volatile("" ::: "memory"); }
    }
};
struct EpiLnResLn {
    static constexpr bool PERM = false, AFTER_DRAIN = true;
    const float* base; float* out; bf16_t* xn; int ldc; const float* bias; PanelStats st1, st2; unsigned poison;
    __device__ __forceinline__ void refuse(size_t i0, size_t stride, int M, int N) const { const float q = __builtin_nanf(""); for (size_t i = i0; i < (size_t)M * N; i += stride) { const size_t o = (i / N) * ldc + i % N; out[o] = q; xn[o] = (bf16_t)0x7fc0u; }
        if (i0 == 0) { unsigned expect = 0u; __hip_atomic_compare_exchange_strong(st1.tmo + 1, &expect, 0x7f0u, __ATOMIC_RELAXED, __ATOMIC_RELAXED, __HIP_MEMORY_SCOPE_AGENT); __hip_atomic_store(st1.tmo, 1u, __ATOMIC_RELAXED, __HIP_MEMORY_SCOPE_AGENT); } }
    __device__ __forceinline__ void fused(f32x4 (&acc)[2][2][4][2], const Unit& u, int wr, int wc, int fr, int fq, PG8_LAS unsigned char* lds, int wid, int lane) const {
        typedef float f32x2v __attribute__((ext_vector_type(2))); typedef unsigned u32x2v __attribute__((ext_vector_type(2)));
        const PG8_LAS f32x2v* S = (const PG8_LAS f32x2v*)(lds + 8192);
        const int col0 = u.pn * BM + wc * 32 + 4 * fq;
#pragma unroll
        for (int bj = 0; bj < 2; ++bj)
#pragma unroll
            for (int n = 0; n < 2; ++n) { const f32x4 bv = bias ? *(const f32x4*)(bias + col0 + bj * HALF + n * 16) : (f32x4){0.f, 0.f, 0.f, 0.f};
#pragma unroll
                for (int ai = 0; ai < 2; ++ai)
#pragma unroll
                    for (int m = 0; m < 4; ++m) acc[ai][bj][m][n] += bv; }
        bool bad = st1.run(acc, u, wr, wc, fr, fq, lds, wid, lane) || poison != 0u;
        const float qnan = __builtin_nanf("");
#pragma unroll
        for (int ai = 0; ai < 2; ++ai)
#pragma unroll
            for (int m = 0; m < 4; ++m) { const int r = ai * HALF + wr * 64 + m * 16 + fr; const f32x2v sr = S[r]; const size_t off = (size_t)(u.pm * BM + r) * ldc + col0;
#pragma unroll
                for (int bj = 0; bj < 2; ++bj)
#pragma unroll
                    for (int n = 0; n < 2; ++n) { const f32x4 bs = *(const f32x4*)(base + off + bj * HALF + n * 16); acc[ai][bj][m][n] = bs + (acc[ai][bj][m][n] - sr.x) * sr.y; }
                asm volatile("" : "+v"(acc[ai][0][m][0]), "+v"(acc[ai][0][m][1]), "+v"(acc[ai][1][m][0]), "+v"(acc[ai][1][m][1]));
                if (m & 1) asm volatile("" ::: "memory"); }
        const bool bad1 = bad;
        bad = st2.run(acc, u, wr, wc, fr, fq, lds, wid, lane) || bad;
#pragma unroll
        for (int ai = 0; ai < 2; ++ai)
#pragma unroll
            for (int m = 0; m < 4; ++m) { const int r = ai * HALF + wr * 64 + m * 16 + fr; const f32x2v sr = S[r]; const size_t off = (size_t)(u.pm * BM + r) * ldc + col0;
#pragma unroll
                for (int bj = 0; bj < 2; ++bj)
#pragma unroll
                    for (int n = 0; n < 2; ++n) { const f32x4 x1 = acc[ai][bj][m][n]; *(f32x4*)(out + off + bj * HALF + n * 16) = bad1 ? (f32x4){qnan, qnan, qnan, qnan} : x1;
                        const f32x4 o = (x1 - sr.x) * sr.y; u32x2v w; w.x = cvt_pk_bf16(o[0], o[1]); w.y = cvt_pk_bf16(o[2], o[3]);
                        if (bad) { w.x = 0x7fc07fc0u; w.y = 0x7fc07fc0u; } *(u32x2v*)(xn + off + bj * HALF + n * 16) = w; }
                asm volatile("" ::: "memory"); }
    }
};

template <class Epi, class Sched, bool ALIGN_EPI = false, bool SP2 = false>
__device__ __forceinline__ void gemm_phase(PG8_LAS unsigned char* lds, const Gemm g, const Sched& S, const Epi& E) {
    int tid_l = threadIdx.x; asm volatile("" : "+v"(tid_l));
    const int tid = tid_l, wid = __builtin_amdgcn_readfirstlane(tid >> 6), lane = tid & 63, wr = wid >> 2, wc = wid & 3, fr = lane & 15, fq = lane >> 4;
    const int K = g.K, nt = K / BK;
    unsigned voffA[2], voffB[2];
#pragma unroll
    for (int i = 0; i < 2; ++i) { int R, C; stage_rc(tid * 16 + i * 8192, R, C); const int Rb = Epi::PERM ? ((R & ~31) + perm32(R & 31)) : R;
        voffA[i] = (unsigned)(R * K + C) * 2u; voffB[i] = (unsigned)(Rb * K + C) * 2u; }
    const size_t kstep = (size_t)(BK * 2);
    const size_t hstep = (size_t)HALF * K * 2;
    const size_t tstep = 2 * hstep;
    const unsigned ldsw = (unsigned)wid * 1024u;
    const int aoff = lds_byte(wr * 64 + fr, fq * 8), boff = lds_byte(wc * 32 + fr, fq * 8);
#define PG8_SA(b, h) (((b) * 2 + (h)) * HTB)
#define PG8_SB(b, h) ((4 + (b) * 2 + (h)) * HTB)
#define PG8_STAGE(bufoff, gbase, voff) do { _Pragma("unroll") for (int _i = 0; _i < 2; ++_i) \
        __builtin_amdgcn_global_load_lds((const unsigned*)((const char*)(gbase) + (voff)[_i]), (PG8_LAS unsigned*)(lds + (bufoff) + ldsw + _i * 8192), 16, 0, 0); } while (0)
#define PG8_LDA(dst, b, h) do { _Pragma("unroll") for (int m = 0; m < 4; ++m) _Pragma("unroll") for (int k = 0; k < 2; ++k) dst[m][k] = *(const PG8_LAS bf16x8*)(lds + PG8_SA(b, h) + aoff + m * 2048 + k * 1024); } while (0)
#define PG8_LDB(dst, b, h) do { _Pragma("unroll") for (int n = 0; n < 2; ++n) _Pragma("unroll") for (int k = 0; k < 2; ++k) dst[n][k] = *(const PG8_LAS bf16x8*)(lds + PG8_SB(b, h) + boff + n * 2048 + k * 1024); } while (0)
#define PG8_MMA(ai, bj, At, Bt) do { __builtin_amdgcn_s_setprio(1); _Pragma("unroll") for (int m = 0; m < 4; ++m) _Pragma("unroll") for (int n = 0; n < 2; ++n) _Pragma("unroll") for (int k = 0; k < 2; ++k) \
        acc[ai][bj][m][n] = __builtin_amdgcn_mfma_f32_16x16x32_bf16(Bt[n][k], At[m][k], acc[ai][bj][m][n], 0, 0, 0); __builtin_amdgcn_s_setprio(0); } while (0)
#define PG8_WAIT_V(n) asm volatile("s_waitcnt vmcnt(" #n ")" ::: "memory")
#define PG8_WAIT_L(n) asm volatile("s_waitcnt lgkmcnt(" #n ")" ::: "memory")
#define PG8_BAR __builtin_amdgcn_s_barrier()
#define PG8_SCHED __builtin_amdgcn_sched_barrier(0)
    Unit cur, nxt; int ui = 0;
    if (!S.next(0, cur)) return;
    f32x4 acc[2][2][4][2];
#pragma unroll
    for (int a = 0; a < 2; ++a)
#pragma unroll
        for (int b = 0; b < 2; ++b)
#pragma unroll
            for (int m = 0; m < 4; ++m)
#pragma unroll
                for (int n = 0; n < 2; ++n) acc[a][b][m][n] = (f32x4){0.f, 0.f, 0.f, 0.f};
    bf16x8 At[4][2], B0[2][2], B1[2][2];
    const char* cA = (const char*)g.A + (size_t)cur.pm * tstep; const char* cB = (const char*)g.Bt + (size_t)cur.pn * tstep;
    S.a_ready(cur);
    if constexpr (SP2) {
        PG8_STAGE(PG8_SB(0, 0), cB, voffB); PG8_STAGE(PG8_SB(0, 1), cB + hstep, voffB); PG8_STAGE(PG8_SA(0, 0), cA, voffA); PG8_STAGE(PG8_SA(0, 1), cA + hstep, voffA);
        if (wr == 1) PG8_BAR;
        PG8_WAIT_V(2); PG8_BAR;
        PG8_STAGE(PG8_SB(1, 0), cB + kstep, voffB); PG8_STAGE(PG8_SA(1, 0), cA + kstep, voffA); PG8_STAGE(PG8_SB(1, 1), cB + hstep + kstep, voffB);
        PG8_WAIT_V(6); PG8_BAR;
    } else {
        PG8_STAGE(PG8_SB(0, 0), cB, voffB); PG8_STAGE(PG8_SA(0, 0), cA, voffA); PG8_STAGE(PG8_SB(0, 1), cB + hstep, voffB); PG8_STAGE(PG8_SA(0, 1), cA + hstep, voffA);
        if (wr == 1) PG8_BAR;
        PG8_WAIT_V(4); PG8_BAR;
        PG8_STAGE(PG8_SB(1, 0), cB + kstep, voffB); PG8_STAGE(PG8_SA(1, 0), cA + kstep, voffA); PG8_STAGE(PG8_SB(1, 1), cB + hstep + kstep, voffB);
        PG8_WAIT_V(6); PG8_BAR;
    }
    for (;;) {
        const bool has_next = S.next(ui + 1, nxt);
        const char* nA = has_next ? (const char*)g.A + (size_t)nxt.pm * tstep : cA; const char* nB = has_next ? (const char*)g.Bt + (size_t)nxt.pn * tstep : cB;
        for (int t = 0; t < nt; t += 2) {
            const bool last = (t == nt - 2);
            const char* a1 = cA + (size_t)(t + 1) * kstep;
            const char* a2 = last ? nA : cA + (size_t)(t + 2) * kstep; const char* b2 = last ? nB : cB + (size_t)(t + 2) * kstep;
            const char* a3 = a2 + kstep; const char* b3 = b2 + kstep;
            if (last && has_next) S.a_ready(nxt);
            if constexpr (SP2) {
            PG8_LDB(B0, 0, 0); PG8_LDB(B1, 0, 1); PG8_SCHED; PG8_LDA(At, 0, 0); PG8_STAGE(PG8_SA(1, 1), a1 + hstep, voffA);
            PG8_WAIT_V(8); PG8_WAIT_L(0); PG8_BAR; PG8_MMA(0, 0, At, B0); PG8_MMA(0, 1, At, B1); PG8_BAR; PG8_SCHED;
            PG8_LDA(At, 0, 1); PG8_STAGE(PG8_SB(0, 0), b2, voffB); PG8_STAGE(PG8_SB(0, 1), b2 + hstep, voffB); PG8_STAGE(PG8_SA(0, 0), a2, voffA);
            PG8_WAIT_V(8); PG8_WAIT_L(0); PG8_BAR; PG8_MMA(1, 0, At, B0); PG8_MMA(1, 1, At, B1); PG8_BAR; PG8_SCHED;
            PG8_LDB(B0, 1, 0); PG8_LDB(B1, 1, 1); PG8_SCHED; PG8_LDA(At, 1, 0); PG8_STAGE(PG8_SA(0, 1), a2 + hstep, voffA);
            PG8_WAIT_V(8); PG8_WAIT_L(0); PG8_BAR; PG8_MMA(0, 0, At, B0); PG8_MMA(0, 1, At, B1); PG8_BAR; PG8_SCHED;
            PG8_LDA(At, 1, 1); PG8_STAGE(PG8_SB(1, 0), b3, voffB); PG8_STAGE(PG8_SB(1, 1), b3 + hstep, voffB); PG8_STAGE(PG8_SA(1, 0), a3, voffA);
            PG8_WAIT_V(8); PG8_WAIT_L(0); PG8_BAR; PG8_MMA(1, 0, At, B0); PG8_MMA(1, 1, At, B1); PG8_BAR; PG8_SCHED;
            } else {
            PG8_LDB(B0, 0, 0); PG8_SCHED; PG8_LDA(At, 0, 0); PG8_STAGE(PG8_SA(1, 1), a1 + hstep, voffA);
            PG8_WAIT_L(8); PG8_BAR; PG8_WAIT_L(0); PG8_MMA(0, 0, At, B0); PG8_BAR; PG8_SCHED;
            PG8_LDB(B1, 0, 1); PG8_STAGE(PG8_SB(0, 0), b2, voffB);
            PG8_BAR; PG8_WAIT_L(0); PG8_MMA(0, 1, At, B1); PG8_BAR;
            PG8_LDA(At, 0, 1); PG8_STAGE(PG8_SA(0, 0), a2, voffA);
            PG8_BAR; PG8_WAIT_L(0); PG8_MMA(1, 0, At, B0); PG8_BAR; PG8_SCHED;
            PG8_STAGE(PG8_SB(0, 1), b2 + hstep, voffB);
            PG8_WAIT_V(6); PG8_BAR; PG8_MMA(1, 1, At, B1); PG8_BAR;
            PG8_LDB(B0, 1, 0); PG8_SCHED; PG8_LDA(At, 1, 0); PG8_STAGE(PG8_SA(0, 1), a2 + hstep, voffA);
            PG8_WAIT_L(8); PG8_BAR; PG8_WAIT_L(0); PG8_MMA(0, 0, At, B0); PG8_BAR; PG8_SCHED;
            PG8_LDB(B1, 1, 1); PG8_STAGE(PG8_SB(1, 0), b3, voffB);
            PG8_BAR; PG8_WAIT_L(0); PG8_MMA(0, 1, At, B1); PG8_BAR;
            PG8_LDA(At, 1, 1); PG8_STAGE(PG8_SA(1, 0), a3, voffA);
            PG8_BAR; PG8_WAIT_L(0); PG8_MMA(1, 0, At, B0); PG8_BAR; PG8_SCHED;
            PG8_STAGE(PG8_SB(1, 1), b3 + hstep, voffB);
            PG8_WAIT_V(6); PG8_BAR; PG8_MMA(1, 1, At, B1); PG8_BAR;
            }
        }
        if constexpr (ALIGN_EPI) { if (wr == 0) PG8_BAR; }
        if constexpr (!Epi::AFTER_DRAIN) { E(acc, cur, wr, wc, fr, fq); S.done(cur); }
        if (!has_next) break;
#pragma unroll
        for (int a = 0; a < 2; ++a)
#pragma unroll
            for (int b = 0; b < 2; ++b)
#pragma unroll
                for (int m = 0; m < 4; ++m)
#pragma unroll
                    for (int n = 0; n < 2; ++n) acc[a][b][m][n] = (f32x4){0.f, 0.f, 0.f, 0.f};
        cur = nxt; cA = nA; cB = nB; ++ui;
        if constexpr (ALIGN_EPI) { if (wr == 1) PG8_BAR; }
    }
    PG8_WAIT_V(0);
    if constexpr (!ALIGN_EPI) { if (wr == 0) PG8_BAR; }
    PG8_BAR;
    if constexpr (Epi::AFTER_DRAIN) { E.fused(acc, cur, wr, wc, fr, fq, lds, wid, lane); S.done(cur); }
#undef PG8_SA
#undef PG8_SB
#undef PG8_STAGE
#undef PG8_LDA
#undef PG8_LDB
#undef PG8_MMA
#undef PG8_WAIT_V
#undef PG8_WAIT_L
#undef PG8_BAR
#undef PG8_SCHED
}
}

#include <hip/hip_cooperative_groups.h>
#include <cstdio>
namespace cg = cooperative_groups;

#define LAS __attribute__((address_space(3)))
typedef unsigned short bf16;
typedef float f32x4 __attribute__((ext_vector_type(4)));
typedef float f32x2 __attribute__((ext_vector_type(2)));
typedef short bf16x8 __attribute__((ext_vector_type(8)));
typedef unsigned u32x4 __attribute__((ext_vector_type(4)));
typedef unsigned u32x2 __attribute__((ext_vector_type(2)));
typedef _Float16 h16x4 __attribute__((ext_vector_type(4)));
typedef _Float16 h16x8 __attribute__((ext_vector_type(8)));

constexpr int D = 1024, ML = 32768, MC = 512, MT = 33280, SEQ = 16384, CTXL = 256, FF = 2816, LW = 1280;
constexpr int NMOD = 9216;
constexpr size_t MiB = 1u << 20;
constexpr size_t WS_MOD = 1 * MiB, WS_ROPE = 2 * MiB, WS_XC = 6 * MiB, WS_W = 40 * MiB;
constexpr size_t WS_HB = 206 * MiB, WS_YB = 271 * MiB, WS_BIG = 336 * MiB;
constexpr size_t HL_BYTES = (size_t)MT * LW * 2;
constexpr size_t WS_SUM = WS_BIG + 2 * HL_BYTES, WS_CIN = WS_SUM + 21 * MiB;
constexpr size_t WS_LF = WS_HB, WS_LB2 = WS_HB + HL_BYTES;
constexpr size_t WS_XA = 8 * MiB, WS_XB = 531 * MiB, WS_XCH = 563 * MiB, WS_END = 564 * MiB;
constexpr size_t W1T_BYTES = 11 * MiB, W2T_BYTES = 5 * MiB + MiB / 2;
__host__ __device__ constexpr size_t off_w1t(int i, int f) { return WS_W + (size_t)(i * 2 + f) * W1T_BYTES; }
__host__ __device__ constexpr size_t off_w2t(int i, int f) { return WS_W + 88 * MiB + (size_t)(i * 2 + f) * W2T_BYTES; }
__host__ __device__ constexpr size_t off_na(int j) { return WS_W + 132 * MiB + (size_t)j * 8 * MiB; }
__host__ __device__ constexpr size_t off_lru(int j) { return WS_W + 148 * MiB + (size_t)j * 9 * MiB; }
constexpr size_t LRU_WOL = 5 * MiB, LRU_WG = 7 * MiB + MiB / 2;
constexpr size_t ACT_ELEMS = (size_t)MT * D;
constexpr int LDS_BYTES = 147456;

struct TJob { long long src_off; long long dst_off; int in_idx, map, ldn, ldk, nnt, tile0, ncol0, pad; };
constexpr int MAXJOBS = 44;
struct Args {
    const float* in[23];
    float* out;
    unsigned char* ws;
    int ph_lo, ph_hi, njobs, ntiles;
    unsigned pdesc[48];
    TJob jobs[MAXJOBS];
};

__device__ __forceinline__ float bf2f(unsigned short v) { return __uint_as_float((unsigned)v << 16); }
__device__ __forceinline__ unsigned pk2(float lo, float hi) { return pg8::cvt_pk_bf16(lo, hi); }
__device__ __forceinline__ float wave_sum(float v) {
#pragma unroll
    for (int o = 1; o < 64; o <<= 1) v += __shfl_xor(v, o);
    return v;
}
__device__ __forceinline__ float sigmoidf_(float v) { return __builtin_amdgcn_rcpf(1.0f + __expf(-v)); }

struct EpiSwiGLU {
    static constexpr bool PERM = true, AFTER_DRAIN = false;
    bf16* O;
    __device__ __forceinline__ void operator()(const f32x4 (&acc)[2][2][4][2], const pg8::Unit& u, int wr, int wc, int fr, int fq) const {
        const int row0 = u.pm * 256 + wr * 64 + fr, colh = u.pn * 128 + wc * 32 + 8 * fq;
#pragma unroll
        for (int ai = 0; ai < 2; ++ai)
#pragma unroll
            for (int m = 0; m < 4; ++m) { bf16* rowp = O + (size_t)(row0 + ai * 128 + m * 16) * FF + colh;
                float o[8];
#pragma unroll
                for (int n = 0; n < 2; ++n) { const f32x4 g = acc[ai][0][m][n], up = acc[ai][1][m][n];
                    const f32x4 ng = __builtin_elementwise_max(g, (f32x4){-14.f, -14.f, -14.f, -14.f}) * -1.4426950408889634f;
                    const f32x4 d = (f32x4){__builtin_amdgcn_exp2f(ng[0]), __builtin_amdgcn_exp2f(ng[1]), __builtin_amdgcn_exp2f(ng[2]), __builtin_amdgcn_exp2f(ng[3])} + 1.0f;
                    const float p01 = d[0] * d[1], p23 = d[2] * d[3]; const float t = __builtin_amdgcn_rcpf(p01 * p23);
                    const float i01 = t * p23, i23 = t * p01;
                    const f32x4 gu = g * up;
                    o[4 * n + 0] = gu[0] * (i01 * d[1]); o[4 * n + 1] = gu[1] * (i01 * d[0]); o[4 * n + 2] = gu[2] * (i23 * d[3]); o[4 * n + 3] = gu[3] * (i23 * d[2]); }
                u32x4 w; w.x = pk2(o[0], o[1]); w.y = pk2(o[2], o[3]); w.z = pk2(o[4], o[5]); w.w = pk2(o[6], o[7]);
                *(u32x4*)rowp = w; }
    }
};
struct EpiRope {
    static constexpr bool PERM = true, AFTER_DRAIN = false;
    bf16* Q; bf16* K; const float* ctab; const float* stab;
    __device__ __forceinline__ void operator()(const f32x4 (&acc)[2][2][4][2], const pg8::Unit& u, int wr, int wc, int fr, int fq) const {
        const int row0 = u.pm * 256 + wr * 64 + fr;
        const int i = 4 * (wc & 1) + fq;
#pragma unroll
        for (int ai = 0; ai < 2; ++ai)
#pragma unroll
            for (int m = 0; m < 4; ++m) {
                const int row = row0 + ai * 128 + m * 16;
                f32x4 cs = (f32x4){1.f, 1.f, 1.f, 1.f}, sn = (f32x4){0.f, 0.f, 0.f, 0.f};
                if (row < ML) { const int t = row & (SEQ - 1); cs = *(const f32x4*)(ctab + t * 32 + 4 * i); sn = *(const f32x4*)(stab + t * 32 + 4 * i); }
#pragma unroll
                for (int bj = 0; bj < 2; ++bj) {
                    const int c = u.pn * 256 + bj * 128 + wc * 32;
                    const bool isk = c >= 1024; const int head = (c & 1023) >> 6;
                    const float sc = isk ? 1.0f : 0.18033688011112042f;
                    bf16* dst = (isk ? K : Q) + (size_t)row * D + head * 64 + 4 * i;
                    const f32x4 x1 = acc[ai][bj][m][0], x2 = acc[ai][bj][m][1];
                    const f32x4 o1 = (x1 * cs - x2 * sn) * sc, o2 = (x1 * sn + x2 * cs) * sc;
                    u32x2 w1, w2; w1.x = pk2(o1[0], o1[1]); w1.y = pk2(o1[2], o1[3]); w2.x = pk2(o2[0], o2[1]); w2.y = pk2(o2[2], o2[3]);
                    *(u32x2*)dst = w1; *(u32x2*)(dst + 32) = w2; } }
    }
};
struct EpiGeluSplit {
    static constexpr bool PERM = true, AFTER_DRAIN = false;
    bf16* G; bf16* V;
    __device__ __forceinline__ void operator()(const f32x4 (&acc)[2][2][4][2], const pg8::Unit& u, int wr, int wc, int fr, int fq) const {
        const int row0 = u.pm * 256 + wr * 64 + fr; const bool isg = u.pn < 5;
        const int col0 = (isg ? u.pn * 256 : u.pn * 256 - LW) + wc * 32 + 8 * fq;
        bf16* base = isg ? G : V;
#pragma unroll
        for (int ai = 0; ai < 2; ++ai)
#pragma unroll
            for (int m = 0; m < 4; ++m) { bf16* rowp = base + (size_t)(row0 + ai * 128 + m * 16) * LW + col0;
#pragma unroll
                for (int bj = 0; bj < 2; ++bj) { f32x4 v0 = acc[ai][bj][m][0], v1 = acc[ai][bj][m][1];
                    if (isg) {
#pragma unroll
                        for (int e = 0; e < 4; ++e) { const float a = v0[e], b = v1[e];
                            v0[e] = a * sigmoidf_(1.5957691216f * (a + 0.044715f * a * a * a));
                            v1[e] = b * sigmoidf_(1.5957691216f * (b + 0.044715f * b * b * b)); } }
                    u32x4 w; w.x = pk2(v0[0], v0[1]); w.y = pk2(v0[2], v0[3]); w.z = pk2(v1[0], v1[1]); w.w = pk2(v1[2], v1[3]);
                    *(u32x4*)(rowp + bj * 128) = w; } }
    }
};

#ifndef PG8_ALIGN_EPI
#define PG8_ALIGN_EPI false
#endif
#ifndef PG8_USE_SP2
#define PG8_USE_SP2 true
#endif
template <class Epi>
__device__ __forceinline__ void run_gemm(LAS unsigned char* lds, const bf16* A, const bf16* Bt, int Mg, int Ng, int K, const Epi& E) {
    int bid = blockIdx.x, gsz = gridDim.x; asm volatile("" : "+s"(bid), "+s"(gsz));
    pg8::Gemm g{A, Bt, Mg, Ng, K}; pg8::StaticOrder S; S.init(Mg, Ng, gsz, bid);
    pg8::gemm_phase<Epi, pg8::StaticOrder, PG8_ALIGN_EPI, PG8_USE_SP2>(lds, g, S, E);
}

__device__ __forceinline__ const float* pick_in(const Args& a, const int z, int idx) {
    const float* p = a.in[8 + z];
    p = idx == 9 ? a.in[9 + z] : p; p = idx == 10 ? a.in[10 + z] : p; p = idx == 11 ? a.in[11 + z] : p; p = idx == 12 ? a.in[12 + z] : p;
    p = idx == 14 ? a.in[14 + z] : p; p = idx == 17 ? a.in[17 + z] : p; p = idx == 19 ? a.in[19 + z] : p; p = idx == 22 ? a.in[22 + z] : p;
    return p;
}
__device__ __forceinline__ int map_row(int map, int n) {
    if (map == 1) return 256 * (n >> 7) + (n & 127);
    if (map == 2) return 256 * (n >> 7) + 128 + (n & 127);
    if (map == 3) { const int hc = n >> 6, d = n & 63; return 64 * hc + 8 * ((d & 31) >> 2) + 4 * (d >> 5) + (d & 3); }
    return n;
}
__device__ __forceinline__ void prep_phase(const Args& a, const int z, LAS unsigned char* lds) {
    int tid_ = threadIdx.x; asm volatile("" : "+v"(tid_));
    const int tid = tid_, wave = __builtin_amdgcn_readfirstlane(tid >> 6), lane = tid & 63;
    float* MOD = (float*)((a.ws + z) + WS_MOD);
    LAS float* sc = (LAS float*)lds;
    LAS float* red = (LAS float*)(lds + 16384);
    bool have_sc = false;
    for (int it = blockIdx.x; it < 144; it += gridDim.x) {
        if (!have_sc) {
            for (int e = tid; e < 3 * D; e += 512) { const int r = e >> 10, k = e & 1023; const float v = r < 2 ? a.in[1 + z][r * D + k] : a.in[3 + z][k]; sc[e] = v * sigmoidf_(v); }
            have_sc = true; __syncthreads();
        }
        const int layer = it / 36, cg0 = (it % 36) * 256;
        const float* W = a.in[4 + z] + (size_t)layer * D * NMOD + cg0 + 4 * lane;
        f32x4 acc0 = (f32x4){0.f, 0.f, 0.f, 0.f}, acc1 = acc0, acc2 = acc0;
        const int kb = wave * 128;
        for (int k0 = 0; k0 < 128; k0 += 8) {
            f32x4 w[8];
#pragma unroll
            for (int e = 0; e < 8; ++e) w[e] = *(const f32x4*)(W + (size_t)(kb + k0 + e) * NMOD);
#pragma unroll
            for (int e = 0; e < 8; ++e) { const float s0 = sc[kb + k0 + e], s1 = sc[D + kb + k0 + e], s2 = sc[2 * D + kb + k0 + e];
                acc0 += w[e] * s0; acc1 += w[e] * s1; acc2 += w[e] * s2; }
        }
        *(LAS f32x4*)(red + (wave * 3 + 0) * 256 + 4 * lane) = acc0;
        *(LAS f32x4*)(red + (wave * 3 + 1) * 256 + 4 * lane) = acc1;
        *(LAS f32x4*)(red + (wave * 3 + 2) * 256 + 4 * lane) = acc2;
        __syncthreads();
        for (int e = tid; e < 768; e += 512) { const int r = e >> 8, c = e & 255; float s = 0.f;
#pragma unroll
            for (int w8 = 0; w8 < 8; ++w8) s += red[(w8 * 3 + r) * 256 + c];
            MOD[(size_t)(layer * 3 + r) * NMOD + cg0 + c] = s + a.in[5 + z][layer * NMOD + cg0 + c]; }
        __syncthreads();
    }
    {
        float* ctab = (float*)((a.ws + z) + WS_ROPE); float* stab = ctab + SEQ * 32;
        for (int e = blockIdx.x * 512 + tid; e < SEQ * 32; e += gridDim.x * 512) {
            const int t = e >> 5, p = e & 31; const float pos = (float)(p < 16 ? (t >> 6) : (t & 63));
            const float invf = powf(10000.0f, -(float)(p & 15) / 16.0f); const float ang = pos * invf;
            ctab[e] = cosf(ang); stab[e] = sinf(ang); }
    }
    __syncthreads();
    LAS float* T = (LAS float*)(lds + 65536);
    int jxs = 0;
    for (int tile0 = blockIdx.x; tile0 < a.ntiles; tile0 += 2 * gridDim.x) {
        bf16* dst[2]; int mapk[2], ldk[2], k0s[2], n0s[2]; bool ok[2];
#pragma unroll
        for (int q = 0; q < 2; ++q) {
            const int tile = tile0 + q * (int)gridDim.x; ok[q] = tile < a.ntiles; const int tl = ok[q] ? tile : tile0;
            if (tl < a.jobs[jxs].tile0) jxs = 0;
            while (jxs + 1 < a.njobs && tl >= a.jobs[jxs + 1].tile0) ++jxs;
            const TJob jb = a.jobs[jxs];
            const int local = tl - jb.tile0, kt = local / jb.nnt, nt = local % jb.nnt; k0s[q] = kt * 64; n0s[q] = nt * 128;
            dst[q] = (bf16*)((a.ws + z) + jb.dst_off); mapk[q] = jb.map; ldk[q] = jb.ldk;
            const int kk = tid >> 3, nj = (tid & 7) * 4;
            const float* p = pick_in(a, z, jb.in_idx) + jb.src_off + (size_t)(k0s[q] + kk) * jb.ldn + jb.ncol0 + n0s[q] + nj;
            LAS float* t = T + q * 8256 + kk * 129 + nj;
#pragma unroll
            for (int j = 0; j < 4; ++j) { const f32x4 v = *(const f32x4*)(p + 32 * j); t[32 * j] = v[0]; t[32 * j + 1] = v[1]; t[32 * j + 2] = v[2]; t[32 * j + 3] = v[3]; }
        }
        __syncthreads();
#pragma unroll
        for (int q = 0; q < 2; ++q) if (ok[q]) {
            const int nl = tid >> 2, ks = (tid & 3) * 16; const LAS float* t = T + q * 8256 + ks * 129 + nl;
            u32x4 o0, o1;
            o0.x = pk2(t[0], t[129]); o0.y = pk2(t[2 * 129], t[3 * 129]); o0.z = pk2(t[4 * 129], t[5 * 129]); o0.w = pk2(t[6 * 129], t[7 * 129]);
            o1.x = pk2(t[8 * 129], t[9 * 129]); o1.y = pk2(t[10 * 129], t[11 * 129]); o1.z = pk2(t[12 * 129], t[13 * 129]); o1.w = pk2(t[14 * 129], t[15 * 129]);
            size_t drow, dcol;
            if (mapk[q] == 4) { drow = (size_t)((k0s[q] >> 7) * 128 + n0s[q] + nl); dcol = (size_t)((k0s[q] & 127) + ks); }
            else { drow = (size_t)map_row(mapk[q], n0s[q] + nl); dcol = (size_t)(k0s[q] + ks); }
            bf16* dp = dst[q] + drow * ldk[q] + dcol;
            *(u32x4*)dp = o0; *(u32x4*)(dp + 8) = o1; }
        __syncthreads();
    }
}

__device__ __forceinline__ void norm_phase(const Args& a, const int z, int res_l, int res_s, float res_w, int pre_l, int pre_s, bool dry) {
    int tid_ = threadIdx.x; asm volatile("" : "+v"(tid_));
    const int tid = tid_, wave = __builtin_amdgcn_readfirstlane(tid >> 6), lane = tid & 63;
    const int gw = blockIdx.x * 8 + wave, NGW = gridDim.x * 8;
    const float* MOD = (const float*)((a.ws + z) + WS_MOD);
    const bf16* YB = (const bf16*)((a.ws + z) + WS_YB);
    bf16* HB = (bf16*)((a.ws + z) + WS_HB);
    const bool first = res_l < 0, has_pre = pre_l >= 0;
    const int rbeg = (int)(((long long)gw * MT) / NGW), rend = (int)(((long long)(gw + 1) * MT) / NGW);
    f32x4 vres[4], vsc[4], vsh[4]; int rcur = -1;
    for (int rowa = rbeg; rowa < rend; rowa += 2) {
        int rows[2] = {rowa, rowa + 1}; bool v1 = rows[1] < rend;
        const int rcl = rowa < SEQ ? 0 : (rowa < ML ? 1 : 2);
        if (v1 && (rows[1] < SEQ ? 0 : (rows[1] < ML ? 1 : 2)) != rcl) v1 = false;
        if (!v1) rows[1] = rowa;
        if (rcl != rcur) {
            rcur = rcl;
            if (!first) { const float* gate = MOD + (size_t)(res_l * 3 + rcl) * NMOD + (3 * res_s + 2) * D; const float* gpost = a.in[7 + z] + (size_t)(res_l * 3 + res_s) * D;
#pragma unroll
                for (int j = 0; j < 4; ++j) vres[j] = *(const f32x4*)(gate + j * 256 + 4 * lane) * *(const f32x4*)(gpost + j * 256 + 4 * lane) * res_w; }
            if (has_pre) { const float* mb = MOD + (size_t)(pre_l * 3 + rcl) * NMOD + (3 * pre_s) * D; const float* gpre = a.in[6 + z] + (size_t)(pre_l * 3 + pre_s) * D;
#pragma unroll
                for (int j = 0; j < 4; ++j) { vsh[j] = *(const f32x4*)(mb + j * 256 + 4 * lane); vsc[j] = (*(const f32x4*)(mb + D + j * 256 + 4 * lane) + 1.0f) * *(const f32x4*)(gpre + j * 256 + 4 * lane); } }
        }
        _Float16* x16[2];
#pragma unroll
        for (int q = 0; q < 2; ++q) { const int row = rows[q];
            x16[q] = (_Float16*)((a.ws + z) + (row < SEQ ? WS_XA : (row < ML ? WS_XB : WS_XCH))) + (size_t)(row < SEQ ? row : (row < ML ? row - SEQ : row - ML)) * D; }
        f32x4 xv[2][4]; f32x4 yv[2][4];
        if (first) {
#pragma unroll
            for (int q = 0; q < 2; ++q) { const int row = rows[q]; const float* xs = row < ML ? a.in[0 + z] + (size_t)row * D : a.in[2 + z] + (size_t)(row - ML) * D;
#pragma unroll
                for (int j = 0; j < 4; ++j) xv[q][j] = *(const f32x4*)(xs + j * 256 + 4 * lane); }
        } else {
#pragma unroll
            for (int q = 0; q < 2; ++q)
#pragma unroll
                for (int j = 0; j < 4; ++j) { const h16x4 hv = __builtin_nontemporal_load((const h16x4*)(x16[q] + j * 256 + 4 * lane));
                    xv[q][j] = (f32x4){(float)hv[0], (float)hv[1], (float)hv[2], (float)hv[3]}; }
        }
        if (!first) {
            float ss[2] = {0.f, 0.f};
#pragma unroll
            for (int q = 0; q < 2; ++q)
#pragma unroll
                for (int j = 0; j < 4; ++j) { const u32x2 w = __builtin_nontemporal_load((const u32x2*)(YB + (size_t)rows[q] * D + j * 256 + 4 * lane));
                    yv[q][j] = (f32x4){__uint_as_float(w.x << 16), __uint_as_float(w.x & 0xffff0000u), __uint_as_float(w.y << 16), __uint_as_float(w.y & 0xffff0000u)};
                    ss[q] += (yv[q][j][0] * yv[q][j][0] + yv[q][j][1] * yv[q][j][1]) + (yv[q][j][2] * yv[q][j][2] + yv[q][j][3] * yv[q][j][3]); }
#pragma unroll
            for (int o = 1; o < 64; o <<= 1) { ss[0] += __shfl_xor(ss[0], o); ss[1] += __shfl_xor(ss[1], o); }
#pragma unroll
            for (int q = 0; q < 2; ++q) { const float rstd = rsqrtf(ss[q] * (1.0f / D) + 1e-6f);
#pragma unroll
                for (int j = 0; j < 4; ++j) xv[q][j] += vres[j] * yv[q][j] * rstd; }
        }
#pragma unroll
        for (int q = 0; q < 2; ++q) if (q == 0 || v1) {
            if (has_pre) {
#pragma unroll
                for (int j = 0; j < 4; ++j) __builtin_nontemporal_store((h16x4){(_Float16)xv[q][j][0], (_Float16)xv[q][j][1], (_Float16)xv[q][j][2], (_Float16)xv[q][j][3]}, (h16x4*)(x16[q] + j * 256 + 4 * lane));
            } else if (rows[q] < ML) {
#pragma unroll
                for (int j = 0; j < 4; ++j) *(f32x4*)((a.out + z) + (size_t)rows[q] * D + j * 256 + 4 * lane) = xv[q][j];
            }
        }
        if (has_pre) {
            float ss[2] = {0.f, 0.f};
#pragma unroll
            for (int q = 0; q < 2; ++q)
#pragma unroll
                for (int j = 0; j < 4; ++j) ss[q] += (xv[q][j][0] * xv[q][j][0] + xv[q][j][1] * xv[q][j][1]) + (xv[q][j][2] * xv[q][j][2] + xv[q][j][3] * xv[q][j][3]);
#pragma unroll
            for (int o = 1; o < 64; o <<= 1) { ss[0] += __shfl_xor(ss[0], o); ss[1] += __shfl_xor(ss[1], o); }
#pragma unroll
            for (int q = 0; q < 2; ++q) if (q == 0 || v1) { const float rstd = rsqrtf(ss[q] * (1.0f / D) + 1e-6f);
#pragma unroll
                for (int j = 0; j < 4; ++j) { const f32x4 h = xv[q][j] * rstd * vsc[j] + vsh[j];
                    u32x2 w; w.x = pk2(h[0], h[1]); w.y = pk2(h[2], h[3]);
                    *(u32x2*)(HB + (size_t)rows[q] * D + j * 256 + 4 * lane) = w; } }
        }
    }
}

struct KVFrag { bf16x8 k[2][2]; bf16x8 v[4]; };
__device__ __forceinline__ void attn_load(KVFrag& f, const bf16* Kb, const bf16* Vt, int T0, int krow, int h, int fr, int g) {
    const bf16* kp = Kb + (size_t)(T0 + krow) * D + h * 64 + g * 8;
#pragma unroll
    for (int t = 0; t < 2; ++t)
#pragma unroll
        for (int ks = 0; ks < 2; ++ks) f.k[t][ks] = *(const bf16x8*)(kp + (size_t)(4 * t) * D + ks * 32);
    const bf16* vp = Vt + (size_t)(h * 64 + fr) * MT + T0 + g * 8;
#pragma unroll
    for (int dt = 0; dt < 4; ++dt) f.v[dt] = *(const bf16x8*)(vp + (size_t)(dt * 16) * MT);
}
__device__ __forceinline__ void attn_step(const KVFrag& f, const bf16x8 qb0, const bf16x8 qb1, const bool lat, const LAS float* bpl, const unsigned vm,
                                          f32x4 (&o)[4], float& mrun, float& lrun) {
    f32x4 s0 = (f32x4){0.f, 0.f, 0.f, 0.f}, s1 = s0;
    s0 = __builtin_amdgcn_mfma_f32_16x16x32_bf16(f.k[0][0], qb0, s0, 0, 0, 0);
    s0 = __builtin_amdgcn_mfma_f32_16x16x32_bf16(f.k[0][1], qb1, s0, 0, 0, 0);
    s1 = __builtin_amdgcn_mfma_f32_16x16x32_bf16(f.k[1][0], qb0, s1, 0, 0, 0);
    s1 = __builtin_amdgcn_mfma_f32_16x16x32_bf16(f.k[1][1], qb1, s1, 0, 0, 0);
    float s[8] = {s0[0], s0[1], s0[2], s0[3], s1[0], s1[1], s1[2], s1[3]};
    if (lat) {
#pragma unroll
        for (int e = 0; e < 8; ++e) { const float bv = bpl[e]; s[e] = ((vm >> e) & 1u) ? s[e] + bv : -1e30f; }
    }
    float cm = fmaxf(fmaxf(fmaxf(s[0], s[1]), fmaxf(s[2], s[3])), fmaxf(fmaxf(s[4], s[5]), fmaxf(s[6], s[7])));
    if (__any(cm > mrun + 40.0f)) {
        cm = fmaxf(cm, __shfl_xor(cm, 16)); cm = fmaxf(cm, __shfl_xor(cm, 32));
        const float mnew = fmaxf(mrun, cm); const float alpha = __builtin_amdgcn_exp2f(mrun - mnew);
        lrun *= alpha; mrun = mnew;
#pragma unroll
        for (int dt = 0; dt < 4; ++dt) o[dt] = o[dt] * alpha;
    }
    float ps = 0.f;
#pragma unroll
    for (int e = 0; e < 8; ++e) { s[e] = __builtin_amdgcn_exp2f(s[e] - mrun); ps += s[e]; }
    lrun += ps;
    union { u32x4 u; bf16x8 v; } pb;
    pb.u.x = pk2(s[0], s[1]); pb.u.y = pk2(s[2], s[3]); pb.u.z = pk2(s[4], s[5]); pb.u.w = pk2(s[6], s[7]);
#pragma unroll
    for (int dt = 0; dt < 4; ++dt) o[dt] = __builtin_amdgcn_mfma_f32_16x16x32_bf16(f.v[dt], pb.v, o[dt], 0, 0, 0);
}
constexpr int A_KC = 0, A_KP = 144, A_VC = 36864, A_VP = 528, A_RP = 36864 + 33792, A_QS = 36864 + 33792 + 2560;
__device__ __forceinline__ void attn_phase(const Args& a, const int z, int j, LAS unsigned char* lds, bool dry) {
    int tid_ = threadIdx.x; asm volatile("" : "+v"(tid_));
    const int tid = tid_, wave = __builtin_amdgcn_readfirstlane(tid >> 6), lane = tid & 63, fr = lane & 15, g = lane >> 4;
    bf16* Q = (bf16*)((a.ws + z) + WS_BIG); const bf16* Kb = Q + ACT_ELEMS; const bf16* Vt = Q + 2 * ACT_ELEMS;
    const int krow = (fr >> 2) * 8 + (fr & 3);
    for (int wg = blockIdx.x; wg < 256; wg += gridDim.x) {
        const int xcd = wg & 7, idx = wg >> 3, pair = xcd * 4 + (idx >> 3), sub = idx & 7, b = pair >> 4, h = pair & 15;
        __syncthreads();
        for (int e = tid; e < 256 * 8; e += 512) { const int key = e >> 3, p = e & 7;
            *(LAS u32x4*)(lds + A_KC + key * A_KP + p * 16) = *(const u32x4*)(Kb + (size_t)(ML + b * CTXL + key) * D + h * 64 + p * 8); }
        for (int e = tid; e < 64 * 32; e += 512) { const int d = e >> 5, p = e & 31;
            *(LAS u32x4*)(lds + A_VC + d * A_VP + p * 16) = *(const u32x4*)(Vt + (size_t)(h * 64 + d) * MT + ML + b * CTXL + p * 8); }
        { const float* rpb = a.in[13 + z] + (size_t)(j * 16 + h) * 465; for (int e = tid; e < 465; e += 512) ((LAS float*)(lds + A_RP))[64 + e] = rpb[e] * 1.4426950408889634f; }
        __syncthreads();
        if (wave < 2) {
            const int qrow0 = ML + b * CTXL + (sub * 2 + wave) * 16;
            bf16* qp = Q + (size_t)(qrow0 + fr) * D + h * 64;
            const bf16x8 qb0 = *(const bf16x8*)(qp + g * 8), qb1 = *(const bf16x8*)(qp + 32 + g * 8);
            f32x4 o[4];
#pragma unroll
            for (int dt = 0; dt < 4; ++dt) o[dt] = (f32x4){0.f, 0.f, 0.f, 0.f};
            float mrun = -1e30f, lrun = 0.f;
            for (int cc = 0; cc < 8; ++cc) {
                KVFrag f;
#pragma unroll
                for (int t = 0; t < 2; ++t)
#pragma unroll
                    for (int ks = 0; ks < 2; ++ks) f.k[t][ks] = *(const LAS bf16x8*)(lds + A_KC + (cc * 32 + krow + 4 * t) * A_KP + (ks * 32 + g * 8) * 2);
#pragma unroll
                for (int dt = 0; dt < 4; ++dt) f.v[dt] = *(const LAS bf16x8*)(lds + A_VC + (dt * 16 + fr) * A_VP + (cc * 32 + g * 8) * 2);
                attn_step(f, qb0, qb1, false, nullptr, 0u, o, mrun, lrun);
            }
            lrun += __shfl_xor(lrun, 16); lrun += __shfl_xor(lrun, 32);
            const float inv = 1.0f / lrun;
            bf16* op = dry ? (bf16*)((a.ws + z) + WS_HB) + (size_t)(qrow0 + fr) * D + h * 64 : qp;
#pragma unroll
            for (int dt = 0; dt < 4; ++dt) { u32x2 w; w.x = pk2(o[dt][0] * inv, o[dt][1] * inv); w.y = pk2(o[dt][2] * inv, o[dt][3] * inv);
                *(u32x2*)(op + dt * 16 + g * 4) = w; }
        }
        for (int li = wave; li < 32; li += 8) {
            const int rg = li >> 2, cq = li & 3, rbase = sub * 32 + rg * 4;
            const int cw = cq == 0 ? 0 : (cq == 1 ? 8 : (cq == 2 ? 24 : 32));
            const int cqq = cq * 16 + fr, c0 = min(max(cqq - 8, 0), 48);
            unsigned vm = 0u;
#pragma unroll
            for (int e = 0; e < 8; ++e) { const int rel = cw + g * 8 + e - c0; vm |= (rel >= 0 && rel < 16) ? (1u << e) : 0u; }
            const LAS float* rpl = (const LAS float*)(lds + A_RP) + 64 + (cw + g * 8 - cqq + 15);
            bf16* qp = Q + (size_t)(b * SEQ + rbase * 64 + cq * 16 + fr) * D + h * 64;
            f32x4 o[4][4]; float mrun[4], lrun[4];
            LAS unsigned char* qs = lds + A_QS + wave * 8192 + lane * 16;
#pragma unroll
            for (int t = 0; t < 4; ++t) { *(LAS bf16x8*)(qs + t * 2048) = *(const bf16x8*)(qp + (size_t)t * 64 * D + g * 8); *(LAS bf16x8*)(qs + t * 2048 + 1024) = *(const bf16x8*)(qp + (size_t)t * 64 * D + 32 + g * 8);
                mrun[t] = -1e30f; lrun[t] = 0.f;
#pragma unroll
                for (int dt = 0; dt < 4; ++dt) o[t][dt] = (f32x4){0.f, 0.f, 0.f, 0.f}; }
            const int kr_lo = min(max(rbase - 4, 0), 248), kr_hi = min(max(rbase - 1, 0), 248) + 7;
            KVFrag cur, nxt;
            attn_load(cur, Kb, Vt, b * SEQ + kr_lo * 64 + cw, krow, h, fr, g);
            nxt = cur;
            for (int kr = kr_lo; kr <= kr_hi; ++kr) {
                if (kr < kr_hi) attn_load(nxt, Kb, Vt, b * SEQ + (kr + 1) * 64 + cw, krow, h, fr, g);
#pragma unroll
                for (int t = 0; t < 4; ++t) { const int r = rbase + t, r0 = min(max(r - 4, 0), 248);
                    if (kr >= r0 && kr < r0 + 8)
                        attn_step(cur, *(const LAS bf16x8*)(qs + t * 2048), *(const LAS bf16x8*)(qs + t * 2048 + 1024), true, rpl + (kr - r + 7) * 31, vm, o[t], mrun[t], lrun[t]); }
                cur = nxt;
            }
            for (int cc = 0; cc < 8; ++cc) {
                KVFrag f;
#pragma unroll
                for (int t = 0; t < 2; ++t)
#pragma unroll
                    for (int ks = 0; ks < 2; ++ks) f.k[t][ks] = *(const LAS bf16x8*)(lds + A_KC + (cc * 32 + krow + 4 * t) * A_KP + (ks * 32 + g * 8) * 2);
#pragma unroll
                for (int dt = 0; dt < 4; ++dt) f.v[dt] = *(const LAS bf16x8*)(lds + A_VC + (dt * 16 + fr) * A_VP + (cc * 32 + g * 8) * 2);
#pragma unroll
                for (int t = 0; t < 4; ++t) attn_step(f, *(const LAS bf16x8*)(qs + t * 2048), *(const LAS bf16x8*)(qs + t * 2048 + 1024), false, nullptr, 0u, o[t], mrun[t], lrun[t]);
            }
#pragma unroll
            for (int t = 0; t < 4; ++t) {
                float lt = lrun[t]; lt += __shfl_xor(lt, 16); lt += __shfl_xor(lt, 32);
                const float inv = 1.0f / lt;
                bf16* op = (dry ? (bf16*)((a.ws + z) + WS_HB) + (size_t)(b * SEQ + rbase * 64 + cq * 16 + fr) * D + h * 64 : qp) + (size_t)t * 64 * D;
#pragma unroll
                for (int dt = 0; dt < 4; ++dt) { u32x2 w; w.x = pk2(o[t][dt][0] * inv, o[t][dt][1] * inv); w.y = pk2(o[t][dt][2] * inv, o[t][dt][3] * inv);
                    *(u32x2*)(op + dt * 16 + g * 4) = w; }
            }
        }
    }
    __syncthreads();
}

constexpr int UP = 132;
constexpr int L_U32 = 0, L_UB = 33792, L_GB = 51200, L_T1 = 68608, L_T2 = 86016;
#define LRU_PREFETCH(TASK) do { const int n_ = (TASK) / 1040, c_ = (TASK) - n_ * 1040, m0_ = c_ * 32; int lo_, hi_; \
        if (m0_ < ML) { lo_ = (m0_ / SEQ) * SEQ; hi_ = lo_ + SEQ; } else { lo_ = ML + ((m0_ - ML) / CTXL) * CTXL; hi_ = lo_ + CTXL; } \
        _Pragma("unroll") for (int tap = 0; tap < 4; ++tap) { const int mr = m0_ + tokc + tap - 2; \
            pv[tap] = (mr >= lo_ && mr < hi_) ? *(const u32x4*)(V + (size_t)mr * LW + n_ * 128 + ch8) : (u32x4){0u, 0u, 0u, 0u}; } \
        if (FINAL) pg = *(const u32x4*)(G + (size_t)(m0_ + tokc) * LW + n_ * 128 + ch8); } while (0)
__device__ __forceinline__ unsigned char* lb_row_ptr(const Args& a, const int z, int row) {
    return row < SEQ ? (unsigned char*)(a.out + z) + HL_BYTES + (size_t)row * (LW * 2) : (a.ws + z) + WS_LB2 + (size_t)(row - SEQ) * (LW * 2);
}
__device__ __forceinline__ void lru_scan_phase(const Args& a, const int z, int j, LAS unsigned char* lds) {
    constexpr bool FINAL = false;
    int tid_ = threadIdx.x; asm volatile("" : "+v"(tid_));
    const int tid = tid_, wave = __builtin_amdgcn_readfirstlane(tid >> 6), lane = tid & 63, fr = lane & 15, g = lane >> 4;
    const int tokc = tid >> 4, ch8 = (tid & 15) * 8, ct = wave, ch = ct * 16 + fr;
    bf16* G = (bf16*)((a.ws + z) + WS_BIG); const bf16* V = G + (size_t)MT * LW;
    const bf16* Wg = (const bf16*)((a.ws + z) + off_lru(j) + LRU_WG);
    const float* convw = a.in[15 + z] + (size_t)j * 4 * LW; const float* convb = a.in[16 + z] + (size_t)j * LW;
    const float* b_a = a.in[18 + z] + (size_t)j * 2 * LW; const float* b_x = a.in[20 + z] + (size_t)j * 2 * LW; const float* lam = a.in[21 + z] + (size_t)j * 2 * LW;
    f32x2* SUM = (f32x2*)((a.ws + z) + WS_SUM);
    unsigned char* HLg = (unsigned char*)(a.out + z); unsigned char* LFg = (a.ws + z) + WS_LF;
    int cur_n = -1, pm0 = 0, pn = 0;
    bf16x8 bw[4][4]; float cba[2] = {0.f, 0.f}, cbx[2] = {0.f, 0.f}, csp[2] = {0.f, 0.f};
    f32x4 cw[4][2], cbias[2];
    u32x4 pv[4], pg = (u32x4){0u, 0u, 0u, 0u};
    int task = blockIdx.x, it = 0;
    if (task < 10400) LRU_PREFETCH(task);
    for (; task < 10400; ++it, task += gridDim.x) {
        const int buf = it & 1;
        const int n = task / 1040, c = task - n * 1040, m0 = c * 32;
        LAS float* U32 = (LAS float*)(lds + L_U32) + buf * 32 * UP; LAS bf16* UB = (LAS bf16*)(lds + L_UB) + buf * 32 * 136; LAS bf16* GB = (LAS bf16*)(lds + L_GB) + buf * 32 * 136; LAS _Float16* T1 = (LAS _Float16*)(lds + L_T1) + buf * 32 * 136; LAS _Float16* T2 = (LAS _Float16*)(lds + L_T2) + buf * 32 * 136;
        if (n != cur_n) {
            cur_n = n;
#pragma unroll
            for (int tap = 0; tap < 4; ++tap) { cw[tap][0] = *(const f32x4*)(convw + tap * LW + n * 128 + ch8); cw[tap][1] = *(const f32x4*)(convw + tap * LW + n * 128 + ch8 + 4); }
            cbias[0] = *(const f32x4*)(convb + n * 128 + ch8); cbias[1] = *(const f32x4*)(convb + n * 128 + ch8 + 4);
#pragma unroll
            for (int cb = 0; cb < 4; ++cb)
#pragma unroll
                for (int ks = 0; ks < 4; ++ks) bw[cb][ks] = *(const bf16x8*)(Wg + ((size_t)(cb * 10 + n) * 128 + ch) * 128 + ks * 32 + g * 8);
#pragma unroll
            for (int dir = 0; dir < 2; ++dir) { cba[dir] = b_a[dir * LW + n * 128 + ch]; cbx[dir] = b_x[dir * LW + n * 128 + ch]; csp[dir] = -8.0f * 1.4426950408889634f * log1pf(__expf(-lam[dir * LW + n * 128 + ch])); }
        }
        { f32x4 u0 = cbias[0], u1 = cbias[1];
#pragma unroll
          for (int tap = 0; tap < 4; ++tap) { const u32x4 vv = pv[tap];
              u0 += cw[tap][0] * (f32x4){__uint_as_float(vv.x << 16), __uint_as_float(vv.x & 0xffff0000u), __uint_as_float(vv.y << 16), __uint_as_float(vv.y & 0xffff0000u)};
              u1 += cw[tap][1] * (f32x4){__uint_as_float(vv.z << 16), __uint_as_float(vv.z & 0xffff0000u), __uint_as_float(vv.w << 16), __uint_as_float(vv.w & 0xffff0000u)}; }
          *(LAS f32x4*)(U32 + tokc * UP + ch8) = u0; *(LAS f32x4*)(U32 + tokc * UP + ch8 + 4) = u1;
          u32x4 w; w.x = pk2(u0[0], u0[1]); w.y = pk2(u0[2], u0[3]); w.z = pk2(u1[0], u1[1]); w.w = pk2(u1[2], u1[3]);
          *(LAS u32x4*)(UB + tokc * 136 + ch8) = w;
          }
        __syncthreads();
        if (it > 0) {
            const int pb = (buf ^ 1) * 32 * 136; const size_t go = ((size_t)(pm0 + tokc) * LW + pn * 128 + ch8) * 2;
            *(u32x4*)(HLg + go) = *(const LAS u32x4*)((const LAS bf16*)(lds + L_GB) + pb + tokc * 136 + ch8);
            *(u32x4*)(LFg + go) = *(const LAS u32x4*)((const LAS _Float16*)(lds + L_T1) + pb + tokc * 136 + ch8);
            *(u32x4*)(lb_row_ptr(a, z, pm0 + tokc) + (size_t)(pn * 128 + ch8) * 2) = *(const LAS u32x4*)((const LAS _Float16*)(lds + L_T2) + pb + tokc * 136 + ch8); }
        { const int tn = task + gridDim.x; if (tn < 10400) LRU_PREFETCH(tn); }
        f32x4 acc[2][4];
#pragma unroll
        for (int rt = 0; rt < 2; ++rt)
#pragma unroll
            for (int cb = 0; cb < 4; ++cb) acc[rt][cb] = (f32x4){0.f, 0.f, 0.f, 0.f};
#pragma unroll
        for (int ks = 0; ks < 4; ++ks) {
            bf16x8 af[2];
#pragma unroll
            for (int rt = 0; rt < 2; ++rt) af[rt] = *(const LAS bf16x8*)(UB + (rt * 16 + fr) * 136 + ks * 32 + g * 8);
#pragma unroll
            for (int cb = 0; cb < 4; ++cb)
#pragma unroll
                for (int rt = 0; rt < 2; ++rt) acc[rt][cb] = __builtin_amdgcn_mfma_f32_16x16x32_bf16(af[rt], bw[cb][ks], acc[rt][cb], 0, 0, 0);
        }
        float uv[2][4];
#pragma unroll
        for (int rt = 0; rt < 2; ++rt)
#pragma unroll
            for (int jj = 0; jj < 4; ++jj) uv[rt][jj] = U32[(rt * 16 + g * 4 + jj) * UP + ch];
        float rec[2][4];
#pragma unroll
        for (int rt = 0; rt < 2; ++rt)
#pragma unroll
            for (int jj = 0; jj < 4; ++jj) rec[rt][jj] = 0.f;
#pragma unroll
        for (int dir = 0; dir < 2; ++dir) {
            float av[2][4], bv[2][4], lav[2][4], SA[2], SB[2];
#pragma unroll
            for (int rt = 0; rt < 2; ++rt) {
#pragma unroll
                for (int jp = 0; jp < 2; ++jp) {
                    const f32x2 xr = (f32x2){acc[rt][dir * 2][2 * jp], acc[rt][dir * 2][2 * jp + 1]} + cba[dir];
                    const f32x2 xi = (f32x2){acc[rt][dir * 2 + 1][2 * jp], acc[rt][dir * 2 + 1][2 * jp + 1]} + cbx[dir];
                    const f32x2 nr = __builtin_elementwise_max(xr, (f32x2){-30.f, -30.f}) * -1.4426950408889634f;
                    const f32x2 ni = __builtin_elementwise_max(xi, (f32x2){-30.f, -30.f}) * -1.4426950408889634f;
                    const f32x2 er1 = (f32x2){__builtin_amdgcn_exp2f(nr.x), __builtin_amdgcn_exp2f(nr.y)} + 1.0f;
                    const f32x2 ei1 = (f32x2){__builtin_amdgcn_exp2f(ni.x), __builtin_amdgcn_exp2f(ni.y)} + 1.0f;
                    const f32x2 pr = er1 * ei1;
                    const f32x2 tinv = (f32x2){__builtin_amdgcn_rcpf(pr.x), __builtin_amdgcn_rcpf(pr.y)};
                    const f32x2 rg = tinv * ei1, ig = tinv * er1;
                    const f32x2 la2 = rg * csp[dir];
                    const f32x2 a_ = (f32x2){__builtin_amdgcn_exp2f(la2.x), __builtin_amdgcn_exp2f(la2.y)};
                    const f32x2 x2 = la2 * 1.3862943611198906f;
                    const f32x2 ser = -x2 * (x2 * (x2 * (x2 * 0.041666668f + 0.16666667f) + 0.5f) + 1.0f);
                    const f32x2 alt = 1.0f - a_ * a_;
                    f32x2 om; om.x = x2.x > -0.1f ? ser.x : alt.x; om.y = x2.y > -0.1f ? ser.y : alt.y;
                    om = __builtin_elementwise_max(om, (f32x2){0.f, 0.f});
                    const f32x2 sq = (f32x2){__builtin_amdgcn_sqrtf(om.x), __builtin_amdgcn_sqrtf(om.y)};
                    const f32x2 b_ = sq * ig * (f32x2){uv[rt][2 * jp], uv[rt][2 * jp + 1]};
                    av[rt][2 * jp] = a_.x; av[rt][2 * jp + 1] = a_.y; bv[rt][2 * jp] = b_.x; bv[rt][2 * jp + 1] = b_.y; lav[rt][2 * jp] = la2.x; lav[rt][2 * jp + 1] = la2.y; }
                float sa = 1.f, sb = 0.f;
#pragma unroll
                for (int q = 0; q < 4; ++q) { const int jj = dir ? 3 - q : q; sb = av[rt][jj] * sb + bv[rt][jj]; sa *= av[rt][jj]; }
                SA[rt] = sa; SB[rt] = sb;
            }
            float Hrun = 0.f, Atot = 1.f, myc[2] = {0.f, 0.f}, myab[2] = {1.f, 1.f};
#pragma unroll
            for (int q = 0; q < 8; ++q) { const int rt = dir ? 1 - (q >> 2) : (q >> 2), gg = dir ? 3 - (q & 3) : (q & 3);
                const float sa = __shfl(SA[rt], fr + 16 * gg), sb = __shfl(SB[rt], fr + 16 * gg);
                myc[rt] = (gg == g) ? Hrun : myc[rt]; myab[rt] = (gg == g) ? Atot : myab[rt];
                Hrun = sa * Hrun + sb; Atot *= sa; }
            if (g == 0) SUM[(size_t)(c * 2 + dir) * LW + n * 128 + ch] = (f32x2){Atot, Hrun};
            LAS _Float16* TL = dir ? T2 : T1;
#pragma unroll
            for (int rt = 0; rt < 2; ++rt) { float h = myc[rt], lp = __builtin_amdgcn_logf(myab[rt]);
#pragma unroll
                for (int q = 0; q < 4; ++q) { const int jj = dir ? 3 - q : q; h = av[rt][jj] * h + bv[rt][jj]; rec[rt][jj] += h;
                    lp += lav[rt][jj]; TL[(rt * 16 + g * 4 + jj) * 136 + ch] = (_Float16)lp; } }
        }
#pragma unroll
        for (int rt = 0; rt < 2; ++rt)
#pragma unroll
            for (int jj = 0; jj < 4; ++jj) GB[(rt * 16 + g * 4 + jj) * 136 + ch] = (bf16)(pk2(rec[rt][jj], 0.f) & 0xffffu);
        pm0 = m0; pn = n;
    }
    __syncthreads();
    if (it > 0) { const int pb = ((it - 1) & 1) * 32 * 136; const size_t go = ((size_t)(pm0 + tokc) * LW + pn * 128 + ch8) * 2;
        *(u32x4*)(HLg + go) = *(const LAS u32x4*)((const LAS bf16*)(lds + L_GB) + pb + tokc * 136 + ch8);
        *(u32x4*)(LFg + go) = *(const LAS u32x4*)((const LAS _Float16*)(lds + L_T1) + pb + tokc * 136 + ch8);
        *(u32x4*)(lb_row_ptr(a, z, pm0 + tokc) + (size_t)(pn * 128 + ch8) * 2) = *(const LAS u32x4*)((const LAS _Float16*)(lds + L_T2) + pb + tokc * 136 + ch8); }
    __syncthreads();
}
__device__ __forceinline__ void lru_apply_phase(const Args& a, const int z, bool dry) {
    int tid_ = threadIdx.x; asm volatile("" : "+v"(tid_));
    const int tid = tid_;
    bf16* G = (bf16*)((a.ws + z) + WS_BIG); const float* CIN = (const float*)((a.ws + z) + WS_CIN);
    const unsigned char* HLg = (const unsigned char*)(a.out + z); const unsigned char* LFg = (a.ws + z) + WS_LF;
    const int stride = (int)gridDim.x * 512;
    for (int idx0 = blockIdx.x * 512 + tid; idx0 < MT * 160; idx0 += 4 * stride) {
        u32x4 hl[4], gv[4]; h16x8 lf[4], lb[4]; f32x4 cfa[4][2], cba[4][2]; size_t go[4]; bool ok[4];
#pragma unroll
        for (int k = 0; k < 4; ++k) { const int idx = idx0 + k * stride; ok[k] = idx < MT * 160; const int id = ok[k] ? idx : idx0;
            const int row = id / 160, c8 = (id - row * 160) * 8, chunk = row >> 5; go[k] = ((size_t)row * LW + c8) * 2;
            hl[k] = *(const u32x4*)(HLg + go[k]); gv[k] = *(const u32x4*)((const unsigned char*)G + go[k]);
            lf[k] = *(const h16x8*)(LFg + go[k]); lb[k] = *(const h16x8*)(lb_row_ptr(a, z, row) + (size_t)c8 * 2);
            const float* cfp = CIN + (size_t)(chunk * 2) * LW + c8;
            cfa[k][0] = *(const f32x4*)cfp; cfa[k][1] = *(const f32x4*)(cfp + 4); cba[k][0] = *(const f32x4*)(cfp + LW); cba[k][1] = *(const f32x4*)(cfp + LW + 4); }
#pragma unroll
        for (int k = 0; k < 4; ++k) if (ok[k]) {
            const unsigned hw[4] = {hl[k].x, hl[k].y, hl[k].z, hl[k].w}, gw[4] = {gv[k].x, gv[k].y, gv[k].z, gv[k].w};
            float r[8];
#pragma unroll
            for (int e = 0; e < 8; ++e) { const float hv = (e & 1) ? __uint_as_float(hw[e >> 1] & 0xffff0000u) : __uint_as_float(hw[e >> 1] << 16);
                const float gg = (e & 1) ? __uint_as_float(gw[e >> 1] & 0xffff0000u) : __uint_as_float(gw[e >> 1] << 16);
                r[e] = (hv + __builtin_amdgcn_exp2f((float)lf[k][e]) * cfa[k][e >> 2][e & 3] + __builtin_amdgcn_exp2f((float)lb[k][e]) * cba[k][e >> 2][e & 3]) * gg; }
            u32x4 w; w.x = pk2(r[0], r[1]); w.y = pk2(r[2], r[3]); w.z = pk2(r[4], r[5]); w.w = pk2(r[6], r[7]);
            *(u32x4*)((unsigned char*)G + (dry ? HL_BYTES : 0) + go[k]) = w;
        }
    }
}
__device__ __forceinline__ void lru_carry_phase(const Args& a, const int z, LAS unsigned char* lds) {
    int tid_ = threadIdx.x; asm volatile("" : "+v"(tid_));
    const int tid = tid_, seg = tid >> 4, cl = tid & 15;
    const f32x2* SUM = (const f32x2*)((a.ws + z) + WS_SUM); float* CIN = (float*)((a.ws + z) + WS_CIN);
    LAS f32x2* SEG = (LAS f32x2*)lds;
    for (int wg = blockIdx.x; wg < 320; wg += gridDim.x) {
        const int chain = wg * 16 + cl, b = chain / 2560, dir = (chain / LW) & 1, ch = chain % LW;
        f32x2 v[17]; float A = 1.f, Hh = 0.f;
#pragma unroll
        for (int e = 0; e < 17; ++e) { const int s = seg * 17 + e; int c;
            if (s < 8) c = 1024 + b * 8 + (dir ? 7 - s : s); else { const int li = s - 8; c = b * 512 + (dir ? 511 - li : li); }
            v[e] = (s < 520) ? SUM[(size_t)(c * 2 + dir) * LW + ch] : (f32x2){1.f, 0.f}; }
#pragma unroll
        for (int e = 0; e < 17; ++e) { Hh = v[e][0] * Hh + v[e][1]; A *= v[e][0]; }
        __syncthreads();
        SEG[seg * 16 + cl] = (f32x2){A, Hh};
        __syncthreads();
        float Hc = 0.f;
        for (int q = 0; q < seg; ++q) { const f32x2 sv = SEG[q * 16 + cl]; Hc = sv[0] * Hc + sv[1]; }
#pragma unroll
        for (int e = 0; e < 17; ++e) { const int s = seg * 17 + e; int c;
            if (s < 8) c = 1024 + b * 8 + (dir ? 7 - s : s); else { const int li = s - 8; c = b * 512 + (dir ? 511 - li : li); }
            if (s < 520) CIN[(size_t)(c * 2 + dir) * LW + ch] = Hc;
            Hc = v[e][0] * Hc + v[e][1]; }
    }
    __syncthreads();
}

#define XB_TMO      128
#define XB_XCNT(j)  (256  + 64 * (j))
#define XB_XSUB(j)  (1280 + 64 * (j))
#define XB_XGEN(j)  (2304 + 64 * (j))
#define XB_TOP      3328
#define XB_TOPGEN   3392
#define XCD_BAR_WORDS 3456
#define XB_SPIN_CAP (1u << 18)
__device__ __forceinline__ unsigned xb_ld(unsigned* p)              { return __hip_atomic_load(p, __ATOMIC_RELAXED, __HIP_MEMORY_SCOPE_AGENT); }
__device__ __forceinline__ unsigned xb_add(unsigned* p, unsigned v) { return __hip_atomic_fetch_add(p, v, __ATOMIC_RELAXED, __HIP_MEMORY_SCOPE_AGENT); }
__device__ __forceinline__ unsigned xb_xcc_id() { return (unsigned)__builtin_amdgcn_s_getreg((3 << 11) | 20) & 0xFu; }
#define XB_SPIN(cond, bar) do { unsigned _sp = 0; while (cond) { __builtin_amdgcn_s_sleep(1); \
    if ((++_sp & 255u) == 0u) { if (xb_ld(&(bar)[XB_TMO])) break; if (_sp > XB_SPIN_CAP) { atomicAdd(&(bar)[XB_TMO], 1u); break; } } } } while (0)
struct XcdBarrier { unsigned* bar; unsigned x; volatile LAS unsigned* st; };
__device__ __forceinline__ XcdBarrier xcd_barrier_post(unsigned* bar, volatile LAS unsigned* st) {
    XcdBarrier b; b.bar = bar; b.x = xb_xcc_id(); b.st = st;
    if (threadIdx.x == 0) (void)xb_add(&bar[XB_XCNT(b.x)], 1u);
    return b;
}
__device__ __forceinline__ void xcd_barrier_complete(unsigned* bar, unsigned x, unsigned& nloc, unsigned& nx) {
    const unsigned G = gridDim.x * gridDim.y * gridDim.z;
    unsigned sum, cnt, mine, sp = 0u;
    for (;;) {
        sum = 0u; cnt = 0u; mine = 0u;
#pragma unroll
        for (unsigned j = 0; j < 16; ++j) { const unsigned c = xb_ld(&bar[XB_XCNT(j)]); sum += c; cnt += (c > 0u) ? 1u : 0u; mine = (j == x) ? c : mine; }
        if (sum == G) break;
        __builtin_amdgcn_s_sleep(1);
        if ((++sp & 255u) == 0u) { if (xb_ld(&bar[XB_TMO])) break; if (sp > XB_SPIN_CAP) { atomicAdd(&bar[XB_TMO], 1u); break; } }
    }
    nloc = mine > 0u ? mine : 1u; nx = cnt > 0u ? cnt : 1u;
}
__device__ __forceinline__ void xcd_barrier(const XcdBarrier& b) {
    asm volatile("s_waitcnt vmcnt(0)" ::: "memory");
    __syncthreads();
    if (threadIdx.x == 0) {
        unsigned* bar = b.bar;
        __builtin_amdgcn_s_waitcnt(0);
        unsigned nloc = b.st[0], nx = b.st[1];
        if (nloc == 0u) { xcd_barrier_complete(bar, b.x, nloc, nx); b.st[0] = nloc; b.st[1] = nx; }
        const unsigned old = xb_add(&bar[XB_XSUB(b.x)], 1u);
        const unsigned gen = old / nloc;
        if (old + 1u == (gen + 1u) * nloc) {
            __builtin_amdgcn_fence(__ATOMIC_RELEASE, "agent");
            asm volatile("s_waitcnt vmcnt(0)" ::: "memory");
            const unsigned og = xb_add(&bar[XB_TOP], 1u);
            const unsigned tg = og / nx;
            if (og + 1u == (tg + 1u) * nx) xb_add(&bar[XB_TOPGEN], 1u);
            else XB_SPIN(xb_ld(&bar[XB_TOPGEN]) == tg, bar);
            __builtin_amdgcn_fence(__ATOMIC_ACQUIRE, "agent");
            xb_add(&bar[XB_XGEN(b.x)], 1u);
            asm volatile("s_waitcnt vmcnt(0)" ::: "memory");
        } else {
            XB_SPIN(xb_ld(&bar[XB_XGEN(b.x)]) == gen, bar);
            __builtin_amdgcn_fence(__ATOMIC_ACQUIRE, "agent");
            asm volatile("s_waitcnt vmcnt(0)" ::: "memory");
        }
    }
    __syncthreads();
}
#ifndef DBL_MASK
#define DBL_MASK 0
#endif
#ifndef EN_MASK
#define EN_MASK 0xffff
#endif
#define EN(t) ((EN_MASK >> (t)) & 1)
enum { PT_PREP = 0, PT_NORM = 1, PT_G1 = 2, PT_PLAIN = 3, PT_QK = 4, PT_ATT = 5, PT_IN = 6, PT_L2 = 7, PT_L3 = 8, PT_L4 = 9 };
__global__ void __launch_bounds__(512, 2) mega_fwd(Args a) {
    extern __shared__ __attribute__((aligned(16))) unsigned char lds_raw[];
    LAS unsigned char* lds = (LAS unsigned char*)lds_raw;
    cg::grid_group grid = cg::this_grid();
    volatile LAS unsigned* bst = (volatile LAS unsigned*)(lds + LDS_BYTES - 64);
    if (threadIdx.x < 2) bst[threadIdx.x] = 0u;
    __syncthreads();
    const XcdBarrier xbar = xcd_barrier_post((unsigned*)a.ws, bst);
    for (int ph = a.ph_lo; ph < a.ph_hi; ++ph) {
        int z; asm volatile("s_mov_b32 %0, 0" : "=s"(z));
        bf16* HB = (bf16*)((a.ws + z) + WS_HB); bf16* YB = (bf16*)((a.ws + z) + WS_YB); bf16* BIG = (bf16*)((a.ws + z) + WS_BIG);
        const unsigned pd = a.pdesc[ph + z];
        const int type = pd & 0xff, i = (pd >> 8) & 0xff, s = (pd >> 16) & 0xff, sub = (pd >> 24) & 0xff, j = i >> 1;
        for (int rep = ((DBL_MASK >> type) & 1) ? 0 : 1; rep < 2; ++rep) {
        const bool dry = rep == 0;
        if (rep == 1 && DBL_MASK) __syncthreads();
        if (type == PT_PREP && EN(PT_PREP)) prep_phase(a, z, lds);
        else if (type == PT_NORM && EN(PT_NORM)) {
            int res_l = (s > 0) ? i : i - 1, res_s = (s > 0) ? s - 1 : 2;
            const float res_w = (res_s == 1) ? 1.0f : 0.5f;
            norm_phase(a, z, res_l, res_s, res_w, i < 4 ? i : -1, s, dry);
        } else if (type == PT_G1 && EN(PT_G1)) {
            const bf16* W1t = (const bf16*)((a.ws + z) + WS_W) + (size_t)(i * 2 + (s >> 1)) * (W1T_BYTES / 2);
            EpiSwiGLU E{BIG}; run_gemm(lds, HB, W1t, (i == 3 && s == 2) ? ML : MT, 2 * FF, D, E);
        } else if (type == PT_PLAIN && EN(PT_PLAIN)) {
            const bf16* A = BIG; const bf16* Bt; int Mg = MT, Ng = D, K; bf16* O = YB; int ldc = D;
            if (sub == 0) { Bt = (const bf16*)((a.ws + z) + WS_W + 88 * MiB) + (size_t)(i * 2 + (s >> 1)) * (W2T_BYTES / 2); K = FF; }
            else if (sub == 1) { Bt = (const bf16*)((a.ws + z) + WS_W + 132 * MiB) + (size_t)j * (4 * MiB) + 3 * MiB; K = D; }
            else if (sub == 2) { Bt = (const bf16*)((a.ws + z) + WS_W + 148 * MiB) + (size_t)j * (9 * MiB / 2) + LRU_WOL / 2; K = LW; }
            else { A = (const bf16*)((a.ws + z) + WS_W + 132 * MiB) + (size_t)j * (4 * MiB) + 2 * MiB; Bt = HB; Mg = D; Ng = MT; K = D; O = BIG + 2 * ACT_ELEMS; ldc = MT; }
            if (i == 3 && s >= 1 && sub != 3) Mg = ML;
            pg8::EpiBf16<0> E{O, ldc, nullptr, 0, 0}; run_gemm(lds, A, Bt, Mg, Ng, K, E);
        } else if (type == PT_QK && EN(PT_QK)) {
            const bf16* Wn = (const bf16*)((a.ws + z) + WS_W + 132 * MiB) + (size_t)j * (4 * MiB);
            EpiRope E{BIG, BIG + ACT_ELEMS, (const float*)((a.ws + z) + WS_ROPE), (const float*)((a.ws + z) + WS_ROPE) + SEQ * 32};
            run_gemm(lds, HB, Wn, MT, 2048, D, E);
        } else if (type == PT_ATT && EN(PT_ATT)) attn_phase(a, z, j, lds, dry);
        else if (type == PT_IN && EN(PT_IN)) {
            const bf16* Wl = (const bf16*)((a.ws + z) + WS_W + 148 * MiB) + (size_t)j * (9 * MiB / 2);
            EpiGeluSplit E{BIG, BIG + (size_t)MT * LW}; run_gemm(lds, HB, Wl, MT, 2 * LW, D, E);
        } else if (type == PT_L2 && EN(PT_L2)) lru_scan_phase(a, z, j, lds);
        else if (type == PT_L3 && EN(PT_L3)) lru_carry_phase(a, z, lds);
        else if (type == PT_L4 && EN(PT_L4)) lru_apply_phase(a, z, dry);
        }
        if (ph + 1 < a.ph_hi) { if (ph == a.ph_lo) grid.sync(); else xcd_barrier(xbar); }
    }
}
constexpr int N_PHASES = 48;

#ifndef MK_MULTI
#define MK_MULTI 0
#endif
extern "C" void kernel_launch(void* const* d_in, const int* in_sizes, int n_in, void* d_out, int out_size, void* d_ws, size_t ws_size, hipStream_t stream) {
    static int grid = 0;
    if (grid == 0) {
        int dev = 0, cus = 0, per_cu = 0;
        hipGetDevice(&dev);
        hipDeviceGetAttribute(&cus, hipDeviceAttributeMultiprocessorCount, dev);
        if (hipFuncSetAttribute((const void*)mega_fwd, hipFuncAttributeMaxDynamicSharedMemorySize, LDS_BYTES) != hipSuccess) { fprintf(stderr, "hipFuncSetAttribute failed\n"); grid = -1; return; }
        if (hipOccupancyMaxActiveBlocksPerMultiprocessor(&per_cu, (const void*)mega_fwd, 512, LDS_BYTES) != hipSuccess || per_cu < 1) { fprintf(stderr, "occupancy query: %d\n", per_cu); per_cu = 1; }
        (void)hipGetLastError();
        grid = cus * per_cu;
        if (ws_size < WS_END || n_in != 23) { fprintf(stderr, "kernel_launch: ws %zu n_in %d\n", ws_size, n_in); grid = -1; return; }
    }
    if (grid < 0) return;
    Args a{};
    for (int i = 0; i < 23; ++i) a.in[i] = (const float*)d_in[i];
    a.out = (float*)d_out; a.ws = (unsigned char*)d_ws;
    int nj = 0, tiles = 0;
    auto add = [&](int in_idx, long long src_off, size_t dst_off, int K, int N, int ldn, int ldk, int map, int ncol0) {
        TJob& t = a.jobs[nj++]; t.src_off = src_off; t.dst_off = (long long)dst_off; t.in_idx = in_idx; t.map = map; t.ldn = ldn; t.ldk = ldk; t.nnt = N / 128; t.tile0 = tiles; t.ncol0 = ncol0; t.pad = 0;
        tiles += (K / 64) * (N / 128);
    };
    for (int i = 0; i < 4; ++i) for (int f = 0; f < 2; ++f) {
        add(8, (long long)(i * 2 + f) * D * FF, off_w1t(i, f), D, FF, FF, D, 1, 0);
        add(9, (long long)(i * 2 + f) * D * FF, off_w1t(i, f), D, FF, FF, D, 2, 0);
        add(10, (long long)(i * 2 + f) * FF * D, off_w2t(i, f), FF, D, D, FF, 0, 0);
    }
    for (int j = 0; j < 2; ++j) {
        add(11, (long long)j * D * 3 * D, off_na(j), D, 2 * D, 3 * D, D, 3, 0);
        add(11, (long long)j * D * 3 * D, off_na(j) + 4 * MiB, D, D, 3 * D, D, 0, 2 * D);
        add(12, (long long)j * D * D, off_na(j) + 6 * MiB, D, D, D, D, 0, 0);
        add(14, (long long)j * D * 2 * LW, off_lru(j), D, 2 * LW, 2 * LW, D, 0, 0);
        add(22, (long long)j * LW * D, off_lru(j) + LRU_WOL, LW, D, D, LW, 0, 0);
        for (int d = 0; d < 2; ++d) {
            add(17, (long long)(j * 2 + d) * 10 * 128 * 128, off_lru(j) + LRU_WG + (size_t)(d * 2 + 0) * 10 * 128 * 128 * 2, LW, 128, 128, 128, 4, 0);
            add(19, (long long)(j * 2 + d) * 10 * 128 * 128, off_lru(j) + LRU_WG + (size_t)(d * 2 + 1) * 10 * 128 * 128 * 2, LW, 128, 128, 128, 4, 0);
        }
    }
    a.njobs = nj; a.ntiles = tiles;
    {
        int np = 0;
        auto P = [&](int type, int i, int s, int sub) { a.pdesc[np++] = (unsigned)type | ((unsigned)i << 8) | ((unsigned)s << 16) | ((unsigned)sub << 24); };
        P(PT_PREP, 0, 0, 0);
        for (int i = 0; i < 4; ++i) for (int s = 0; s < 3; ++s) {
            P(PT_NORM, i, s, 0);
            if (s != 1) { P(PT_G1, i, s, 0); P(PT_PLAIN, i, s, 0); }
            else if ((i & 1) == 0) { P(PT_QK, i, s, 0); P(PT_PLAIN, i, s, 3); P(PT_ATT, i, s, 0); P(PT_PLAIN, i, s, 1); }
            else { P(PT_IN, i, s, 0); P(PT_L2, i, s, 0); P(PT_L3, i, s, 0); P(PT_L4, i, s, 0); P(PT_PLAIN, i, s, 2); }
        }
        P(PT_NORM, 4, 0, 0);
        if (np != N_PHASES) { fprintf(stderr, "phase count %d\n", np); return; }
    }
#if MK_MULTI
    for (int p = 0; p < N_PHASES; ++p) { a.ph_lo = p; a.ph_hi = p + 1; hipLaunchKernelGGL(mega_fwd, dim3(grid), dim3(512), LDS_BYTES, stream, a); }
#else
    a.ph_lo = 0; a.ph_hi = N_PHASES;
    if (hipMemsetAsync(d_ws, 0, 16384, stream) != hipSuccess) { fprintf(stderr, "memset failed\n"); return; }
    void* kargs[] = {&a};
    hipError_t e = hipLaunchCooperativeKernel((const void*)mega_fwd, dim3(grid), dim3(512), kargs, LDS_BYTES, stream);
    if (e != hipSuccess) fprintf(stderr, "cooperative launch failed: %s (grid %d)\n", hipGetErrorString(e), grid);
#endif
}
```

```cpp
#include <hip/hip_runtime.h>
namespace pg8 {
#define PG8_LAS __attribute__((address_space(3)))
typedef unsigned short bf16_t;
typedef short bf16x8 __attribute__((ext_vector_type(8)));
typedef float f32x4 __attribute__((ext_vector_type(4)));
typedef unsigned u32x4 __attribute__((ext_vector_type(4)));
constexpr int BM = 256, BK = 64, HALF = 128, HTB = HALF * BK * 2  , STAGE_BYTES = 8 * HTB, NXCD = 8, WGM = 8;

__host__ __device__ __forceinline__ int lds_byte(int r, int c) { const int st = (r >> 4) * 2 + (c >> 5), rr = r & 15, cc = c & 31, ob = rr * 64 + cc * 2; return st * 1024 + (ob ^ (((ob >> 9) & 1) << 5)); }
__host__ __device__ __forceinline__ void stage_rc(int b, int& R, int& C) { const int st = b / 1024, sb = b % 1024, swz = sb ^ (((sb >> 9) & 1) << 5); R = (st >> 1) * 16 + swz / 64; C = (st & 1) * 32 + (swz % 64) / 2; }
__host__ __device__ __forceinline__ int perm32(int rho) { const int n = rho >> 4, i = rho & 15; return 8 * (i >> 2) + 4 * n + (i & 3); }

struct Unit { int pm, pn; };
struct Gemm { const bf16_t* A; const bf16_t* Bt; int M, N, K; };

struct StaticOrder {
    int nM, nN, nwg, G, c;
    __host__ __device__ void init(int M, int N, int G_, int c_) { nM = M / BM; nN = N / BM; nwg = nM * nN; G = G_; c = c_; }
    __host__ __device__ bool next(int i, Unit& u) const {
        const long L = (long)i * G + c; if (L >= nwg) return false;
        int wgid = (int)L; { const int q = nwg / NXCD, r = nwg % NXCD, xcd = wgid % NXCD, off = wgid / NXCD; wgid = (xcd < r ? xcd * (q + 1) : r * (q + 1) + (xcd - r) * q) + off; }
        const int nig = WGM * nN, gid = wgid / nig, fm = gid * WGM, gsz = (nM - fm) < WGM ? (nM - fm) : WGM;
        u.pm = fm + ((wgid % nig) % gsz); u.pn = (wgid % nig) / gsz; return true;
    }
    __device__ __forceinline__ void a_ready(const Unit&) const {}
    __device__ __forceinline__ void done(const Unit&) const {}
};
struct CountedOrder : StaticOrder {
    const unsigned* ready; unsigned need; unsigned* tmo;
    __device__ __forceinline__ void a_ready(const Unit& u) const {
        if (threadIdx.x < 64) {
            const unsigned long long t0 = __builtin_amdgcn_s_memrealtime(); unsigned polls = 0;
            while ((unsigned)__builtin_amdgcn_readfirstlane(__hip_atomic_load(ready + 64 * u.pm, __ATOMIC_RELAXED, __HIP_MEMORY_SCOPE_AGENT)) < need) {
                if ((++polls & 255u) == 0u && __builtin_amdgcn_readfirstlane(__hip_atomic_load(tmo, __ATOMIC_RELAXED, __HIP_MEMORY_SCOPE_AGENT)) != 0u) break;
                if (__builtin_amdgcn_s_memrealtime() - t0 > 2000000ull) {
                    if (threadIdx.x == 0) { unsigned expect = 0u; __hip_atomic_compare_exchange_strong(tmo + 1, &expect, 0x600u | (unsigned)(u.pm & 0xff), __ATOMIC_RELAXED, __ATOMIC_RELAXED, __HIP_MEMORY_SCOPE_AGENT); __hip_atomic_store(tmo, 1u, __ATOMIC_RELAXED, __HIP_MEMORY_SCOPE_AGENT); }
                    break; }
                __builtin_amdgcn_s_sleep(2); }
            __builtin_amdgcn_fence(__ATOMIC_ACQUIRE, "agent");
            asm volatile("s_waitcnt vmcnt(0)" ::: "memory");
        }
#if !defined(BROKEN_HOOK_NO_BARRIER)
        asm volatile("" ::: "memory"); __builtin_amdgcn_s_barrier(); asm volatile("" ::: "memory");
#endif
    }
};

__device__ __forceinline__ unsigned cvt_pk_bf16(float lo, float hi) { unsigned r; asm volatile("v_cvt_pk_bf16_f32 %0, %1, %2" : "=v"(r) : "v"(lo), "v"(hi)); return r; }
typedef float f32x2 __attribute__((ext_vector_type(2)));
__device__ __forceinline__ f32x2 gelu_pk(f32x2 v) {
    const f32x2 av = __builtin_elementwise_abs(v), d = av * 0.2316418882f + 1.0f;
    f32x2 t; t.x = __builtin_amdgcn_rcpf(d.x); t.y = __builtin_amdgcn_rcpf(d.y);
    f32x2 q = t * 0.5307027145f + (-0.7265760135f); q = q * t + 0.7107068705f; q = q * t + (-0.142248368f); q = q * t + 0.127414796f; q = q * t;
    const f32x2 s = (v * v) * (-0.72134752044f);
    f32x2 e; e.x = __builtin_amdgcn_exp2f(s.x); e.y = __builtin_amdgcn_exp2f(s.y);
    const f32x2 m = v * (q * e), r = v - m;
    f32x2 o; o.x = v.x < 0.f ? m.x : r.x; o.y = v.y < 0.f ? m.y : r.y; return o;
}

struct EpiF32 {
    static constexpr bool PERM = false, AFTER_DRAIN = false;
    float* C; int ldc; const float* bias;
    __device__ __forceinline__ void operator()(const f32x4 (&acc)[2][2][4][2], const Unit& u, int wr, int wc, int fr, int fq) const {
        const int row0 = u.pm * BM + wr * 64 + fr, col0 = u.pn * BM + wc * 32 + 4 * fq;
        f32x4 bv[2][2];
#pragma unroll
        for (int bj = 0; bj < 2; ++bj)
#pragma unroll
            for (int n = 0; n < 2; ++n) bv[bj][n] = bias ? *(const f32x4*)(bias + col0 + bj * HALF + n * 16) : (f32x4){0.f, 0.f, 0.f, 0.f};
#pragma unroll
        for (int ai = 0; ai < 2; ++ai)
#pragma unroll
            for (int m = 0; m < 4; ++m) { float* rowp = C + (size_t)(row0 + ai * HALF + m * 16) * ldc + col0;
#pragma unroll
                for (int bj = 0; bj < 2; ++bj)
#pragma unroll
                    for (int n = 0; n < 2; ++n) *(f32x4*)(rowp + bj * HALF + n * 16) = acc[ai][bj][m][n] + bv[bj][n]; }
    }
};
template <int ACT  > struct EpiBf16 {
    static constexpr bool PERM = true, AFTER_DRAIN = false;
    bf16_t* O; int ldc; const float* bias; int split_cols; size_t split_stride;
    __device__ __forceinline__ void operator()(const f32x4 (&acc)[2][2][4][2], const Unit& u, int wr, int wc, int fr, int fq) const {
        const int row0 = u.pm * BM + wr * 64 + fr; int colt = u.pn * BM; bf16_t* base = O;
        if (split_cols) { const int t = colt / split_cols; base += (size_t)t * split_stride; colt -= t * split_cols; }
        const int col0 = colt + wc * 32 + 8 * fq, bcol0 = u.pn * BM + wc * 32 + 8 * fq;
        f32x4 bv[2][2];
#pragma unroll
        for (int bj = 0; bj < 2; ++bj)
#pragma unroll
            for (int n = 0; n < 2; ++n) bv[bj][n] = bias ? *(const f32x4*)(bias + bcol0 + bj * HALF + 4 * n) : (f32x4){0.f, 0.f, 0.f, 0.f};
#pragma unroll
        for (int ai = 0; ai < 2; ++ai)
#pragma unroll
            for (int m = 0; m < 4; ++m) { bf16_t* rowp = base + (size_t)(row0 + ai * HALF + m * 16) * ldc + col0;
#pragma unroll
                for (int bj = 0; bj < 2; ++bj) { f32x4 v0 = acc[ai][bj][m][0] + bv[bj][0], v1 = acc[ai][bj][m][1] + bv[bj][1];
                    if (ACT == 1) { f32x2 a = gelu_pk((f32x2){v0[0], v0[1]}), b = gelu_pk((f32x2){v0[2], v0[3]}), c = gelu_pk((f32x2){v1[0], v1[1]}), d = gelu_pk((f32x2){v1[2], v1[3]});
                        v0 = (f32x4){a.x, a.y, b.x, b.y}; v1 = (f32x4){c.x, c.y, d.x, d.y}; }
                    if (ACT == 2) {
#pragma unroll
                        for (int j = 0; j < 4; ++j) { v0[j] = 0.5f * v0[j] * (1.0f + erff(v0[j] * 0.70710678f)); v1[j] = 0.5f * v1[j] * (1.0f + erff(v1[j] * 0.70710678f)); } }
                    u32x4 w; w.x = cvt_pk_bf16(v0[0], v0[1]); w.y = cvt_pk_bf16(v0[2], v0[3]); w.z = cvt_pk_bf16(v1[0], v1[1]); w.w = cvt_pk_bf16(v1[2], v1[3]);
                    *(u32x4*)(rowp + bj * HALF) = w; } }
    }
};

struct PanelStats {
    unsigned* xbuf;
    unsigned* cnt;
    unsigned* tmo;
    int ntn; float eps;
    unsigned code;
    __device__ __forceinline__ bool run(const f32x4 (&v)[2][2][4][2], const Unit& u, int wr, int wc, int fr, int fq, PG8_LAS unsigned char* lds, int wid, int lane) const {
        typedef float f32x2v __attribute__((ext_vector_type(2)));
        PG8_LAS f32x2v* P = (PG8_LAS f32x2v*)lds;
        PG8_LAS f32x2v* S = (PG8_LAS f32x2v*)(lds + 8192);
        PG8_LAS unsigned* flag = (PG8_LAS unsigned*)(lds + 8192 + 2048);
#pragma unroll
        for (int ai = 0; ai < 2; ++ai)
#pragma unroll
            for (int m = 0; m < 4; ++m) {
                float s = 0.f;
#pragma unroll
                for (int bj = 0; bj < 2; ++bj)
#pragma unroll
                    for (int n = 0; n < 2; ++n) { const f32x4 x = v[ai][bj][m][n]; s += (x[0] + x[1]) + (x[2] + x[3]); }
                s += __shfl_xor(s, 16); s += __shfl_xor(s, 32);
                const float mw = s * (1.0f / 64.0f); float q = 0.f;
#pragma unroll
                for (int bj = 0; bj < 2; ++bj)
#pragma unroll
                    for (int n = 0; n < 2; ++n) { const f32x4 d = v[ai][bj][m][n] - mw; q += (d[0] * d[0] + d[1] * d[1]) + (d[2] * d[2] + d[3] * d[3]); }
                q += __shfl_xor(q, 16); q += __shfl_xor(q, 32);
                if (fq == 0) P[(ai * HALF + wr * 64 + m * 16 + fr) * 4 + wc] = (f32x2v){mw, q};
            }
        asm volatile("s_waitcnt lgkmcnt(0)" ::: "memory"); __builtin_amdgcn_s_barrier(); asm volatile("" ::: "memory");
#if defined(BROKEN_NO_WAIT)
        if (blockIdx.x >= 64) { const long long t0 = clock64(); while (clock64() - t0 < 60000) __builtin_amdgcn_s_sleep(8); }
#endif
        const int row = wid * 32 + (lane & 31);
        if (lane < 32) {
            const f32x2v a = P[row * 4 + 0], b = P[row * 4 + 1], c = P[row * 4 + 2], d = P[row * 4 + 3];
            const float mt = (a.x + b.x + c.x + d.x) * 0.25f;
            const float da = a.x - mt, db = b.x - mt, dc = c.x - mt, dd = d.x - mt;
            const float m2 = (a.y + b.y) + (c.y + d.y) + 64.0f * ((da * da + db * db) + (dc * dc + dd * dd));
            unsigned long long* slot = (unsigned long long*)xbuf + ((size_t)(u.pm * BM + row) * 4 + u.pn);
            __hip_atomic_store(slot, ((unsigned long long)__float_as_uint(m2) << 32) | __float_as_uint(mt), __ATOMIC_RELAXED, __HIP_MEMORY_SCOPE_AGENT);
        }
        asm volatile("s_waitcnt vmcnt(0)" ::: "memory");
        if (lane == 0) __hip_atomic_fetch_add(cnt + 64 * u.pm, 1u, __ATOMIC_RELAXED, __HIP_MEMORY_SCOPE_AGENT);
        if (wid == 0) {
            bool dead = false; const unsigned long long t0 = __builtin_amdgcn_s_memrealtime(); const unsigned want = 8u * (unsigned)ntn;
            for (;;) {
#if defined(BROKEN_NO_WAIT)
                break;
#endif
                if ((unsigned)__builtin_amdgcn_readfirstlane(__hip_atomic_load(cnt + 64 * u.pm, __ATOMIC_RELAXED, __HIP_MEMORY_SCOPE_AGENT)) >= want) break;
                if (__builtin_amdgcn_s_memrealtime() - t0 > 2000000ull) {
                    if (lane == 0) { unsigned expect = 0u; __hip_atomic_compare_exchange_strong(tmo + 1, &expect, code | (unsigned)(u.pm & 0xff), __ATOMIC_RELAXED, __ATOMIC_RELAXED, __HIP_MEMORY_SCOPE_AGENT);
                                     __hip_atomic_store(tmo, 1u, __ATOMIC_RELAXED, __HIP_MEMORY_SCOPE_AGENT); }
                    dead = true; break; }
                __builtin_amdgcn_s_sleep(2);
            }
            __builtin_amdgcn_fence(__ATOMIC_ACQUIRE, "agent");
            if (lane == 0) flag[0] = dead ? 1u : 0u;
        }
        asm volatile("s_waitcnt vmcnt(0) lgkmcnt(0)" ::: "memory"); __builtin_amdgcn_s_barrier(); asm volatile("" ::: "memory");
        const bool bad = flag[0] != 0u;
        if (lane < 32) {
            const unsigned long long* slot = (const unsigned long long*)xbuf + (size_t)(u.pm * BM + row) * 4; float mt[4], m2[4]; float ms = 0.f;
#pragma unroll
            for (int t = 0; t < 4; ++t) { if (t < ntn) { const unsigned long long w = __hip_atomic_load(slot + t, __ATOMIC_RELAXED, __HIP_MEMORY_SCOPE_AGENT); mt[t] = __uint_as_float((unsigned)w); m2[t] = __uint_as_float((unsigned)(w >> 32)); } else { mt[t] = 0.f; m2[t] = 0.f; } ms += mt[t]; }
            const float mean = ms / (float)ntn; float q = 0.f;
#pragma unroll
            for (int t = 0; t < 4; ++t) if (t < ntn) { const float dm = mt[t] - mean; q += m2[t] + 256.0f * dm * dm; }
            S[row] = (f32x2v){mean, 1.0f / sqrtf(q / (256.0f * (float)ntn) + eps)};
        }
        asm volatile("s_waitcnt lgkmcnt(0)" ::: "memory"); __builtin_amdgcn_s_barrier(); asm volatile("" ::: "memory");
        return bad;
    }
};
struct EpiLnRes {
    static constexpr bool PERM = false, AFTER_DRAIN = true;
    const float* base; float* out; int ldc; const float* bias; PanelStats st; unsigned poison;
    __device__ __forceinline__ void refuse(size_t i0, size_t stride, int M, int N) const { const float q = __builtin_nanf(""); for (size_t i = i0; i < (size_t)M * N; i += stride) out[(i / N) * ldc + i % N] = q;
        if (i0 == 0) { unsigned expect = 0u; __hip_atomic_compare_exchange_strong(st.tmo + 1, &expect, 0x7f0u, __ATOMIC_RELAXED, __ATOMIC_RELAXED, __HIP_MEMORY_SCOPE_AGENT); __hip_atomic_store(st.tmo, 1u, __ATOMIC_RELAXED, __HIP_MEMORY_SCOPE_AGENT); } }
    __device__ __forceinline__ void fused(f32x4 (&acc)[2][2][4][2], const Unit& u, int wr, int wc, int fr, int fq, PG8_LAS unsigned char* lds, int wid, int lane) const {
        typedef float f32x2v __attribute__((ext_vector_type(2)));
        const PG8_LAS f32x2v* S = (const PG8_LAS f32x2v*)(lds + 8192);
        const int col0 = u.pn * BM + wc * 32 + 4 * fq;
#pragma unroll
        for (int bj = 0; bj < 2; ++bj)
#pragma unroll
            for (int n = 0; n < 2; ++n) { const f32x4 bv = bias ? *(const f32x4*)(bias + col0 + bj * HALF + n * 16) : (f32x4){0.f, 0.f, 0.f, 0.f};
#pragma unroll
                for (int ai = 0; ai < 2; ++ai)
#pragma unroll
                    for (int m = 0; m < 4; ++m) acc[ai][bj][m][n] += bv; }
        const bool bad = st.run(acc, u, wr, wc, fr, fq, lds, wid, lane) || poison != 0u;
        const float qnan = __builtin_nanf("");
#pragma unroll
        for (int ai = 0; ai < 2; ++ai)
#pragma unroll
            for (int m = 0; m < 4; ++m) { const int r = ai * HALF + wr * 64 + m * 16 + fr; const f32x2v sr = S[r]; const size_t off = (size_t)(u.pm * BM + r) * ldc + col0;
#pragma unroll
                for (int bj = 0; bj < 2; ++bj)
#pragma unroll
                    for (int n = 0; n < 2; ++n) { const f32x4 bs = *(const f32x4*)(base + off + bj * HALF + n * 16); f32x4 o = bs + (acc[ai][bj][m][n] - sr.x) * sr.y;
                        if (bad) o = (f32x4){qnan, qnan, qnan, qnan}; *(f32x4*)(out + off + bj * HALF + n * 16) = o; }
                asm volatile("" ::: "memory"); }
    }
};
struct EpiLnResLn {
    static constexpr bool PERM = false, AFTER_DRAIN = true;
    const float* base; float* out; bf16_t* xn; int ldc; const float* bias; PanelStats st1, st2; unsigned poison;
    __device__ __forceinline__ void refuse(size_t i0, size_t stride, int M, int N) const { const float q = __builtin_nanf(""); for (size_t i = i0; i < (size_t)M * N; i += stride) { const size_t o = (i / N) * ldc + i % N; out[o] = q; xn[o] = (bf16_t)0x7fc0u; }
        if (i0 == 0) { unsigned expect = 0u; __hip_atomic_compare_exchange_strong(st1.tmo + 1, &expect, 0x7f0u, __ATOMIC_RELAXED, __ATOMIC_RELAXED, __HIP_MEMORY_SCOPE_AGENT); __hip_atomic_store(st1.tmo, 1u, __ATOMIC_RELAXED, __HIP_MEMORY_SCOPE_AGENT); } }
    __device__ __forceinline__ void fused(f32x4 (&acc)[2][2][4][2], const Unit& u, int wr, int wc, int fr, int fq, PG8_LAS unsigned char* lds, int wid, int lane) const {
        typedef float f32x2v __attribute__((ext_vector_type(2))); typedef unsigned u32x2v __attribute__((ext_vector_type(2)));
        const PG8_LAS f32x2v* S = (const PG8_LAS f32x2v*)(lds + 8192);
        const int col0 = u.pn * BM + wc * 32 + 4 * fq;
#pragma unroll
        for (int bj = 0; bj < 2; ++bj)
#pragma unroll
            for (int n = 0; n < 2; ++n) { const f32x4 bv = bias ? *(const f32x4*)(bias + col0 + bj * HALF + n * 16) : (f32x4){0.f, 0.f, 0.f, 0.f};
#pragma unroll
                for (int ai = 0; ai < 2; ++ai)
#pragma unroll
                    for (int m = 0; m < 4; ++m) acc[ai][bj][m][n] += bv; }
        bool bad = st1.run(acc, u, wr, wc, fr, fq, lds, wid, lane) || poison != 0u;
        const float qnan = __builtin_nanf("");
#pragma unroll
        for (int ai = 0; ai < 2; ++ai)
#pragma unroll
            for (int m = 0; m < 4; ++m) { const int r = ai * HALF + wr * 64 + m * 16 + fr; const f32x2v sr = S[r]; const size_t off = (size_t)(u.pm * BM + r) * ldc + col0;
#pragma unroll
                for (int bj = 0; bj < 2; ++bj)
#pragma unroll
                    for (int n = 0; n < 2; ++n) { const f32x4 bs = *(const f32x4*)(base + off + bj * HALF + n * 16); acc[ai][bj][m][n] = bs + (acc[ai][bj][m][n] - sr.x) * sr.y; }
                asm volatile("" : "+v"(acc[ai][0][m][0]), "+v"(acc[ai][0][m][1]), "+v"(acc[ai][1][m][0]), "+v"(acc[ai][1][m][1]));
                if (m & 1) asm volatile("" ::: "memory"); }
        const bool bad1 = bad;
        bad = st2.run(acc, u, wr, wc, fr, fq, lds, wid, lane) || bad;
#pragma unroll
        for (int ai = 0; ai < 2; ++ai)
#pragma unroll
            for (int m = 0; m < 4; ++m) { const int r = ai * HALF + wr * 64 + m * 16 + fr; const f32x2v sr = S[r]; const size_t off = (size_t)(u.pm * BM + r) * ldc + col0;
#pragma unroll
                for (int bj = 0; bj < 2; ++bj)
#pragma unroll
                    for (int n = 0; n < 2; ++n) { const f32x4 x1 = acc[ai][bj][m][n]; *(f32x4*)(out + off + bj * HALF + n * 16) = bad1 ? (f32x4){qnan, qnan, qnan, qnan} : x1;
                        const f32x4 o = (x1 - sr.x) * sr.y; u32x2v w; w.x = cvt_pk_bf16(o[0], o[1]); w.y = cvt_pk_bf16(o[2], o[3]);
                        if (bad) { w.x = 0x7fc07fc0u; w.y = 0x7fc07fc0u; } *(u32x2v*)(xn + off + bj * HALF + n * 16) = w; }
                asm volatile("" ::: "memory"); }
    }
};

template <class Epi, class Sched, bool ALIGN_EPI = false, bool SP2 = false>
__device__ __forceinline__ void gemm_phase(PG8_LAS unsigned char* lds, const Gemm g, const Sched& S, const Epi& E) {
    int tid_l = threadIdx.x; asm volatile("" : "+v"(tid_l));
    const int tid = tid_l, wid = __builtin_amdgcn_readfirstlane(tid >> 6), lane = tid & 63, wr = wid >> 2, wc = wid & 3, fr = lane & 15, fq = lane >> 4;
    const int K = g.K, nt = K / BK;
    unsigned voffA[2], voffB[2];
#pragma unroll
    for (int i = 0; i < 2; ++i) { int R, C; stage_rc(tid * 16 + i * 8192, R, C); const int Rb = Epi::PERM ? ((R & ~31) + perm32(R & 31)) : R;
        voffA[i] = (unsigned)(R * K + C) * 2u; voffB[i] = (unsigned)(Rb * K + C) * 2u; }
    const size_t kstep = (size_t)(BK * 2);
    const size_t hstep = (size_t)HALF * K * 2;
    const size_t tstep = 2 * hstep;
    const unsigned ldsw = (unsigned)wid * 1024u;
    const int aoff = lds_byte(wr * 64 + fr, fq * 8), boff = lds_byte(wc * 32 + fr, fq * 8);
#define PG8_SA(b, h) (((b) * 2 + (h)) * HTB)
#define PG8_SB(b, h) ((4 + (b) * 2 + (h)) * HTB)
#define PG8_STAGE(bufoff, gbase, voff) do { _Pragma("unroll") for (int _i = 0; _i < 2; ++_i) \
        __builtin_amdgcn_global_load_lds((const unsigned*)((const char*)(gbase) + (voff)[_i]), (PG8_LAS unsigned*)(lds + (bufoff) + ldsw + _i * 8192), 16, 0, 0); } while (0)
#define PG8_LDA(dst, b, h) do { _Pragma("unroll") for (int m = 0; m < 4; ++m) _Pragma("unroll") for (int k = 0; k < 2; ++k) dst[m][k] = *(const PG8_LAS bf16x8*)(lds + PG8_SA(b, h) + aoff + m * 2048 + k * 1024); } while (0)
#define PG8_LDB(dst, b, h) do { _Pragma("unroll") for (int n = 0; n < 2; ++n) _Pragma("unroll") for (int k = 0; k < 2; ++k) dst[n][k] = *(const PG8_LAS bf16x8*)(lds + PG8_SB(b, h) + boff + n * 2048 + k * 1024); } while (0)
#define PG8_MMA(ai, bj, At, Bt) do { __builtin_amdgcn_s_setprio(1); _Pragma("unroll") for (int m = 0; m < 4; ++m) _Pragma("unroll") for (int n = 0; n < 2; ++n) _Pragma("unroll") for (int k = 0; k < 2; ++k) \
        acc[ai][bj][m][n] = __builtin_amdgcn_mfma_f32_16x16x32_bf16(Bt[n][k], At[m][k], acc[ai][bj][m][n], 0, 0, 0); __builtin_amdgcn_s_setprio(0); } while (0)
#define PG8_WAIT_V(n) asm volatile("s_waitcnt vmcnt(" #n ")" ::: "memory")
#define PG8_WAIT_L(n) asm volatile("s_waitcnt lgkmcnt(" #n ")" ::: "memory")
#define PG8_BAR __builtin_amdgcn_s_barrier()
#define PG8_SCHED __builtin_amdgcn_sched_barrier(0)
    Unit cur, nxt; int ui = 0;
    if (!S.next(0, cur)) return;
    f32x4 acc[2][2][4][2];
#pragma unroll
    for (int a = 0; a < 2; ++a)
#pragma unroll
        for (int b = 0; b < 2; ++b)
#pragma unroll
            for (int m = 0; m < 4; ++m)
#pragma unroll
                for (int n = 0; n < 2; ++n) acc[a][b][m][n] = (f32x4){0.f, 0.f, 0.f, 0.f};
    bf16x8 At[4][2], B0[2][2], B1[2][2];
    const char* cA = (const char*)g.A + (size_t)cur.pm * tstep; const char* cB = (const char*)g.Bt + (size_t)cur.pn * tstep;
    S.a_ready(cur);
    if constexpr (SP2) {
        PG8_STAGE(PG8_SB(0, 0), cB, voffB); PG8_STAGE(PG8_SB(0, 1), cB + hstep, voffB); PG8_STAGE(PG8_SA(0, 0), cA, voffA); PG8_STAGE(PG8_SA(0, 1), cA + hstep, voffA);
        if (wr == 1) PG8_BAR;
        PG8_WAIT_V(2); PG8_BAR;
        PG8_STAGE(PG8_SB(1, 0), cB + kstep, voffB); PG8_STAGE(PG8_SA(1, 0), cA + kstep, voffA); PG8_STAGE(PG8_SB(1, 1), cB + hstep + kstep, voffB);
        PG8_WAIT_V(6); PG8_BAR;
    } else {
        PG8_STAGE(PG8_SB(0, 0), cB, voffB); PG8_STAGE(PG8_SA(0, 0), cA, voffA); PG8_STAGE(PG8_SB(0, 1), cB + hstep, voffB); PG8_STAGE(PG8_SA(0, 1), cA + hstep, voffA);
        if (wr == 1) PG8_BAR;
        PG8_WAIT_V(4); PG8_BAR;
        PG8_STAGE(PG8_SB(1, 0), cB + kstep, voffB); PG8_STAGE(PG8_SA(1, 0), cA + kstep, voffA); PG8_STAGE(PG8_SB(1, 1), cB + hstep + kstep, voffB);
        PG8_WAIT_V(6); PG8_BAR;
    }
    for (;;) {
        const bool has_next = S.next(ui + 1, nxt);
        const char* nA = has_next ? (const char*)g.A + (size_t)nxt.pm * tstep : cA; const char* nB = has_next ? (const char*)g.Bt + (size_t)nxt.pn * tstep : cB;
        for (int t = 0; t < nt; t += 2) {
            const bool last = (t == nt - 2);
            const char* a1 = cA + (size_t)(t + 1) * kstep;
            const char* a2 = last ? nA : cA + (size_t)(t + 2) * kstep; const char* b2 = last ? nB : cB + (size_t)(t + 2) * kstep;
            const char* a3 = a2 + kstep; const char* b3 = b2 + kstep;
            if (last && has_next) S.a_ready(nxt);
            if constexpr (SP2) {
            PG8_LDB(B0, 0, 0); PG8_LDB(B1, 0, 1); PG8_SCHED; PG8_LDA(At, 0, 0); PG8_STAGE(PG8_SA(1, 1), a1 + hstep, voffA);
            PG8_WAIT_V(8); PG8_WAIT_L(0); PG8_BAR; PG8_MMA(0, 0, At, B0); PG8_MMA(0, 1, At, B1); PG8_BAR; PG8_SCHED;
            PG8_LDA(At, 0, 1); PG8_STAGE(PG8_SB(0, 0), b2, voffB); PG8_STAGE(PG8_SB(0, 1), b2 + hstep, voffB); PG8_STAGE(PG8_SA(0, 0), a2, voffA);
            PG8_WAIT_V(8); PG8_WAIT_L(0); PG8_BAR; PG8_MMA(1, 0, At, B0); PG8_MMA(1, 1, At, B1); PG8_BAR; PG8_SCHED;
            PG8_LDB(B0, 1, 0); PG8_LDB(B1, 1, 1); PG8_SCHED; PG8_LDA(At, 1, 0); PG8_STAGE(PG8_SA(0, 1), a2 + hstep, voffA);
            PG8_WAIT_V(8); PG8_WAIT_L(0); PG8_BAR; PG8_MMA(0, 0, At, B0); PG8_MMA(0, 1, At, B1); PG8_BAR; PG8_SCHED;
            PG8_LDA(At, 1, 1); PG8_STAGE(PG8_SB(1, 0), b3, voffB); PG8_STAGE(PG8_SB(1, 1), b3 + hstep, voffB); PG8_STAGE(PG8_SA(1, 0), a3, voffA);
            PG8_WAIT_V(8); PG8_WAIT_L(0); PG8_BAR; PG8_MMA(1, 0, At, B0); PG8_MMA(1, 1, At, B1); PG8_BAR; PG8_SCHED;
            } else {
            PG8_LDB(B0, 0, 0); PG8_SCHED; PG8_LDA(At, 0, 0); PG8_STAGE(PG8_SA(1, 1), a1 + hstep, voffA);
            PG8_WAIT_L(8); PG8_BAR; PG8_WAIT_L(0); PG8_MMA(0, 0, At, B0); PG8_BAR; PG8_SCHED;
            PG8_LDB(B1, 0, 1); PG8_STAGE(PG8_SB(0, 0), b2, voffB);
            PG8_BAR; PG8_WAIT_L(0); PG8_MMA(0, 1, At, B1); PG8_BAR;
            PG8_LDA(At, 0, 1); PG8_STAGE(PG8_SA(0, 0), a2, voffA);
            PG8_BAR; PG8_WAIT_L(0); PG8_MMA(1, 0, At, B0); PG8_BAR; PG8_SCHED;
            PG8_STAGE(PG8_SB(0, 1), b2 + hstep, voffB);
            PG8_WAIT_V(6); PG8_BAR; PG8_MMA(1, 1, At, B1); PG8_BAR;
            PG8_LDB(B0, 1, 0); PG8_SCHED; PG8_LDA(At, 1, 0); PG8_STAGE(PG8_SA(0, 1), a2 + hstep, voffA);
            PG8_WAIT_L(8); PG8_BAR; PG8_WAIT_L(0); PG8_MMA(0, 0, At, B0); PG8_BAR; PG8_SCHED;
            PG8_LDB(B1, 1, 1); PG8_STAGE(PG8_SB(1, 0), b3, voffB);
            PG8_BAR; PG8_WAIT_L(0); PG8_MMA(0, 1, At, B1); PG8_BAR;
            PG8_LDA(At, 1, 1); PG8_STAGE(PG8_SA(1, 0), a3, voffA);
            PG8_BAR; PG8_WAIT_L(0); PG8_MMA(1, 0, At, B0); PG8_BAR; PG8_SCHED;
            PG8_STAGE(PG8_SB(1, 1), b3 + hstep, voffB);
            PG8_WAIT_V(6); PG8_BAR; PG8_MMA(1, 1, At, B1); PG8_BAR;
            }
        }
        if constexpr (ALIGN_EPI) { if (wr == 0) PG8_BAR; }
        if constexpr (!Epi::AFTER_DRAIN) { E(acc, cur, wr, wc, fr, fq); S.done(cur); }
        if (!has_next) break;
#pragma unroll
        for (int a = 0; a < 2; ++a)
#pragma unroll
            for (int b = 0; b < 2; ++b)
#pragma unroll
                for (int m = 0; m < 4; ++m)
#pragma unroll
                    for (int n = 0; n < 2; ++n) acc[a][b][m][n] = (f32x4){0.f, 0.f, 0.f, 0.f};
        cur = nxt; cA = nA; cB = nB; ++ui;
        if constexpr (ALIGN_EPI) { if (wr == 1) PG8_BAR; }
    }
    PG8_WAIT_V(0);
    if constexpr (!ALIGN_EPI) { if (wr == 0) PG8_BAR; }
    PG8_BAR;
    if constexpr (Epi::AFTER_DRAIN) { E.fused(acc, cur, wr, wc, fr, fq, lds, wid, lane); S.done(cur); }
#undef PG8_SA
#undef PG8_SB
#undef PG8_STAGE
#undef PG8_LDA
#undef PG8_LDB
#undef PG8_MMA
#undef PG8_WAIT_V
#undef PG8_WAIT_L
#undef PG8_BAR
#undef PG8_SCHED
}
}

#include <hip/hip_cooperative_groups.h>
#include <cstdio>
namespace cg = cooperative_groups;

#define LAS __attribute__((address_space(3)))
typedef unsigned short bf16;
typedef float f32x4 __attribute__((ext_vector_type(4)));
typedef float f32x2 __attribute__((ext_vector_type(2)));
typedef short bf16x8 __attribute__((ext_vector_type(8)));
typedef unsigned u32x4 __attribute__((ext_vector_type(4)));
typedef unsigned u32x2 __attribute__((ext_vector_type(2)));
typedef _Float16 h16x4 __attribute__((ext_vector_type(4)));
typedef _Float16 h16x8 __attribute__((ext_vector_type(8)));

constexpr int D = 1024, ML = 32768, MC = 512, MT = 33280, SEQ = 16384, CTXL = 256, FF = 2816, LW = 1280;
constexpr int NMOD = 9216;
constexpr size_t MiB = 1u << 20;
constexpr size_t WS_MOD = 1 * MiB, WS_ROPE = 2 * MiB, WS_XC = 6 * MiB, WS_W = 40 * MiB;
constexpr size_t WS_HB = 206 * MiB, WS_YB = 271 * MiB, WS_BIG = 336 * MiB;
constexpr size_t HL_BYTES = (size_t)MT * LW * 2;
constexpr size_t WS_SUM = WS_BIG + 2 * HL_BYTES, WS_CIN = WS_SUM + 21 * MiB;
constexpr size_t WS_LF = WS_HB, WS_LB2 = WS_HB + HL_BYTES;
constexpr size_t WS_XA = 8 * MiB, WS_XB = 531 * MiB, WS_XCH = 563 * MiB, WS_END = 564 * MiB;
constexpr size_t W1T_BYTES = 11 * MiB, W2T_BYTES = 5 * MiB + MiB / 2;
__host__ __device__ constexpr size_t off_w1t(int i, int f) { return WS_W + (size_t)(i * 2 + f) * W1T_BYTES; }
__host__ __device__ constexpr size_t off_w2t(int i, int f) { return WS_W + 88 * MiB + (size_t)(i * 2 + f) * W2T_BYTES; }
__host__ __device__ constexpr size_t off_na(int j) { return WS_W + 132 * MiB + (size_t)j * 8 * MiB; }
__host__ __device__ constexpr size_t off_lru(int j) { return WS_W + 148 * MiB + (size_t)j * 9 * MiB; }
constexpr size_t LRU_WOL = 5 * MiB, LRU_WG = 7 * MiB + MiB / 2;
constexpr size_t ACT_ELEMS = (size_t)MT * D;
constexpr int LDS_BYTES = 147456;

struct TJob { long long src_off; long long dst_off; int in_idx, map, ldn, ldk, nnt, tile0, ncol0, pad; };
constexpr int MAXJOBS = 44;
struct Args {
    const float* in[23];
    float* out;
    unsigned char* ws;
    int ph_lo, ph_hi, njobs, ntiles;
    unsigned pdesc[48];
    TJob jobs[MAXJOBS];
};

__device__ __forceinline__ float bf2f(unsigned short v) { return __uint_as_float((unsigned)v << 16); }
__device__ __forceinline__ unsigned pk2(float lo, float hi) { return pg8::cvt_pk_bf16(lo, hi); }
__device__ __forceinline__ float wave_sum(float v) {
#pragma unroll
    for (int o = 1; o < 64; o <<= 1) v += __shfl_xor(v, o);
    return v;
}
__device__ __forceinline__ float sigmoidf_(float v) { return __builtin_amdgcn_rcpf(1.0f + __expf(-v)); }

struct EpiSwiGLU {
    static constexpr bool PERM = true, AFTER_DRAIN = false;
    bf16* O;
    __device__ __forceinline__ void operator()(const f32x4 (&acc)[2][2][4][2], const pg8::Unit& u, int wr, int wc, int fr, int fq) const {
        const int row0 = u.pm * 256 + wr * 64 + fr, colh = u.pn * 128 + wc * 32 + 8 * fq;
#pragma unroll
        for (int ai = 0; ai < 2; ++ai)
#pragma unroll
            for (int m = 0; m < 4; ++m) { bf16* rowp = O + (size_t)(row0 + ai * 128 + m * 16) * FF + colh;
                float o[8];
#pragma unroll
                for (int n = 0; n < 2; ++n) { const f32x4 g = acc[ai][0][m][n], up = acc[ai][1][m][n];
                    const f32x4 ng = __builtin_elementwise_max(g, (f32x4){-14.f, -14.f, -14.f, -14.f}) * -1.4426950408889634f;
                    const f32x4 d = (f32x4){__builtin_amdgcn_exp2f(ng[0]), __builtin_amdgcn_exp2f(ng[1]), __builtin_amdgcn_exp2f(ng[2]), __builtin_amdgcn_exp2f(ng[3])} + 1.0f;
                    const float p01 = d[0] * d[1], p23 = d[2] * d[3]; const float t = __builtin_amdgcn_rcpf(p01 * p23);
                    const float i01 = t * p23, i23 = t * p01;
                    const f32x4 gu = g * up;
                    o[4 * n + 0] = gu[0] * (i01 * d[1]); o[4 * n + 1] = gu[1] * (i01 * d[0]); o[4 * n + 2] = gu[2] * (i23 * d[3]); o[4 * n + 3] = gu[3] * (i23 * d[2]); }
                u32x4 w; w.x = pk2(o[0], o[1]); w.y = pk2(o[2], o[3]); w.z = pk2(o[4], o[5]); w.w = pk2(o[6], o[7]);
                *(u32x4*)rowp = w; }
    }
};
struct EpiRope {
    static constexpr bool PERM = true, AFTER_DRAIN = false;
    bf16* Q; bf16* K; const float* ctab; const float* stab;
    __device__ __forceinline__ void operator()(const f32x4 (&acc)[2][2][4][2], const pg8::Unit& u, int wr, int wc, int fr, int fq) const {
        const int row0 = u.pm * 256 + wr * 64 + fr;
        const int i = 4 * (wc & 1) + fq;
#pragma unroll
        for (int ai = 0; ai < 2; ++ai)
#pragma unroll
            for (int m = 0; m < 4; ++m) {
                const int row = row0 + ai * 128 + m * 16;
                f32x4 cs = (f32x4){1.f, 1.f, 1.f, 1.f}, sn = (f32x4){0.f, 0.f, 0.f, 0.f};
                if (row < ML) { const int t = row & (SEQ - 1); cs = *(const f32x4*)(ctab + t * 32 + 4 * i); sn = *(const f32x4*)(stab + t * 32 + 4 * i); }
#pragma unroll
                for (int bj = 0; bj < 2; ++bj) {
                    const int c = u.pn * 256 + bj * 128 + wc * 32;
                    const bool isk = c >= 1024; const int head = (c & 1023) >> 6;
                    const float sc = isk ? 1.0f : 0.18033688011112042f;
                    bf16* dst = (isk ? K : Q) + (size_t)row * D + head * 64 + 4 * i;
                    const f32x4 x1 = acc[ai][bj][m][0], x2 = acc[ai][bj][m][1];
                    const f32x4 o1 = (x1 * cs - x2 * sn) * sc, o2 = (x1 * sn + x2 * cs) * sc;
                    u32x2 w1, w2; w1.x = pk2(o1[0], o1[1]); w1.y = pk2(o1[2], o1[3]); w2.x = pk2(o2[0], o2[1]); w2.y = pk2(o2[2], o2[3]);
                    *(u32x2*)dst = w1; *(u32x2*)(dst + 32) = w2; } }
    }
};
struct EpiGeluSplit {
    static constexpr bool PERM = true, AFTER_DRAIN = false;
    bf16* G; bf16* V;
    __device__ __forceinline__ void operator()(const f32x4 (&acc)[2][2][4][2], const pg8::Unit& u, int wr, int wc, int fr, int fq) const {
        const int row0 = u.pm * 256 + wr * 64 + fr; const bool isg = u.pn < 5;
        const int col0 = (isg ? u.pn * 256 : u.pn * 256 - LW) + wc * 32 + 8 * fq;
        bf16* base = isg ? G : V;
#pragma unroll
        for (int ai = 0; ai < 2; ++ai)
#pragma unroll
            for (int m = 0; m < 4; ++m) { bf16* rowp = base + (size_t)(row0 + ai * 128 + m * 16) * LW + col0;
#pragma unroll
                for (int bj = 0; bj < 2; ++bj) { f32x4 v0 = acc[ai][bj][m][0], v1 = acc[ai][bj][m][1];
                    if (isg) {
#pragma unroll
                        for (int e = 0; e < 4; ++e) { const float a = v0[e], b = v1[e];
                            v0[e] = a * sigmoidf_(1.5957691216f * (a + 0.044715f * a * a * a));
                            v1[e] = b * sigmoidf_(1.5957691216f * (b + 0.044715f * b * b * b)); } }
                    u32x4 w; w.x = pk2(v0[0], v0[1]); w.y = pk2(v0[2], v0[3]); w.z = pk2(v1[0], v1[1]); w.w = pk2(v1[2], v1[3]);
                    *(u32x4*)(rowp + bj * 128) = w; } }
    }
};

#ifndef PG8_ALIGN_EPI
#define PG8_ALIGN_EPI false
#endif
#ifndef PG8_USE_SP2
#define PG8_USE_SP2 true
#endif
template <class Epi>
__device__ __forceinline__ void run_gemm(LAS unsigned char* lds, const bf16* A, const bf16* Bt, int Mg, int Ng, int K, const Epi& E) {
    int bid = blockIdx.x, gsz = gridDim.x; asm volatile("" : "+s"(bid), "+s"(gsz));
    pg8::Gemm g{A, Bt, Mg, Ng, K}; pg8::StaticOrder S; S.init(Mg, Ng, gsz, bid);
    pg8::gemm_phase<Epi, pg8::StaticOrder, PG8_ALIGN_EPI, PG8_USE_SP2>(lds, g, S, E);
}

__device__ __forceinline__ const float* pick_in(const Args& a, const int z, int idx) {
    const float* p = a.in[8 + z];
    p = idx == 9 ? a.in[9 + z] : p; p = idx == 10 ? a.in[10 + z] : p; p = idx == 11 ? a.in[11 + z] : p; p = idx == 12 ? a.in[12 + z] : p;
    p = idx == 14 ? a.in[14 + z] : p; p = idx == 17 ? a.in[17 + z] : p; p = idx == 19 ? a.in[19 + z] : p; p = idx == 22 ? a.in[22 + z] : p;
    return p;
}
__device__ __forceinline__ int map_row(int map, int n) {
    if (map == 1) return 256 * (n >> 7) + (n & 127);
    if (map == 2) return 256 * (n >> 7) + 128 + (n & 127);
    if (map == 3) { const int hc = n >> 6, d = n & 63; return 64 * hc + 8 * ((d & 31) >> 2) + 4 * (d >> 5) + (d & 3); }
    return n;
}
__device__ __forceinline__ void prep_phase(const Args& a, const int z, LAS unsigned char* lds) {
    int tid_ = threadIdx.x; asm volatile("" : "+v"(tid_));
    const int tid = tid_, wave = __builtin_amdgcn_readfirstlane(tid >> 6), lane = tid & 63;
    float* MOD = (float*)((a.ws + z) + WS_MOD);
    LAS float* sc = (LAS float*)lds;
    LAS float* red = (LAS float*)(lds + 16384);
    bool have_sc = false;
    for (int it = blockIdx.x; it < 144; it += gridDim.x) {
        if (!have_sc) {
            for (int e = tid; e < 3 * D; e += 512) { const int r = e >> 10, k = e & 1023; const float v = r < 2 ? a.in[1 + z][r * D + k] : a.in[3 + z][k]; sc[e] = v * sigmoidf_(v); }
            have_sc = true; __syncthreads();
        }
        const int layer = it / 36, cg0 = (it % 36) * 256;
        const float* W = a.in[4 + z] + (size_t)layer * D * NMOD + cg0 + 4 * lane;
        f32x4 acc0 = (f32x4){0.f, 0.f, 0.f, 0.f}, acc1 = acc0, acc2 = acc0;
        const int kb = wave * 128;
        for (int k0 = 0; k0 < 128; k0 += 8) {
            f32x4 w[8];
#pragma unroll
            for (int e = 0; e < 8; ++e) w[e] = *(const f32x4*)(W + (size_t)(kb + k0 + e) * NMOD);
#pragma unroll
            for (int e = 0; e < 8; ++e) { const float s0 = sc[kb + k0 + e], s1 = sc[D + kb + k0 + e], s2 = sc[2 * D + kb + k0 + e];
                acc0 += w[e] * s0; acc1 += w[e] * s1; acc2 += w[e] * s2; }
        }
        *(LAS f32x4*)(red + (wave * 3 + 0) * 256 + 4 * lane) = acc0;
        *(LAS f32x4*)(red + (wave * 3 + 1) * 256 + 4 * lane) = acc1;
        *(LAS f32x4*)(red + (wave * 3 + 2) * 256 + 4 * lane) = acc2;
        __syncthreads();
        for (int e = tid; e < 768; e += 512) { const int r = e >> 8, c = e & 255; float s = 0.f;
#pragma unroll
            for (int w8 = 0; w8 < 8; ++w8) s += red[(w8 * 3 + r) * 256 + c];
            MOD[(size_t)(layer * 3 + r) * NMOD + cg0 + c] = s + a.in[5 + z][layer * NMOD + cg0 + c]; }
        __syncthreads();
    }
    {
        float* ctab = (float*)((a.ws + z) + WS_ROPE); float* stab = ctab + SEQ * 32;
        for (int e = blockIdx.x * 512 + tid; e < SEQ * 32; e += gridDim.x * 512) {
            const int t = e >> 5, p = e & 31; const float pos = (float)(p < 16 ? (t >> 6) : (t & 63));
            const float invf = powf(10000.0f, -(float)(p & 15) / 16.0f); const float ang = pos * invf;
            ctab[e] = cosf(ang); stab[e] = sinf(ang); }
    }
    __syncthreads();
    LAS float* T = (LAS float*)(lds + 65536);
    int jxs = 0;
    for (int tile0 = blockIdx.x; tile0 < a.ntiles; tile0 += 2 * gridDim.x) {
        bf16* dst[2]; int mapk[2], ldk[2], k0s[2], n0s[2]; bool ok[2];
#pragma unroll
        for (int q = 0; q < 2; ++q) {
            const int tile = tile0 + q * (int)gridDim.x; ok[q] = tile < a.ntiles; const int tl = ok[q] ? tile : tile0;
            if (tl < a.jobs[jxs].tile0) jxs = 0;
            while (jxs + 1 < a.njobs && tl >= a.jobs[jxs + 1].tile0) ++jxs;
            const TJob jb = a.jobs[jxs];
            const int local = tl - jb.tile0, kt = local / jb.nnt, nt = local % jb.nnt; k0s[q] = kt * 64; n0s[q] = nt * 128;
            dst[q] = (bf16*)((a.ws + z) + jb.dst_off); mapk[q] = jb.map; ldk[q] = jb.ldk;
            const int kk = tid >> 3, nj = (tid & 7) * 4;
            const float* p = pick_in(a, z, jb.in_idx) + jb.src_off + (size_t)(k0s[q] + kk) * jb.ldn + jb.ncol0 + n0s[q] + nj;
            LAS float* t = T + q * 8256 + kk * 129 + nj;
#pragma unroll
            for (int j = 0; j < 4; ++j) { const f32x4 v = *(const f32x4*)(p + 32 * j); t[32 * j] = v[0]; t[32 * j + 1] = v[1]; t[32 * j + 2] = v[2]; t[32 * j + 3] = v[3]; }
        }
        __syncthreads();
#pragma unroll
        for (int q = 0; q < 2; ++q) if (ok[q]) {
            const int nl = tid >> 2, ks = (tid & 3) * 16; const LAS float* t = T + q * 8256 + ks * 129 + nl;
            u32x4 o0, o1;
            o0.x = pk2(t[0], t[129]); o0.y = pk2(t[2 * 129], t[3 * 129]); o0.z = pk2(t[4 * 129], t[5 * 129]); o0.w = pk2(t[6 * 129], t[7 * 129]);
            o1.x = pk2(t[8 * 129], t[9 * 129]); o1.y = pk2(t[10 * 129], t[11 * 129]); o1.z = pk2(t[12 * 129], t[13 * 129]); o1.w = pk2(t[14 * 129], t[15 * 129]);
            size_t drow, dcol;
            if (mapk[q] == 4) { drow = (size_t)((k0s[q] >> 7) * 128 + n0s[q] + nl); dcol = (size_t)((k0s[q] & 127) + ks); }
            else { drow = (size_t)map_row(mapk[q], n0s[q] + nl); dcol = (size_t)(k0s[q] + ks); }
            bf16* dp = dst[q] + drow * ldk[q] + dcol;
            *(u32x4*)dp = o0; *(u32x4*)(dp + 8) = o1; }
        __syncthreads();
    }
}

__device__ __forceinline__ void norm_phase(const Args& a, const int z, int res_l, int res_s, float res_w, int pre_l, int pre_s, bool dry) {
    int tid_ = threadIdx.x; asm volatile("" : "+v"(tid_));
    const int tid = tid_, wave = __builtin_amdgcn_readfirstlane(tid >> 6), lane = tid & 63;
    const int gw = blockIdx.x * 8 + wave, NGW = gridDim.x * 8;
    const float* MOD = (const float*)((a.ws + z) + WS_MOD);
    const bf16* YB = (const bf16*)((a.ws + z) + WS_YB);
    bf16* HB = (bf16*)((a.ws + z) + WS_HB);
    const bool first = res_l < 0, has_pre = pre_l >= 0;
    const int rbeg = (int)(((long long)gw * MT) / NGW), rend = (int)(((long long)(gw + 1) * MT) / NGW);
    f32x4 vres[4], vsc[4], vsh[4]; int rcur = -1;
    for (int rowa = rbeg; rowa < rend; rowa += 2) {
        int rows[2] = {rowa, rowa + 1}; bool v1 = rows[1] < rend;
        const int rcl = rowa < SEQ ? 0 : (rowa < ML ? 1 : 2);
        if (v1 && (rows[1] < SEQ ? 0 : (rows[1] < ML ? 1 : 2)) != rcl) v1 = false;
        if (!v1) rows[1] = rowa;
        if (rcl != rcur) {
            rcur = rcl;
            if (!first) { const float* gate = MOD + (size_t)(res_l * 3 + rcl) * NMOD + (3 * res_s + 2) * D; const float* gpost = a.in[7 + z] + (size_t)(res_l * 3 + res_s) * D;
#pragma unroll
                for (int j = 0; j < 4; ++j) vres[j] = *(const f32x4*)(gate + j * 256 + 4 * lane) * *(const f32x4*)(gpost + j * 256 + 4 * lane) * res_w; }
            if (has_pre) { const float* mb = MOD + (size_t)(pre_l * 3 + rcl) * NMOD + (3 * pre_s) * D; const float* gpre = a.in[6 + z] + (size_t)(pre_l * 3 + pre_s) * D;
#pragma unroll
                for (int j = 0; j < 4; ++j) { vsh[j] = *(const f32x4*)(mb + j * 256 + 4 * lane); vsc[j] = (*(const f32x4*)(mb + D + j * 256 + 4 * lane) + 1.0f) * *(const f32x4*)(gpre + j * 256 + 4 * lane); } }
        }
        _Float16* x16[2];
#pragma unroll
        for (int q = 0; q < 2; ++q) { const int row = rows[q];
            x16[q] = (_Float16*)((a.ws + z) + (row < SEQ ? WS_XA : (row < ML ? WS_XB : WS_XCH))) + (size_t)(row < SEQ ? row : (row < ML ? row - SEQ : row - ML)) * D; }
        f32x4 xv[2][4]; f32x4 yv[2][4];
        if (first) {
#pragma unroll
            for (int q = 0; q < 2; ++q) { const int row = rows[q]; const float* xs = row < ML ? a.in[0 + z] + (size_t)row * D : a.in[2 + z] + (size_t)(row - ML) * D;
#pragma unroll
                for (int j = 0; j < 4; ++j) xv[q][j] = __builtin_nontemporal_load((const f32x4*)(xs + j * 256 + 4 * lane)); }
        } else {
#pragma unroll
            for (int q = 0; q < 2; ++q)
#pragma unroll
                for (int j = 0; j < 4; ++j) { const h16x4 hv = __builtin_nontemporal_load((const h16x4*)(x16[q] + j * 256 + 4 * lane));
                    xv[q][j] = (f32x4){(float)hv[0], (float)hv[1], (float)hv[2], (float)hv[3]}; }
        }
        if (!first) {
            float ss[2] = {0.f, 0.f};
#pragma unroll
            for (int q = 0; q < 2; ++q)
#pragma unroll
                for (int j = 0; j < 4; ++j) { const u32x2 w = __builtin_nontemporal_load((const u32x2*)(YB + (size_t)rows[q] * D + j * 256 + 4 * lane));
                    yv[q][j] = (f32x4){__uint_as_float(w.x << 16), __uint_as_float(w.x & 0xffff0000u), __uint_as_float(w.y << 16), __uint_as_float(w.y & 0xffff0000u)};
                    ss[q] += (yv[q][j][0] * yv[q][j][0] + yv[q][j][1] * yv[q][j][1]) + (yv[q][j][2] * yv[q][j][2] + yv[q][j][3] * yv[q][j][3]); }
#pragma unroll
            for (int o = 1; o < 64; o <<= 1) { ss[0] += __shfl_xor(ss[0], o); ss[1] += __shfl_xor(ss[1], o); }
#pragma unroll
            for (int q = 0; q < 2; ++q) { const float rstd = rsqrtf(ss[q] * (1.0f / D) + 1e-6f);
#pragma unroll
                for (int j = 0; j < 4; ++j) xv[q][j] += vres[j] * yv[q][j] * rstd; }
        }
#pragma unroll
        for (int q = 0; q < 2; ++q) if (q == 0 || v1) {
            if (has_pre) {
#pragma unroll
                for (int j = 0; j < 4; ++j) __builtin_nontemporal_store((h16x4){(_Float16)xv[q][j][0], (_Float16)xv[q][j][1], (_Float16)xv[q][j][2], (_Float16)xv[q][j][3]}, (h16x4*)(x16[q] + j * 256 + 4 * lane));
            } else if (rows[q] < ML) {
#pragma unroll
                for (int j = 0; j < 4; ++j) __builtin_nontemporal_store(xv[q][j], (f32x4*)((a.out + z) + (size_t)rows[q] * D + j * 256 + 4 * lane));
            }
        }
        if (has_pre) {
            float ss[2] = {0.f, 0.f};
#pragma unroll
            for (int q = 0; q < 2; ++q)
#pragma unroll
                for (int j = 0; j < 4; ++j) ss[q] += (xv[q][j][0] * xv[q][j][0] + xv[q][j][1] * xv[q][j][1]) + (xv[q][j][2] * xv[q][j][2] + xv[q][j][3] * xv[q][j][3]);
#pragma unroll
            for (int o = 1; o < 64; o <<= 1) { ss[0] += __shfl_xor(ss[0], o); ss[1] += __shfl_xor(ss[1], o); }
#pragma unroll
            for (int q = 0; q < 2; ++q) if (q == 0 || v1) { const float rstd = rsqrtf(ss[q] * (1.0f / D) + 1e-6f);
#pragma unroll
                for (int j = 0; j < 4; ++j) { const f32x4 h = xv[q][j] * rstd * vsc[j] + vsh[j];
                    u32x2 w; w.x = pk2(h[0], h[1]); w.y = pk2(h[2], h[3]);
                    *(u32x2*)(HB + (size_t)rows[q] * D + j * 256 + 4 * lane) = w; } }
        }
    }
}

struct KVFrag { bf16x8 k[2][2]; bf16x8 v[4]; };
__device__ __forceinline__ void attn_load(KVFrag& f, const bf16* Kb, const bf16* Vt, int T0, int krow, int h, int fr, int g) {
    const bf16* kp = Kb + (size_t)(T0 + krow) * D + h * 64 + g * 8;
#pragma unroll
    for (int t = 0; t < 2; ++t)
#pragma unroll
        for (int ks = 0; ks < 2; ++ks) f.k[t][ks] = *(const bf16x8*)(kp + (size_t)(4 * t) * D + ks * 32);
    const bf16* vp = Vt + (size_t)(h * 64 + fr) * MT + T0 + g * 8;
#pragma unroll
    for (int dt = 0; dt < 4; ++dt) f.v[dt] = *(const bf16x8*)(vp + (size_t)(dt * 16) * MT);
}
__device__ __forceinline__ void attn_step(const KVFrag& f, const bf16x8 qb0, const bf16x8 qb1, const bool lat, const LAS float* bpl, const unsigned vm,
                                          f32x4 (&o)[4], float& mrun, float& lrun) {
    f32x4 s0 = (f32x4){0.f, 0.f, 0.f, 0.f}, s1 = s0;
    s0 = __builtin_amdgcn_mfma_f32_16x16x32_bf16(f.k[0][0], qb0, s0, 0, 0, 0);
    s0 = __builtin_amdgcn_mfma_f32_16x16x32_bf16(f.k[0][1], qb1, s0, 0, 0, 0);
    s1 = __builtin_amdgcn_mfma_f32_16x16x32_bf16(f.k[1][0], qb0, s1, 0, 0, 0);
    s1 = __builtin_amdgcn_mfma_f32_16x16x32_bf16(f.k[1][1], qb1, s1, 0, 0, 0);
    float s[8] = {s0[0], s0[1], s0[2], s0[3], s1[0], s1[1], s1[2], s1[3]};
    if (lat) {
#pragma unroll
        for (int e = 0; e < 8; ++e) { const float bv = bpl[e]; s[e] = ((vm >> e) & 1u) ? s[e] + bv : -1e30f; }
    }
    float cm = fmaxf(fmaxf(fmaxf(s[0], s[1]), fmaxf(s[2], s[3])), fmaxf(fmaxf(s[4], s[5]), fmaxf(s[6], s[7])));
    if (__any(cm > mrun + 40.0f)) {
        cm = fmaxf(cm, __shfl_xor(cm, 16)); cm = fmaxf(cm, __shfl_xor(cm, 32));
        const float mnew = fmaxf(mrun, cm); const float alpha = __builtin_amdgcn_exp2f(mrun - mnew);
        lrun *= alpha; mrun = mnew;
#pragma unroll
        for (int dt = 0; dt < 4; ++dt) o[dt] = o[dt] * alpha;
    }
    float ps = 0.f;
#pragma unroll
    for (int e = 0; e < 8; ++e) { s[e] = __builtin_amdgcn_exp2f(s[e] - mrun); ps += s[e]; }
    lrun += ps;
    union { u32x4 u; bf16x8 v; } pb;
    pb.u.x = pk2(s[0], s[1]); pb.u.y = pk2(s[2], s[3]); pb.u.z = pk2(s[4], s[5]); pb.u.w = pk2(s[6], s[7]);
#pragma unroll
    for (int dt = 0; dt < 4; ++dt) o[dt] = __builtin_amdgcn_mfma_f32_16x16x32_bf16(f.v[dt], pb.v, o[dt], 0, 0, 0);
}
constexpr int A_KC = 0, A_KP = 144, A_VC = 36864, A_VP = 528, A_RP = 36864 + 33792, A_QS = 36864 + 33792 + 2560;
__device__ __forceinline__ void attn_phase(const Args& a, const int z, int j, LAS unsigned char* lds, bool dry) {
    int tid_ = threadIdx.x; asm volatile("" : "+v"(tid_));
    const int tid = tid_, wave = __builtin_amdgcn_readfirstlane(tid >> 6), lane = tid & 63, fr = lane & 15, g = lane >> 4;
    bf16* Q = (bf16*)((a.ws + z) + WS_BIG); const bf16* Kb = Q + ACT_ELEMS; const bf16* Vt = Q + 2 * ACT_ELEMS;
    const int krow = (fr >> 2) * 8 + (fr & 3);
    for (int wg = blockIdx.x; wg < 256; wg += gridDim.x) {
        const int xcd = wg & 7, idx = wg >> 3, pair = xcd * 4 + (idx >> 3), sub = idx & 7, b = pair >> 4, h = pair & 15;
        __syncthreads();
        for (int e = tid; e < 256 * 8; e += 512) { const int key = e >> 3, p = e & 7;
            *(LAS u32x4*)(lds + A_KC + key * A_KP + p * 16) = *(const u32x4*)(Kb + (size_t)(ML + b * CTXL + key) * D + h * 64 + p * 8); }
        for (int e = tid; e < 64 * 32; e += 512) { const int d = e >> 5, p = e & 31;
            *(LAS u32x4*)(lds + A_VC + d * A_VP + p * 16) = *(const u32x4*)(Vt + (size_t)(h * 64 + d) * MT + ML + b * CTXL + p * 8); }
        { const float* rpb = a.in[13 + z] + (size_t)(j * 16 + h) * 465; for (int e = tid; e < 465; e += 512) ((LAS float*)(lds + A_RP))[64 + e] = rpb[e] * 1.4426950408889634f; }
        __syncthreads();
        if (wave < 2) {
            const int qrow0 = ML + b * CTXL + (sub * 2 + wave) * 16;
            bf16* qp = Q + (size_t)(qrow0 + fr) * D + h * 64;
            const bf16x8 qb0 = *(const bf16x8*)(qp + g * 8), qb1 = *(const bf16x8*)(qp + 32 + g * 8);
            f32x4 o[4];
#pragma unroll
            for (int dt = 0; dt < 4; ++dt) o[dt] = (f32x4){0.f, 0.f, 0.f, 0.f};
            float mrun = -1e30f, lrun = 0.f;
            for (int cc = 0; cc < 8; ++cc) {
                KVFrag f;
#pragma unroll
                for (int t = 0; t < 2; ++t)
#pragma unroll
                    for (int ks = 0; ks < 2; ++ks) f.k[t][ks] = *(const LAS bf16x8*)(lds + A_KC + (cc * 32 + krow + 4 * t) * A_KP + (ks * 32 + g * 8) * 2);
#pragma unroll
                for (int dt = 0; dt < 4; ++dt) f.v[dt] = *(const LAS bf16x8*)(lds + A_VC + (dt * 16 + fr) * A_VP + (cc * 32 + g * 8) * 2);
                attn_step(f, qb0, qb1, false, nullptr, 0u, o, mrun, lrun);
            }
            lrun += __shfl_xor(lrun, 16); lrun += __shfl_xor(lrun, 32);
            const float inv = 1.0f / lrun;
            bf16* op = dry ? (bf16*)((a.ws + z) + WS_HB) + (size_t)(qrow0 + fr) * D + h * 64 : qp;
#pragma unroll
            for (int dt = 0; dt < 4; ++dt) { u32x2 w; w.x = pk2(o[dt][0] * inv, o[dt][1] * inv); w.y = pk2(o[dt][2] * inv, o[dt][3] * inv);
                *(u32x2*)(op + dt * 16 + g * 4) = w; }
        }
        for (int li = wave; li < 32; li += 8) {
            const int rg = li >> 2, cq = li & 3, rbase = sub * 32 + rg * 4;
            const int cw = cq == 0 ? 0 : (cq == 1 ? 8 : (cq == 2 ? 24 : 32));
            const int cqq = cq * 16 + fr, c0 = min(max(cqq - 8, 0), 48);
            unsigned vm = 0u;
#pragma unroll
            for (int e = 0; e < 8; ++e) { const int rel = cw + g * 8 + e - c0; vm |= (rel >= 0 && rel < 16) ? (1u << e) : 0u; }
            const LAS float* rpl = (const LAS float*)(lds + A_RP) + 64 + (cw + g * 8 - cqq + 15);
            bf16* qp = Q + (size_t)(b * SEQ + rbase * 64 + cq * 16 + fr) * D + h * 64;
            f32x4 o[4][4]; float mrun[4], lrun[4];
            LAS unsigned char* qs = lds + A_QS + wave * 8192 + lane * 16;
#pragma unroll
            for (int t = 0; t < 4; ++t) { *(LAS bf16x8*)(qs + t * 2048) = *(const bf16x8*)(qp + (size_t)t * 64 * D + g * 8); *(LAS bf16x8*)(qs + t * 2048 + 1024) = *(const bf16x8*)(qp + (size_t)t * 64 * D + 32 + g * 8);
                mrun[t] = -1e30f; lrun[t] = 0.f;
#pragma unroll
                for (int dt = 0; dt < 4; ++dt) o[t][dt] = (f32x4){0.f, 0.f, 0.f, 0.f}; }
            const int kr_lo = min(max(rbase - 4, 0), 248), kr_hi = min(max(rbase - 1, 0), 248) + 7;
            KVFrag cur, nxt;
            attn_load(cur, Kb, Vt, b * SEQ + kr_lo * 64 + cw, krow, h, fr, g);
            nxt = cur;
            for (int kr = kr_lo; kr <= kr_hi; ++kr) {
                if (kr < kr_hi) attn_load(nxt, Kb, Vt, b * SEQ + (kr + 1) * 64 + cw, krow, h, fr, g);
#pragma unroll
                for (int t = 0; t < 4; ++t) { const int r = rbase + t, r0 = min(max(r - 4, 0), 248);
                    if (kr >= r0 && kr < r0 + 8)
                        attn_step(cur, *(const LAS bf16x8*)(qs + t * 2048), *(const LAS bf16x8*)(qs + t * 2048 + 1024), true, rpl + (kr - r + 7) * 31, vm, o[t], mrun[t], lrun[t]); }
                cur = nxt;
            }
            for (int cc = 0; cc < 8; ++cc) {
                KVFrag f;
#pragma unroll
                for (int t = 0; t < 2; ++t)
#pragma unroll
                    for (int ks = 0; ks < 2; ++ks) f.k[t][ks] = *(const LAS bf16x8*)(lds + A_KC + (cc * 32 + krow + 4 * t) * A_KP + (ks * 32 + g * 8) * 2);
#pragma unroll
                for (int dt = 0; dt < 4; ++dt) f.v[dt] = *(const LAS bf16x8*)(lds + A_VC + (dt * 16 + fr) * A_VP + (cc * 32 + g * 8) * 2);
#pragma unroll
                for (int t = 0; t < 4; ++t) attn_step(f, *(const LAS bf16x8*)(qs + t * 2048), *(const LAS bf16x8*)(qs + t * 2048 + 1024), false, nullptr, 0u, o[t], mrun[t], lrun[t]);
            }
#pragma unroll
            for (int t = 0; t < 4; ++t) {
                float lt = lrun[t]; lt += __shfl_xor(lt, 16); lt += __shfl_xor(lt, 32);
                const float inv = 1.0f / lt;
                bf16* op = (dry ? (bf16*)((a.ws + z) + WS_HB) + (size_t)(b * SEQ + rbase * 64 + cq * 16 + fr) * D + h * 64 : qp) + (size_t)t * 64 * D;
#pragma unroll
                for (int dt = 0; dt < 4; ++dt) { u32x2 w; w.x = pk2(o[t][dt][0] * inv, o[t][dt][1] * inv); w.y = pk2(o[t][dt][2] * inv, o[t][dt][3] * inv);
                    *(u32x2*)(op + dt * 16 + g * 4) = w; }
            }
        }
    }
    __syncthreads();
}

constexpr int UP = 132;
constexpr int L_U32 = 0, L_UB = 33792, L_GB = 51200, L_T1 = 68608, L_T2 = 86016;
#define LRU_PREFETCH(TASK) do { const int n_ = (TASK) / 1040, c_ = (TASK) - n_ * 1040, m0_ = c_ * 32; int lo_, hi_; \
        if (m0_ < ML) { lo_ = (m0_ / SEQ) * SEQ; hi_ = lo_ + SEQ; } else { lo_ = ML + ((m0_ - ML) / CTXL) * CTXL; hi_ = lo_ + CTXL; } \
        _Pragma("unroll") for (int tap = 0; tap < 4; ++tap) { const int mr = m0_ + tokc + tap - 2; \
            pv[tap] = (mr >= lo_ && mr < hi_) ? *(const u32x4*)(V + (size_t)mr * LW + n_ * 128 + ch8) : (u32x4){0u, 0u, 0u, 0u}; } \
        if (FINAL) pg = *(const u32x4*)(G + (size_t)(m0_ + tokc) * LW + n_ * 128 + ch8); } while (0)
__device__ __forceinline__ unsigned char* lb_row_ptr(const Args& a, const int z, int row) {
    return row < SEQ ? (unsigned char*)(a.out + z) + HL_BYTES + (size_t)row * (LW * 2) : (a.ws + z) + WS_LB2 + (size_t)(row - SEQ) * (LW * 2);
}
__device__ __forceinline__ void lru_scan_phase(const Args& a, const int z, int j, LAS unsigned char* lds) {
    constexpr bool FINAL = false;
    int tid_ = threadIdx.x; asm volatile("" : "+v"(tid_));
    const int tid = tid_, wave = __builtin_amdgcn_readfirstlane(tid >> 6), lane = tid & 63, fr = lane & 15, g = lane >> 4;
    const int tokc = tid >> 4, ch8 = (tid & 15) * 8, ct = wave, ch = ct * 16 + fr;
    bf16* G = (bf16*)((a.ws + z) + WS_BIG); const bf16* V = G + (size_t)MT * LW;
    const bf16* Wg = (const bf16*)((a.ws + z) + off_lru(j) + LRU_WG);
    const float* convw = a.in[15 + z] + (size_t)j * 4 * LW; const float* convb = a.in[16 + z] + (size_t)j * LW;
    const float* b_a = a.in[18 + z] + (size_t)j * 2 * LW; const float* b_x = a.in[20 + z] + (size_t)j * 2 * LW; const float* lam = a.in[21 + z] + (size_t)j * 2 * LW;
    f32x2* SUM = (f32x2*)((a.ws + z) + WS_SUM);
    unsigned char* HLg = (unsigned char*)(a.out + z); unsigned char* LFg = (a.ws + z) + WS_LF;
    int cur_n = -1, pm0 = 0, pn = 0;
    bf16x8 bw[4][4]; float cba[2] = {0.f, 0.f}, cbx[2] = {0.f, 0.f}, csp[2] = {0.f, 0.f};
    f32x4 cw[4][2], cbias[2];
    u32x4 pv[4], pg = (u32x4){0u, 0u, 0u, 0u};
    int task = blockIdx.x, it = 0;
    if (task < 10400) LRU_PREFETCH(task);
    for (; task < 10400; ++it, task += gridDim.x) {
        const int buf = it & 1;
        const int n = task / 1040, c = task - n * 1040, m0 = c * 32;
        LAS float* U32 = (LAS float*)(lds + L_U32) + buf * 32 * UP; LAS bf16* UB = (LAS bf16*)(lds + L_UB) + buf * 32 * 136; LAS bf16* GB = (LAS bf16*)(lds + L_GB) + buf * 32 * 136; LAS _Float16* T1 = (LAS _Float16*)(lds + L_T1) + buf * 32 * 136; LAS _Float16* T2 = (LAS _Float16*)(lds + L_T2) + buf * 32 * 136;
        if (n != cur_n) {
            cur_n = n;
#pragma unroll
            for (int tap = 0; tap < 4; ++tap) { cw[tap][0] = *(const f32x4*)(convw + tap * LW + n * 128 + ch8); cw[tap][1] = *(const f32x4*)(convw + tap * LW + n * 128 + ch8 + 4); }
            cbias[0] = *(const f32x4*)(convb + n * 128 + ch8); cbias[1] = *(const f32x4*)(convb + n * 128 + ch8 + 4);
#pragma unroll
            for (int cb = 0; cb < 4; ++cb)
#pragma unroll
                for (int ks = 0; ks < 4; ++ks) bw[cb][ks] = *(const bf16x8*)(Wg + ((size_t)(cb * 10 + n) * 128 + ch) * 128 + ks * 32 + g * 8);
#pragma unroll
            for (int dir = 0; dir < 2; ++dir) { cba[dir] = b_a[dir * LW + n * 128 + ch]; cbx[dir] = b_x[dir * LW + n * 128 + ch]; csp[dir] = -8.0f * 1.4426950408889634f * log1pf(__expf(-lam[dir * LW + n * 128 + ch])); }
        }
        { f32x4 u0 = cbias[0], u1 = cbias[1];
#pragma unroll
          for (int tap = 0; tap < 4; ++tap) { const u32x4 vv = pv[tap];
              u0 += cw[tap][0] * (f32x4){__uint_as_float(vv.x << 16), __uint_as_float(vv.x & 0xffff0000u), __uint_as_float(vv.y << 16), __uint_as_float(vv.y & 0xffff0000u)};
              u1 += cw[tap][1] * (f32x4){__uint_as_float(vv.z << 16), __uint_as_float(vv.z & 0xffff0000u), __uint_as_float(vv.w << 16), __uint_as_float(vv.w & 0xffff0000u)}; }
          *(LAS f32x4*)(U32 + tokc * UP + ch8) = u0; *(LAS f32x4*)(U32 + tokc * UP + ch8 + 4) = u1;
          u32x4 w; w.x = pk2(u0[0], u0[1]); w.y = pk2(u0[2], u0[3]); w.z = pk2(u1[0], u1[1]); w.w = pk2(u1[2], u1[3]);
          *(LAS u32x4*)(UB + tokc * 136 + ch8) = w;
          }
        __syncthreads();
        if (it > 0) {
            const int pb = (buf ^ 1) * 32 * 136; const size_t go = ((size_t)(pm0 + tokc) * LW + pn * 128 + ch8) * 2;
            *(u32x4*)(HLg + go) = *(const LAS u32x4*)((const LAS bf16*)(lds + L_GB) + pb + tokc * 136 + ch8);
            *(u32x4*)(LFg + go) = *(const LAS u32x4*)((const LAS _Float16*)(lds + L_T1) + pb + tokc * 136 + ch8);
            *(u32x4*)(lb_row_ptr(a, z, pm0 + tokc) + (size_t)(pn * 128 + ch8) * 2) = *(const LAS u32x4*)((const LAS _Float16*)(lds + L_T2) + pb + tokc * 136 + ch8); }
        { const int tn = task + gridDim.x; if (tn < 10400) LRU_PREFETCH(tn); }
        f32x4 acc[2][4];
#pragma unroll
        for (int rt = 0; rt < 2; ++rt)
#pragma unroll
            for (int cb = 0; cb < 4; ++cb) acc[rt][cb] = (f32x4){0.f, 0.f, 0.f, 0.f};
#pragma unroll
        for (int ks = 0; ks < 4; ++ks) {
            bf16x8 af[2];
#pragma unroll
            for (int rt = 0; rt < 2; ++rt) af[rt] = *(const LAS bf16x8*)(UB + (rt * 16 + fr) * 136 + ks * 32 + g * 8);
#pragma unroll
            for (int cb = 0; cb < 4; ++cb)
#pragma unroll
                for (int rt = 0; rt < 2; ++rt) acc[rt][cb] = __builtin_amdgcn_mfma_f32_16x16x32_bf16(af[rt], bw[cb][ks], acc[rt][cb], 0, 0, 0);
        }
        float uv[2][4];
#pragma unroll
        for (int rt = 0; rt < 2; ++rt)
#pragma unroll
            for (int jj = 0; jj < 4; ++jj) uv[rt][jj] = U32[(rt * 16 + g * 4 + jj) * UP + ch];
        float rec[2][4];
#pragma unroll
        for (int rt = 0; rt < 2; ++rt)
#pragma unroll
            for (int jj = 0; jj < 4; ++jj) rec[rt][jj] = 0.f;
#pragma unroll
        for (int dir = 0; dir < 2; ++dir) {
            float av[2][4], bv[2][4], lav[2][4], SA[2], SB[2];
#pragma unroll
            for (int rt = 0; rt < 2; ++rt) {
#pragma unroll
                for (int jp = 0; jp < 2; ++jp) {
                    const f32x2 xr = (f32x2){acc[rt][dir * 2][2 * jp], acc[rt][dir * 2][2 * jp + 1]} + cba[dir];
                    const f32x2 xi = (f32x2){acc[rt][dir * 2 + 1][2 * jp], acc[rt][dir * 2 + 1][2 * jp + 1]} + cbx[dir];
                    const f32x2 nr = __builtin_elementwise_max(xr, (f32x2){-30.f, -30.f}) * -1.4426950408889634f;
                    const f32x2 ni = __builtin_elementwise_max(xi, (f32x2){-30.f, -30.f}) * -1.4426950408889634f;
                    const f32x2 er1 = (f32x2){__builtin_amdgcn_exp2f(nr.x), __builtin_amdgcn_exp2f(nr.y)} + 1.0f;
                    const f32x2 ei1 = (f32x2){__builtin_amdgcn_exp2f(ni.x), __builtin_amdgcn_exp2f(ni.y)} + 1.0f;
                    const f32x2 pr = er1 * ei1;
                    const f32x2 tinv = (f32x2){__builtin_amdgcn_rcpf(pr.x), __builtin_amdgcn_rcpf(pr.y)};
                    const f32x2 rg = tinv * ei1, ig = tinv * er1;
                    const f32x2 la2 = rg * csp[dir];
                    const f32x2 a_ = (f32x2){__builtin_amdgcn_exp2f(la2.x), __builtin_amdgcn_exp2f(la2.y)};
                    const f32x2 x2 = la2 * 1.3862943611198906f;
                    const f32x2 ser = -x2 * (x2 * (x2 * (x2 * 0.041666668f + 0.16666667f) + 0.5f) + 1.0f);
                    const f32x2 alt = 1.0f - a_ * a_;
                    f32x2 om; om.x = x2.x > -0.1f ? ser.x : alt.x; om.y = x2.y > -0.1f ? ser.y : alt.y;
                    om = __builtin_elementwise_max(om, (f32x2){0.f, 0.f});
                    const f32x2 sq = (f32x2){__builtin_amdgcn_sqrtf(om.x), __builtin_amdgcn_sqrtf(om.y)};
                    const f32x2 b_ = sq * ig * (f32x2){uv[rt][2 * jp], uv[rt][2 * jp + 1]};
                    av[rt][2 * jp] = a_.x; av[rt][2 * jp + 1] = a_.y; bv[rt][2 * jp] = b_.x; bv[rt][2 * jp + 1] = b_.y; lav[rt][2 * jp] = la2.x; lav[rt][2 * jp + 1] = la2.y; }
                float sa = 1.f, sb = 0.f;
#pragma unroll
                for (int q = 0; q < 4; ++q) { const int jj = dir ? 3 - q : q; sb = av[rt][jj] * sb + bv[rt][jj]; sa *= av[rt][jj]; }
                SA[rt] = sa; SB[rt] = sb;
            }
            float Hrun = 0.f, Atot = 1.f, myc[2] = {0.f, 0.f}, myab[2] = {1.f, 1.f};
#pragma unroll
            for (int q = 0; q < 8; ++q) { const int rt = dir ? 1 - (q >> 2) : (q >> 2), gg = dir ? 3 - (q & 3) : (q & 3);
                const float sa = __shfl(SA[rt], fr + 16 * gg), sb = __shfl(SB[rt], fr + 16 * gg);
                myc[rt] = (gg == g) ? Hrun : myc[rt]; myab[rt] = (gg == g) ? Atot : myab[rt];
                Hrun = sa * Hrun + sb; Atot *= sa; }
            if (g == 0) SUM[(size_t)(c * 2 + dir) * LW + n * 128 + ch] = (f32x2){Atot, Hrun};
            LAS _Float16* TL = dir ? T2 : T1;
#pragma unroll
            for (int rt = 0; rt < 2; ++rt) { float h = myc[rt], lp = __builtin_amdgcn_logf(myab[rt]);
#pragma unroll
                for (int q = 0; q < 4; ++q) { const int jj = dir ? 3 - q : q; h = av[rt][jj] * h + bv[rt][jj]; rec[rt][jj] += h;
                    lp += lav[rt][jj]; TL[(rt * 16 + g * 4 + jj) * 136 + ch] = (_Float16)lp; } }
        }
#pragma unroll
        for (int rt = 0; rt < 2; ++rt)
#pragma unroll
            for (int jj = 0; jj < 4; ++jj) GB[(rt * 16 + g * 4 + jj) * 136 + ch] = (bf16)(pk2(rec[rt][jj], 0.f) & 0xffffu);
        pm0 = m0; pn = n;
    }
    __syncthreads();
    if (it > 0) { const int pb = ((it - 1) & 1) * 32 * 136; const size_t go = ((size_t)(pm0 + tokc) * LW + pn * 128 + ch8) * 2;
        *(u32x4*)(HLg + go) = *(const LAS u32x4*)((const LAS bf16*)(lds + L_GB) + pb + tokc * 136 + ch8);
        *(u32x4*)(LFg + go) = *(const LAS u32x4*)((const LAS _Float16*)(lds + L_T1) + pb + tokc * 136 + ch8);
        *(u32x4*)(lb_row_ptr(a, z, pm0 + tokc) + (size_t)(pn * 128 + ch8) * 2) = *(const LAS u32x4*)((const LAS _Float16*)(lds + L_T2) + pb + tokc * 136 + ch8); }
    __syncthreads();
}
__device__ __forceinline__ void lru_apply_phase(const Args& a, const int z, bool dry) {
    int tid_ = threadIdx.x; asm volatile("" : "+v"(tid_));
    const int tid = tid_;
    bf16* G = (bf16*)((a.ws + z) + WS_BIG); const float* CIN = (const float*)((a.ws + z) + WS_CIN);
    const unsigned char* HLg = (const unsigned char*)(a.out + z); const unsigned char* LFg = (a.ws + z) + WS_LF;
    const int stride = (int)gridDim.x * 512;
    for (int idx0 = blockIdx.x * 512 + tid; idx0 < MT * 160; idx0 += 4 * stride) {
        u32x4 hl[4], gv[4]; h16x8 lf[4], lb[4]; f32x4 cfa[4][2], cba[4][2]; size_t go[4]; bool ok[4];
#pragma unroll
        for (int k = 0; k < 4; ++k) { const int idx = idx0 + k * stride; ok[k] = idx < MT * 160; const int id = ok[k] ? idx : idx0;
            const int row = id / 160, c8 = (id - row * 160) * 8, chunk = row >> 5; go[k] = ((size_t)row * LW + c8) * 2;
            hl[k] = __builtin_nontemporal_load((const u32x4*)(HLg + go[k])); gv[k] = __builtin_nontemporal_load((const u32x4*)((const unsigned char*)G + go[k]));
            lf[k] = __builtin_nontemporal_load((const h16x8*)(LFg + go[k])); lb[k] = __builtin_nontemporal_load((const h16x8*)(lb_row_ptr(a, z, row) + (size_t)c8 * 2));
            const float* cfp = CIN + (size_t)(chunk * 2) * LW + c8;
            cfa[k][0] = *(const f32x4*)cfp; cfa[k][1] = *(const f32x4*)(cfp + 4); cba[k][0] = *(const f32x4*)(cfp + LW); cba[k][1] = *(const f32x4*)(cfp + LW + 4); }
#pragma unroll
        for (int k = 0; k < 4; ++k) if (ok[k]) {
            const unsigned hw[4] = {hl[k].x, hl[k].y, hl[k].z, hl[k].w}, gw[4] = {gv[k].x, gv[k].y, gv[k].z, gv[k].w};
            float r[8];
#pragma unroll
            for (int e = 0; e < 8; ++e) { const float hv = (e & 1) ? __uint_as_float(hw[e >> 1] & 0xffff0000u) : __uint_as_float(hw[e >> 1] << 16);
                const float gg = (e & 1) ? __uint_as_float(gw[e >> 1] & 0xffff0000u) : __uint_as_float(gw[e >> 1] << 16);
                r[e] = (hv + __builtin_amdgcn_exp2f((float)lf[k][e]) * cfa[k][e >> 2][e & 3] + __builtin_amdgcn_exp2f((float)lb[k][e]) * cba[k][e >> 2][e & 3]) * gg; }
            u32x4 w; w.x = pk2(r[0], r[1]); w.y = pk2(r[2], r[3]); w.z = pk2(r[4], r[5]); w.w = pk2(r[6], r[7]);
            *(u32x4*)((unsigned char*)G + (dry ? HL_BYTES : 0) + go[k]) = w;
        }
    }
}
__device__ __forceinline__ void lru_carry_phase(const Args& a, const int z, LAS unsigned char* lds) {
    int tid_ = threadIdx.x; asm volatile("" : "+v"(tid_));
    const int tid = tid_, seg = tid >> 4, cl = tid & 15;
    const f32x2* SUM = (const f32x2*)((a.ws + z) + WS_SUM); float* CIN = (float*)((a.ws + z) + WS_CIN);
    LAS f32x2* SEG = (LAS f32x2*)lds;
    for (int wg = blockIdx.x; wg < 320; wg += gridDim.x) {
        const int chain = wg * 16 + cl, b = chain / 2560, dir = (chain / LW) & 1, ch = chain % LW;
        f32x2 v[17]; float A = 1.f, Hh = 0.f;
#pragma unroll
        for (int e = 0; e < 17; ++e) { const int s = seg * 17 + e; int c;
            if (s < 8) c = 1024 + b * 8 + (dir ? 7 - s : s); else { const int li = s - 8; c = b * 512 + (dir ? 511 - li : li); }
            v[e] = (s < 520) ? SUM[(size_t)(c * 2 + dir) * LW + ch] : (f32x2){1.f, 0.f}; }
#pragma unroll
        for (int e = 0; e < 17; ++e) { Hh = v[e][0] * Hh + v[e][1]; A *= v[e][0]; }
        __syncthreads();
        SEG[seg * 16 + cl] = (f32x2){A, Hh};
        __syncthreads();
        float Hc = 0.f;
        for (int q = 0; q < seg; ++q) { const f32x2 sv = SEG[q * 16 + cl]; Hc = sv[0] * Hc + sv[1]; }
#pragma unroll
        for (int e = 0; e < 17; ++e) { const int s = seg * 17 + e; int c;
            if (s < 8) c = 1024 + b * 8 + (dir ? 7 - s : s); else { const int li = s - 8; c = b * 512 + (dir ? 511 - li : li); }
            if (s < 520) CIN[(size_t)(c * 2 + dir) * LW + ch] = Hc;
            Hc = v[e][0] * Hc + v[e][1]; }
    }
    __syncthreads();
}

#define XB_TMO      128
#define XB_XCNT(j)  (256  + 64 * (j))
#define XB_XSUB(j)  (1280 + 64 * (j))
#define XB_XGEN(j)  (2304 + 64 * (j))
#define XB_TOP      3328
#define XB_TOPGEN   3392
#define XCD_BAR_WORDS 3456
#define XB_SPIN_CAP (1u << 18)
__device__ __forceinline__ unsigned xb_ld(unsigned* p)              { return __hip_atomic_load(p, __ATOMIC_RELAXED, __HIP_MEMORY_SCOPE_AGENT); }
__device__ __forceinline__ unsigned xb_add(unsigned* p, unsigned v) { return __hip_atomic_fetch_add(p, v, __ATOMIC_RELAXED, __HIP_MEMORY_SCOPE_AGENT); }
__device__ __forceinline__ unsigned xb_xcc_id() { return (unsigned)__builtin_amdgcn_s_getreg((3 << 11) | 20) & 0xFu; }
#define XB_SPIN(cond, bar) do { unsigned _sp = 0; while (cond) { __builtin_amdgcn_s_sleep(1); \
    if ((++_sp & 255u) == 0u) { if (xb_ld(&(bar)[XB_TMO])) break; if (_sp > XB_SPIN_CAP) { atomicAdd(&(bar)[XB_TMO], 1u); break; } } } } while (0)
struct XcdBarrier { unsigned* bar; unsigned x; volatile LAS unsigned* st; };
__device__ __forceinline__ XcdBarrier xcd_barrier_post(unsigned* bar, volatile LAS unsigned* st) {
    XcdBarrier b; b.bar = bar; b.x = xb_xcc_id(); b.st = st;
    if (threadIdx.x == 0) (void)xb_add(&bar[XB_XCNT(b.x)], 1u);
    return b;
}
__device__ __forceinline__ void xcd_barrier_complete(unsigned* bar, unsigned x, unsigned& nloc, unsigned& nx) {
    const unsigned G = gridDim.x * gridDim.y * gridDim.z;
    unsigned sum, cnt, mine, sp = 0u;
    for (;;) {
        sum = 0u; cnt = 0u; mine = 0u;
#pragma unroll
        for (unsigned j = 0; j < 16; ++j) { const unsigned c = xb_ld(&bar[XB_XCNT(j)]); sum += c; cnt += (c > 0u) ? 1u : 0u; mine = (j == x) ? c : mine; }
        if (sum == G) break;
        __builtin_amdgcn_s_sleep(1);
        if ((++sp & 255u) == 0u) { if (xb_ld(&bar[XB_TMO])) break; if (sp > XB_SPIN_CAP) { atomicAdd(&bar[XB_TMO], 1u); break; } }
    }
    nloc = mine > 0u ? mine : 1u; nx = cnt > 0u ? cnt : 1u;
}
__device__ __forceinline__ void xcd_barrier(const XcdBarrier& b) {
    asm volatile("s_waitcnt vmcnt(0)" ::: "memory");
    __syncthreads();
    if (threadIdx.x == 0) {
        unsigned* bar = b.bar;
        __builtin_amdgcn_s_waitcnt(0);
        unsigned nloc = b.st[0], nx = b.st[1];
        if (nloc == 0u) { xcd_barrier_complete(bar, b.x, nloc, nx); b.st[0] = nloc; b.st[1] = nx; }
        const unsigned old = xb_add(&bar[XB_XSUB(b.x)], 1u);
        const unsigned gen = old / nloc;
        if (old + 1u == (gen + 1u) * nloc) {
            __builtin_amdgcn_fence(__ATOMIC_RELEASE, "agent");
            asm volatile("s_waitcnt vmcnt(0)" ::: "memory");
            const unsigned og = xb_add(&bar[XB_TOP], 1u);
            const unsigned tg = og / nx;
            if (og + 1u == (tg + 1u) * nx) xb_add(&bar[XB_TOPGEN], 1u);
            else XB_SPIN(xb_ld(&bar[XB_TOPGEN]) == tg, bar);
            __builtin_amdgcn_fence(__ATOMIC_ACQUIRE, "agent");
            xb_add(&bar[XB_XGEN(b.x)], 1u);
            asm volatile("s_waitcnt vmcnt(0)" ::: "memory");
        } else {
            XB_SPIN(xb_ld(&bar[XB_XGEN(b.x)]) == gen, bar);
            __builtin_amdgcn_fence(__ATOMIC_ACQUIRE, "agent");
            asm volatile("s_waitcnt vmcnt(0)" ::: "memory");
        }
    }
    __syncthreads();
}
#ifndef DBL_MASK
#define DBL_MASK 0
#endif
#ifndef EN_MASK
#define EN_MASK 0xffff
#endif
#define EN(t) ((EN_MASK >> (t)) & 1)
enum { PT_PREP = 0, PT_NORM = 1, PT_G1 = 2, PT_PLAIN = 3, PT_QK = 4, PT_ATT = 5, PT_IN = 6, PT_L2 = 7, PT_L3 = 8, PT_L4 = 9 };
__global__ void __launch_bounds__(512, 2) mega_fwd(Args a) {
    extern __shared__ __attribute__((aligned(16))) unsigned char lds_raw[];
    LAS unsigned char* lds = (LAS unsigned char*)lds_raw;
    cg::grid_group grid = cg::this_grid();
    volatile LAS unsigned* bst = (volatile LAS unsigned*)(lds + LDS_BYTES - 64);
    if (threadIdx.x < 2) bst[threadIdx.x] = 0u;
    __syncthreads();
    const XcdBarrier xbar = xcd_barrier_post((unsigned*)a.ws, bst);
    for (int ph = a.ph_lo; ph < a.ph_hi; ++ph) {
        int z; asm volatile("s_mov_b32 %0, 0" : "=s"(z));
        bf16* HB = (bf16*)((a.ws + z) + WS_HB); bf16* YB = (bf16*)((a.ws + z) + WS_YB); bf16* BIG = (bf16*)((a.ws + z) + WS_BIG);
        const unsigned pd = a.pdesc[ph + z];
        const int type = pd & 0xff, i = (pd >> 8) & 0xff, s = (pd >> 16) & 0xff, sub = (pd >> 24) & 0xff, j = i >> 1;
        for (int rep = ((DBL_MASK >> type) & 1) ? 0 : 1; rep < 2; ++rep) {
        const bool dry = rep == 0;
        if (rep == 1 && DBL_MASK) __syncthreads();
        if (type == PT_PREP && EN(PT_PREP)) prep_phase(a, z, lds);
        else if (type == PT_NORM && EN(PT_NORM)) {
            int res_l = (s > 0) ? i : i - 1, res_s = (s > 0) ? s - 1 : 2;
            const float res_w = (res_s == 1) ? 1.0f : 0.5f;
            norm_phase(a, z, res_l, res_s, res_w, i < 4 ? i : -1, s, dry);
        } else if (type == PT_G1 && EN(PT_G1)) {
            const bf16* W1t = (const bf16*)((a.ws + z) + WS_W) + (size_t)(i * 2 + (s >> 1)) * (W1T_BYTES / 2);
            EpiSwiGLU E{BIG}; run_gemm(lds, HB, W1t, (i == 3 && s == 2) ? ML : MT, 2 * FF, D, E);
        } else if (type == PT_PLAIN && EN(PT_PLAIN)) {
            const bf16* A = BIG; const bf16* Bt; int Mg = MT, Ng = D, K; bf16* O = YB; int ldc = D;
            if (sub == 0) { Bt = (const bf16*)((a.ws + z) + WS_W + 88 * MiB) + (size_t)(i * 2 + (s >> 1)) * (W2T_BYTES / 2); K = FF; }
            else if (sub == 1) { Bt = (const bf16*)((a.ws + z) + WS_W + 132 * MiB) + (size_t)j * (4 * MiB) + 3 * MiB; K = D; }
            else if (sub == 2) { Bt = (const bf16*)((a.ws + z) + WS_W + 148 * MiB) + (size_t)j * (9 * MiB / 2) + LRU_WOL / 2; K = LW; }
            else { A = (const bf16*)((a.ws + z) + WS_W + 132 * MiB) + (size_t)j * (4 * MiB) + 2 * MiB; Bt = HB; Mg = D; Ng = MT; K = D; O = BIG + 2 * ACT_ELEMS; ldc = MT; }
            if (i == 3 && s >= 1 && sub != 3) Mg = ML;
            pg8::EpiBf16<0> E{O, ldc, nullptr, 0, 0}; run_gemm(lds, A, Bt, Mg, Ng, K, E);
        } else if (type == PT_QK && EN(PT_QK)) {
            const bf16* Wn = (const bf16*)((a.ws + z) + WS_W + 132 * MiB) + (size_t)j * (4 * MiB);
            EpiRope E{BIG, BIG + ACT_ELEMS, (const float*)((a.ws + z) + WS_ROPE), (const float*)((a.ws + z) + WS_ROPE) + SEQ * 32};
            run_gemm(lds, HB, Wn, MT, 2048, D, E);
        } else if (type == PT_ATT && EN(PT_ATT)) attn_phase(a, z, j, lds, dry);
        else if (type == PT_IN && EN(PT_IN)) {
            const bf16* Wl = (const bf16*)((a.ws + z) + WS_W + 148 * MiB) + (size_t)j * (9 * MiB / 2);
            EpiGeluSplit E{BIG, BIG + (size_t)MT * LW}; run_gemm(lds, HB, Wl, MT, 2 * LW, D, E);
        } else if (type == PT_L2 && EN(PT_L2)) lru_scan_phase(a, z, j, lds);
        else if (type == PT_L3 && EN(PT_L3)) lru_carry_phase(a, z, lds);
        else if (type == PT_L4 && EN(PT_L4)) lru_apply_phase(a, z, dry);
        }
        if (ph + 1 < a.ph_hi) { if (ph == a.ph_lo) grid.sync(); else xcd_barrier(xbar); }
    }
}
constexpr int N_PHASES = 48;

#ifndef MK_MULTI
#define MK_MULTI 0
#endif
extern "C" void kernel_launch(void* const* d_in, const int* in_sizes, int n_in, void* d_out, int out_size, void* d_ws, size_t ws_size, hipStream_t stream) {
    static int grid = 0;
    if (grid == 0) {
        int dev = 0, cus = 0, per_cu = 0;
        hipGetDevice(&dev);
        hipDeviceGetAttribute(&cus, hipDeviceAttributeMultiprocessorCount, dev);
        if (hipFuncSetAttribute((const void*)mega_fwd, hipFuncAttributeMaxDynamicSharedMemorySize, LDS_BYTES) != hipSuccess) { fprintf(stderr, "hipFuncSetAttribute failed\n"); grid = -1; return; }
        if (hipOccupancyMaxActiveBlocksPerMultiprocessor(&per_cu, (const void*)mega_fwd, 512, LDS_BYTES) != hipSuccess || per_cu < 1) { fprintf(stderr, "occupancy query: %d\n", per_cu); per_cu = 1; }
        (void)hipGetLastError();
        grid = cus * per_cu;
        if (ws_size < WS_END || n_in != 23) { fprintf(stderr, "kernel_launch: ws %zu n_in %d\n", ws_size, n_in); grid = -1; return; }
    }
    if (grid < 0) return;
    Args a{};
    for (int i = 0; i < 23; ++i) a.in[i] = (const float*)d_in[i];
    a.out = (float*)d_out; a.ws = (unsigned char*)d_ws;
    int nj = 0, tiles = 0;
    auto add = [&](int in_idx, long long src_off, size_t dst_off, int K, int N, int ldn, int ldk, int map, int ncol0) {
        TJob& t = a.jobs[nj++]; t.src_off = src_off; t.dst_off = (long long)dst_off; t.in_idx = in_idx; t.map = map; t.ldn = ldn; t.ldk = ldk; t.nnt = N / 128; t.tile0 = tiles; t.ncol0 = ncol0; t.pad = 0;
        tiles += (K / 64) * (N / 128);
    };
    for (int i = 0; i < 4; ++i) for (int f = 0; f < 2; ++f) {
        add(8, (long long)(i * 2 + f) * D * FF, off_w1t(i, f), D, FF, FF, D, 1, 0);
        add(9, (long long)(i * 2 + f) * D * FF, off_w1t(i, f), D, FF, FF, D, 2, 0);
        add(10, (long long)(i * 2 + f) * FF * D, off_w2t(i, f), FF, D, D, FF, 0, 0);
    }
    for (int j = 0; j < 2; ++j) {
        add(11, (long long)j * D * 3 * D, off_na(j), D, 2 * D, 3 * D, D, 3, 0);
        add(11, (long long)j * D * 3 * D, off_na(j) + 4 * MiB, D, D, 3 * D, D, 0, 2 * D);
        add(12, (long long)j * D * D, off_na(j) + 6 * MiB, D, D, D, D, 0, 0);
        add(14, (long long)j * D * 2 * LW, off_lru(j), D, 2 * LW, 2 * LW, D, 0, 0);
        add(22, (long long)j * LW * D, off_lru(j) + LRU_WOL, LW, D, D, LW, 0, 0);
        for (int d = 0; d < 2; ++d) {
            add(17, (long long)(j * 2 + d) * 10 * 128 * 128, off_lru(j) + LRU_WG + (size_t)(d * 2 + 0) * 10 * 128 * 128 * 2, LW, 128, 128, 128, 4, 0);
            add(19, (long long)(j * 2 + d) * 10 * 128 * 128, off_lru(j) + LRU_WG + (size_t)(d * 2 + 1) * 10 * 128 * 128 * 2, LW, 128, 128, 128, 4, 0);
        }
    }
    a.njobs = nj; a.ntiles = tiles;
    {
        int np = 0;
        auto P = [&](int type, int i, int s, int sub) { a.pdesc[np++] = (unsigned)type | ((unsigned)i << 8) | ((unsigned)s << 16) | ((unsigned)sub << 24); };
        P(PT_PREP, 0, 0, 0);
        for (int i = 0; i < 4; ++i) for (int s = 0; s < 3; ++s) {
            P(PT_NORM, i, s, 0);
            if (s != 1) { P(PT_G1, i, s, 0); P(PT_PLAIN, i, s, 0); }
            else if ((i & 1) == 0) { P(PT_QK, i, s, 0); P(PT_PLAIN, i, s, 3); P(PT_ATT, i, s, 0); P(PT_PLAIN, i, s, 1); }
            else { P(PT_IN, i, s, 0); P(PT_L2, i, s, 0); P(PT_L3, i, s, 0); P(PT_L4, i, s, 0); P(PT_PLAIN, i, s, 2); }
        }
        P(PT_NORM, 4, 0, 0);
        if (np != N_PHASES) { fprintf(stderr, "phase count %d\n", np); return; }
    }
#if MK_MULTI
    for (int p = 0; p < N_PHASES; ++p) { a.ph_lo = p; a.ph_hi = p + 1; hipLaunchKernelGGL(mega_fwd, dim3(grid), dim3(512), LDS_BYTES, stream, a); }
#else
    a.ph_lo = 0; a.ph_hi = N_PHASES;
    if (hipMemsetAsync(d_ws, 0, 16384, stream) != hipSuccess) { fprintf(stderr, "memset failed\n"); return; }
    void* kargs[] = {&a};
    hipError_t e = hipLaunchCooperativeKernel((const void*)mega_fwd, dim3(grid), dim3(512), kargs, LDS_BYTES, stream);
    if (e != hipSuccess) fprintf(stderr, "cooperative launch failed: %s (grid %d)\n", hipGetErrorString(e), grid);
#endif
}
```
